# Optimizing an MI355X kernel written in HIP

```python
import jax, jax.numpy as jnp
from jax import lax
import numpy as np

D_MODEL = 2048
BATCH = 1
SEQ = 8192
DEPTH = 2

N_MEM = 256
EPS = 1e-6
POOL_WINDOWS = (2, 4, 8, 16)
N_POOL_GROUPS = len(POOL_WINDOWS)
POOL_WIDTH = D_MODEL // 2
POOL_GROUP_DIM = POOL_WIDTH // N_POOL_GROUPS
MLSTM_HEADS = 4
MLSTM_WIDTH = D_MODEL - POOL_WIDTH
MLSTM_HEAD_DIM = MLSTM_WIDTH // MLSTM_HEADS
MLSTM_CHUNK = 128
EVEN_IN_WIDTH = POOL_WIDTH + 4 * MLSTM_WIDTH + 2 * MLSTM_HEADS
FORGET_BIAS = 3.0
CONV_WIDTH = 3
XATTN_HEADS = 4
XATTN_HEAD_DIM = D_MODEL // XATTN_HEADS
N_GROUPS = 4
EXPERTS_PER_GROUP = 8
N_EXPERTS = N_GROUPS * EXPERTS_PER_GROUP
TOP_K = 2
D_EXPERT = D_MODEL // 2
MOE_BLOCK = 128
N_EVEN = (DEPTH + 1) // 2
N_ODD = DEPTH // 2

kernel_name = 'hybrid_pool_mlstm_shortconv_xattn_hmoe'


def rmsnorm(x, g):
    xf = x.astype(jnp.float32)
    y = xf * lax.rsqrt(jnp.mean(xf * xf, axis=-1, keepdims=True) + EPS)
    return (y * g.astype(jnp.float32)).astype(x.dtype)


def pool_mixer(u, w_grp, scale):
    b, s, _ = u.shape
    ug = u.astype(jnp.float32).reshape(b, s, N_POOL_GROUPS, POOL_GROUP_DIM)
    cs = jnp.cumsum(ug, axis=1)
    pos = jnp.arange(s)
    diffs = []
    for j, w in enumerate(POOL_WINDOWS):
        c = cs[:, :, j]
        c_prev = jnp.pad(c[:, :s - w], ((0, 0), (w, 0), (0, 0)))
        count = jnp.minimum(pos + 1, w).astype(jnp.float32)[None, :, None]
        diffs.append((c - c_prev) / count - ug[:, :, j])
    d = jnp.stack(diffs, axis=2).astype(u.dtype)
    y = jnp.einsum('bsgc,gcd->bsgd', d, w_grp)
    return y.reshape(b, s, POOL_WIDTH) * scale


def to_chunks(a, n_chunks):
    b, s, h = a.shape[:3]
    a = a.reshape((b, n_chunks, s // n_chunks, h) + a.shape[3:])
    return jnp.moveaxis(a, (1, 3), (0, 2))


def mlstm_chunkwise(q, k, v, i_pre, f_pre):
    b, s, h, dh = q.shape
    nc = s // MLSTM_CHUNK
    f32 = jnp.float32
    qc = to_chunks(q.astype(f32) * dh ** -0.5, nc)
    kc = to_chunks(k.astype(f32), nc)
    vc = to_chunks(v.astype(f32), nc)
    ic = to_chunks(i_pre.astype(f32), nc)
    lfc = to_chunks(jax.nn.log_sigmoid(f_pre.astype(f32)), nc)
    causal = jnp.tril(jnp.ones((MLSTM_CHUNK, MLSTM_CHUNK), dtype=bool))

    def step(carry, inp):
        c_st, n_st, m_st = carry
        qb, kb, vb, ib, lfb = inp
        bcum = jnp.cumsum(lfb, axis=-1)
        dmat = jnp.where(causal, bcum[..., :, None] - bcum[..., None, :] + ib[..., None, :], -jnp.inf)
        inter = bcum + m_st[..., None]
        m_t = jnp.maximum(jnp.max(dmat, axis=-1), inter)
        w_inter = jnp.exp(inter - m_t)
        scores = jnp.einsum('bhtd,bhsd->bhts', qb, kb) * jnp.exp(dmat - m_t[..., None])
        num = (w_inter[..., None] * jnp.einsum('bhvk,bhtk->bhtv', c_st, qb)
               + jnp.einsum('bhts,bhsv->bhtv', scores, vb))
        den = w_inter * jnp.einsum('bhk,bhtk->bht', n_st, qb) + jnp.sum(scores, axis=-1)
        h_out = num / jnp.maximum(jnp.abs(den), jnp.exp(-m_t))[..., None]
        b_last = bcum[..., -1]
        d_end = b_last[..., None] - bcum + ib
        m_new = jnp.maximum(b_last + m_st, jnp.max(d_end, axis=-1))
        a_prev = jnp.exp(b_last + m_st - m_new)
        a_s = jnp.exp(d_end - m_new[..., None])
        c_new = a_prev[..., None, None] * c_st + jnp.einsum('bhsv,bhsk->bhvk', vb * a_s[..., None], kb)
        n_new = a_prev[..., None] * n_st + jnp.einsum('bhs,bhsk->bhk', a_s, kb)
        return (c_new, n_new, m_new), h_out

    init = (jnp.zeros((b, h, dh, dh), f32), jnp.zeros((b, h, dh), f32), jnp.zeros((b, h), f32))
    _, hs = lax.scan(step, init, (qc, kc, vc, ic, lfc))
    return jnp.moveaxis(hs, (0, 2), (1, 3)).reshape(b, s, h, dh)


def head_rmsnorm(hm, gain):
    b, s, h, dh = hm.shape
    y = hm * lax.rsqrt(jnp.mean(hm * hm, axis=-1, keepdims=True) + EPS)
    return y.reshape(b, s, h * dh) * gain.astype(jnp.float32)


def even_mixer(hn, w_in, b_gates, pool_w, pool_scale, head_gain, w_out):
    b, s, _ = hn.shape
    z = hn @ w_in
    cuts = [POOL_WIDTH + j * MLSTM_WIDTH for j in range(5)]
    u, q, k, v, o, g = jnp.split(z, cuts, axis=-1)
    g = g.astype(jnp.float32) + b_gates.astype(jnp.float32)
    heads = lambda a: a.reshape(b, s, MLSTM_HEADS, MLSTM_HEAD_DIM)
    hm = mlstm_chunkwise(heads(q), heads(k), heads(v), g[..., :MLSTM_HEADS], g[..., MLSTM_HEADS:])
    y_m = (jax.nn.sigmoid(o.astype(jnp.float32)) * head_rmsnorm(hm, head_gain)).astype(hn.dtype)
    y_p = pool_mixer(u, pool_w, pool_scale)
    return jnp.concatenate([y_p, y_m], axis=-1) @ w_out


def odd_mixer(hn, w_in, conv_w, w_out):
    s = hn.shape[1]
    gate_b, gate_c, u = jnp.split(hn @ w_in, 3, axis=-1)
    z = gate_c * u
    zp = jnp.pad(z, ((0, 0), (CONV_WIDTH - 1, 0), (0, 0)))
    conv = conv_w[0] * zp[:, 0:s]
    for j in range(1, CONV_WIDTH):
        conv = conv + conv_w[j] * zp[:, j:j + s]
    return (gate_b * conv) @ w_out


def cross_attn(hn, mem_n, wq, wk, wv, wo):
    b, s, d = hn.shape
    m = mem_n.shape[1]
    q = (hn @ wq).reshape(b, s, XATTN_HEADS, XATTN_HEAD_DIM)
    k = (mem_n @ wk).reshape(b, m, XATTN_HEADS, XATTN_HEAD_DIM)
    v = (mem_n @ wv).reshape(b, m, XATTN_HEADS, XATTN_HEAD_DIM)
    sc = jnp.einsum('bshd,bmhd->bhsm', q, k).astype(jnp.float32) * XATTN_HEAD_DIM ** -0.5
    p = jax.nn.softmax(sc, axis=-1).astype(v.dtype)
    o = jnp.einsum('bhsm,bmhd->bshd', p, v).reshape(b, s, d)
    return o @ wo


def hier_moe(hn, wg_r, bg_r, we_r, be_r, w_gate, w_up, w_down):
    b, s, d = hn.shape
    n = b * s
    xt = hn.reshape(n, d)
    tok = jnp.arange(n, dtype=jnp.int32)
    g_logits = (xt @ wg_r).astype(jnp.float32) + bg_r.astype(jnp.float32)
    g_prob = jax.nn.softmax(g_logits, axis=-1)
    grp = jnp.argmax(g_logits, axis=-1).astype(jnp.int32)
    e_logits = ((xt @ we_r).astype(jnp.float32) + be_r.astype(jnp.float32)).reshape(n, N_GROUPS, EXPERTS_PER_GROUP)
    e_in = e_logits[tok, grp]
    top_v, top_i = lax.top_k(e_in, TOP_K)
    w_tok = jax.nn.softmax(top_v, axis=-1) * g_prob[tok, grp][:, None]
    expert = grp[:, None] * EXPERTS_PER_GROUP + top_i.astype(jnp.int32)
    a = n * TOP_K
    e_flat = expert.reshape(a)
    t_flat = jnp.repeat(tok, TOP_K)
    w_flat = w_tok.reshape(a)
    order = jnp.argsort(e_flat)
    e_s, t_s, w_s = e_flat[order], t_flat[order], w_flat[order]
    counts = jnp.bincount(e_flat, length=N_EXPERTS)
    start = jnp.cumsum(counts) - counts
    padded = (counts + MOE_BLOCK - 1) // MOE_BLOCK * MOE_BLOCK
    pend = jnp.cumsum(padded)
    pstart = pend - padded
    dest = pstart[e_s] + jnp.arange(a, dtype=jnp.int32) - start[e_s]
    n_blocks = -(-a // MOE_BLOCK) + N_EXPERTS
    p_rows = n_blocks * MOE_BLOCK
    row_tok = jnp.zeros((p_rows,), jnp.int32).at[dest].set(t_s)
    row_w = jnp.zeros((p_rows,), jnp.float32).at[dest].set(w_s)
    blk_e = jnp.minimum(jnp.searchsorted(pend, jnp.arange(n_blocks) * MOE_BLOCK, side='right'), N_EXPERTS - 1)
    xb = xt[row_tok].reshape(n_blocks, MOE_BLOCK, d)

    def expert_block(args):
        xblk, e = args
        hid = jax.nn.silu(xblk @ w_gate[e]) * (xblk @ w_up[e])
        return hid @ w_down[e]

    yb = lax.map(expert_block, (xb, blk_e)).reshape(p_rows, d)
    y = jnp.zeros((n, d), hn.dtype).at[row_tok].add(yb * row_w[:, None].astype(yb.dtype))
    return y.reshape(b, s, d)


def setup_inputs(seed: int = 0) -> dict:
    key = jax.random.key(seed)
    ks = iter(jax.random.split(key, 40))
    f32 = jnp.float32

    def normal(shape):
        return jax.random.normal(next(ks), shape, f32)

    def dense(shape, fan_in):
        return normal(shape) * fan_in ** -0.5

    def gain(shape):
        return 1.0 + 0.02 * normal(shape)

    def bias(shape):
        return 0.01 * normal(shape)

    gate_b = jnp.concatenate([bias((N_EVEN, MLSTM_HEADS)),
                              FORGET_BIAS + 0.1 * normal((N_EVEN, MLSTM_HEADS))], axis=-1)
    return {
        'x': normal((BATCH, SEQ, D_MODEL)),
        'mem': normal((BATCH, N_MEM, D_MODEL)),
        'mix_norm': gain((DEPTH, D_MODEL)),
        'xattn_norm': gain((DEPTH, D_MODEL)),
        'mem_norm': gain((DEPTH, D_MODEL)),
        'ffn_norm': gain((DEPTH, D_MODEL)),
        'final_norm': gain((D_MODEL,)),
        'ev_w_in': dense((N_EVEN, D_MODEL, EVEN_IN_WIDTH), D_MODEL),
        'ev_b_gates': gate_b,
        'ev_pool_w': dense((N_EVEN, N_POOL_GROUPS, POOL_GROUP_DIM, POOL_GROUP_DIM), POOL_GROUP_DIM),
        'ev_pool_scale': gain((N_EVEN, POOL_WIDTH)),
        'ev_head_norm': gain((N_EVEN, MLSTM_WIDTH)),
        'ev_w_out': dense((N_EVEN, D_MODEL, D_MODEL), D_MODEL),
        'od_w_in': dense((N_ODD, D_MODEL, 3 * D_MODEL), D_MODEL),
        'od_conv_w': dense((N_ODD, CONV_WIDTH, D_MODEL), CONV_WIDTH),
        'od_w_out': dense((N_ODD, D_MODEL, D_MODEL), D_MODEL),
        'xa_wq': dense((DEPTH, D_MODEL, D_MODEL), D_MODEL),
        'xa_wk': dense((DEPTH, D_MODEL, D_MODEL), D_MODEL),
        'xa_wv': dense((DEPTH, D_MODEL, D_MODEL), D_MODEL),
        'xa_wo': dense((DEPTH, D_MODEL, D_MODEL), D_MODEL),
        'rt_group_w': dense((DEPTH, D_MODEL, N_GROUPS), D_MODEL),
        'rt_group_b': bias((DEPTH, N_GROUPS)),
        'rt_expert_w': dense((DEPTH, D_MODEL, N_EXPERTS), D_MODEL),
        'rt_expert_b': bias((DEPTH, N_EXPERTS)),
        'ex_w_gate': dense((DEPTH, N_EXPERTS, D_MODEL, D_EXPERT), D_MODEL),
        'ex_w_up': dense((DEPTH, N_EXPERTS, D_MODEL, D_EXPERT), D_MODEL),
        'ex_w_down': dense((DEPTH, N_EXPERTS, D_EXPERT, D_MODEL), D_EXPERT),
    }


def reference(x, mem, mix_norm, xattn_norm, mem_norm, ffn_norm, final_norm,
              ev_w_in, ev_b_gates, ev_pool_w, ev_pool_scale, ev_head_norm, ev_w_out,
              od_w_in, od_conv_w, od_w_out,
              xa_wq, xa_wk, xa_wv, xa_wo,
              rt_group_w, rt_group_b, rt_expert_w, rt_expert_b,
              ex_w_gate, ex_w_up, ex_w_down):
    h = x
    for layer in range(DEPTH):
        j = layer // 2
        hn = rmsnorm(h, mix_norm[layer])
        if layer % 2 == 0:
            h = h + even_mixer(hn, ev_w_in[j], ev_b_gates[j], ev_pool_w[j], ev_pool_scale[j],
                               ev_head_norm[j], ev_w_out[j])
        else:
            h = h + odd_mixer(hn, od_w_in[j], od_conv_w[j], od_w_out[j])
        h = h + cross_attn(rmsnorm(h, xattn_norm[layer]), rmsnorm(mem, mem_norm[layer]),
                           xa_wq[layer], xa_wk[layer], xa_wv[layer], xa_wo[layer])
        h = h + hier_moe(rmsnorm(h, ffn_norm[layer]), rt_group_w[layer], rt_group_b[layer],
                         rt_expert_w[layer], rt_expert_b[layer],
                         ex_w_gate[layer], ex_w_up[layer], ex_w_down[layer])
    return rmsnorm(h, final_norm)
```

```cpp
#include <hip/hip_runtime.h>
#include <cstdio>
#include <cstdint>

#define LAS __attribute__((address_space(3)))
typedef unsigned short bf16_t;
typedef short bf16x8 __attribute__((ext_vector_type(8)));
typedef short s16x4 __attribute__((ext_vector_type(4)));
typedef short v4i16_t __attribute__((ext_vector_type(4)));
typedef float f32x4 __attribute__((ext_vector_type(4)));
typedef float f32x2 __attribute__((ext_vector_type(2)));
typedef unsigned u32x4 __attribute__((ext_vector_type(4)));
typedef unsigned u32x2 __attribute__((ext_vector_type(2)));

__device__ __forceinline__ unsigned cvt_pk_bf16(float lo, float hi) { unsigned r; asm volatile("v_cvt_pk_bf16_f32 %0, %1, %2" : "=v"(r) : "v"(lo), "v"(hi)); return r; }
__device__ __forceinline__ float bf_lo(unsigned u) { return __builtin_bit_cast(float, u << 16); }
__device__ __forceinline__ float bf_hi(unsigned u) { return __builtin_bit_cast(float, u & 0xffff0000u); }
__device__ __forceinline__ float bf2f(unsigned short b) { return __builtin_bit_cast(float, ((unsigned)b) << 16); }

__device__ __forceinline__ int fresh_tid() { int t = threadIdx.x; asm volatile("" : "+v"(t)); return t; }
__device__ __forceinline__ int fresh_bx() { int t = blockIdx.x; asm volatile("" : "+s"(t)); return t; }
__device__ __forceinline__ int fresh_s(int t) { asm volatile("" : "+s"(t)); return t; }
__device__ __forceinline__ void glds16(const char* base, unsigned voff, unsigned lds_dst) {
    unsigned keep;
    asm volatile("s_mov_b32 %0, m0\n\ts_mov_b32 m0, %3\n\ts_nop 0\n\tglobal_load_lds_dwordx4 %1, %2\n\ts_mov_b32 m0, %0" : "=&s"(keep) : "v"(voff), "s"(base), "s"(lds_dst) : "memory");
}
namespace pg8 {
constexpr int BM = 256, BK = 64, HALF = 128, HTB = HALF * BK * 2  , STAGE_BYTES = 8 * HTB, NXCD = 8, WGM = 8;
__host__ __device__ __forceinline__ int lds_byte(int r, int c) { const int st = (r >> 4) * 2 + (c >> 5), rr = r & 15, cc = c & 31, ob = rr * 64 + cc * 2; return st * 1024 + (ob ^ (((ob >> 9) & 1) << 5)); }
__host__ __device__ __forceinline__ void stage_rc(int b, int& R, int& C) { const int st = b / 1024, sb = b % 1024, swz = sb ^ (((sb >> 9) & 1) << 5); R = (st >> 1) * 16 + swz / 64; C = (st & 1) * 32 + (swz % 64) / 2; }
__host__ __device__ __forceinline__ int perm32(int rho) { const int n = rho >> 4, i = rho & 15; return 8 * (i >> 2) + 4 * n + (i & 3); }

struct Unit { const char* a; const char* b0; const char* b1; char* out; int ldc, pm, pn, e; };

__device__ __forceinline__ bool tile_of(int i, int G, int c, int nM, int nN, int& pm, int& pn) {
    const int nwg = nM * nN; const long L = (long)i * G + c; if (L >= nwg) return false;
    int wgid = (int)L; { const int q = nwg / NXCD, r = nwg % NXCD, xcd = wgid % NXCD, off = wgid / NXCD; wgid = (xcd < r ? xcd * (q + 1) : r * (q + 1) + (xcd - r) * q) + off; }
    const int nig = WGM * nN, gid = wgid / nig, fm = gid * WGM, gsz = (nM - fm) < WGM ? (nM - fm) : WGM;
    pm = fm + ((wgid % nig) % gsz); pn = (wgid % nig) / gsz; return true;
}
struct DenseSched {
    static constexpr bool GATHER = false;
    const char* A; size_t a_mstep, a_nstep; const char* B0; const char* B1; size_t b_nstep; char* out; int ldc, nM, nN, G, c;
    __device__ __forceinline__ bool next(int i, Unit& u) const {
        int pm, pn; if (!tile_of(i, G, c, nM, nN, pm, pn)) return false;
        u.a = A + (size_t)pm * a_mstep + (size_t)pn * a_nstep; u.b0 = B0 + (size_t)pn * b_nstep; u.b1 = B1 + (size_t)pn * b_nstep; u.out = out; u.ldc = ldc; u.pm = pm; u.pn = pn; u.e = 0; return true;
    }
    __device__ __forceinline__ int arow(const Unit&, int r) const { return r; }
};

struct EpiBf16 {
    static constexpr bool PERM = true;
    __device__ __forceinline__ void operator()(const f32x4 (&acc)[2][2][4][2], const Unit& u, int wr, int wc, int fr, int fq) const {
        bf16_t* base = (bf16_t*)u.out; const int row0 = u.pm * BM + wr * 64 + fr, col0 = u.pn * BM + wc * 32 + 8 * fq;
#pragma unroll
        for (int ai = 0; ai < 2; ++ai)
#pragma unroll
            for (int m = 0; m < 4; ++m) { bf16_t* rowp = base + (size_t)(row0 + ai * HALF + m * 16) * u.ldc + col0;
#pragma unroll
                for (int bj = 0; bj < 2; ++bj) { const f32x4 v0 = acc[ai][bj][m][0], v1 = acc[ai][bj][m][1];
                    u32x4 w; w.x = cvt_pk_bf16(v0[0], v0[1]); w.y = cvt_pk_bf16(v0[2], v0[3]); w.z = cvt_pk_bf16(v1[0], v1[1]); w.w = cvt_pk_bf16(v1[2], v1[3]);
                    *(u32x4*)(rowp + bj * HALF) = w; } }
    }
};
struct EpiBf16Scale {
    static constexpr bool PERM = true;
    const float* scale;
    __device__ __forceinline__ void operator()(const f32x4 (&acc)[2][2][4][2], const Unit& u, int wr, int wc, int fr, int fq) const {
        bf16_t* base = (bf16_t*)u.out; const int row0 = u.pm * BM + wr * 64 + fr, col0 = u.pn * BM + wc * 32 + 8 * fq;
        f32x4 sv[2][2];
#pragma unroll
        for (int bj = 0; bj < 2; ++bj)
#pragma unroll
            for (int n = 0; n < 2; ++n) sv[bj][n] = *(const f32x4*)(scale + col0 + bj * HALF + 4 * n);
#pragma unroll
        for (int ai = 0; ai < 2; ++ai)
#pragma unroll
            for (int m = 0; m < 4; ++m) { bf16_t* rowp = base + (size_t)(row0 + ai * HALF + m * 16) * u.ldc + col0;
#pragma unroll
                for (int bj = 0; bj < 2; ++bj) { const f32x4 v0 = acc[ai][bj][m][0] * sv[bj][0], v1 = acc[ai][bj][m][1] * sv[bj][1];
                    u32x4 w; w.x = cvt_pk_bf16(v0[0], v0[1]); w.y = cvt_pk_bf16(v0[2], v0[3]); w.z = cvt_pk_bf16(v1[0], v1[1]); w.w = cvt_pk_bf16(v1[2], v1[3]);
                    *(u32x4*)(rowp + bj * HALF) = w; } }
    }
};
template <bool SILU> struct EpiPair {
    static constexpr bool PERM = true;
    __device__ __forceinline__ void operator()(const f32x4 (&acc)[2][2][4][2], const Unit& u, int wr, int wc, int fr, int fq) const {
        bf16_t* base = (bf16_t*)u.out; const int row0 = u.pm * BM + wr * 64 + fr, col0 = u.pn * HALF + wc * 32 + 8 * fq;
#pragma unroll
        for (int ai = 0; ai < 2; ++ai)
#pragma unroll
            for (int m = 0; m < 4; ++m) { bf16_t* rowp = base + (size_t)(row0 + ai * HALF + m * 16) * u.ldc + col0;
                float r[8];
#pragma unroll
                for (int n = 0; n < 2; ++n)
#pragma unroll
                    for (int j = 0; j < 4; ++j) { const float g = acc[ai][0][m][n][j], up = acc[ai][1][m][n][j];
                        r[n * 4 + j] = SILU ? (g * __builtin_amdgcn_rcpf(1.0f + __expf(-g))) * up : g * up; }
                u32x4 w; w.x = cvt_pk_bf16(r[0], r[1]); w.y = cvt_pk_bf16(r[2], r[3]); w.z = cvt_pk_bf16(r[4], r[5]); w.w = cvt_pk_bf16(r[6], r[7]);
                *(u32x4*)rowp = w; }
    }
};
struct EpiRes {
    static constexpr bool PERM = false;
    const float* res;
    __device__ __forceinline__ void operator()(const f32x4 (&acc)[2][2][4][2], const Unit& u, int wr, int wc, int fr, int fq) const {
        float* base = (float*)u.out; const int row0 = u.pm * BM + wr * 64 + fr, col0 = u.pn * BM + wc * 32 + 4 * fq;
#pragma unroll
        for (int ai = 0; ai < 2; ++ai)
#pragma unroll
            for (int m = 0; m < 4; ++m) { const size_t ro = (size_t)(row0 + ai * HALF + m * 16) * u.ldc + col0;
                f32x4 rv[2][2];
#pragma unroll
                for (int bj = 0; bj < 2; ++bj)
#pragma unroll
                    for (int n = 0; n < 2; ++n) rv[bj][n] = *(const f32x4*)(res + ro + bj * HALF + n * 16);
#pragma unroll
                for (int bj = 0; bj < 2; ++bj)
#pragma unroll
                    for (int n = 0; n < 2; ++n) *(f32x4*)(base + ro + bj * HALF + n * 16) = acc[ai][bj][m][n] + rv[bj][n]; }
    }
};

template <bool RES16> struct EpiResSsq {
    static constexpr bool PERM = true;
    const void* res; float* ssq;
    __device__ __forceinline__ void operator()(const f32x4 (&acc)[2][2][4][2], const Unit& u, int wr, int wc, int fr, int fq) const {
        bf16_t* base = (bf16_t*)u.out; const int row0 = u.pm * BM + wr * 64 + fr, col0 = u.pn * BM + wc * 32 + 8 * fq;
#pragma unroll
        for (int ai = 0; ai < 2; ++ai)
#pragma unroll
            for (int m = 0; m < 4; ++m) { const int row = row0 + ai * HALF + m * 16; const size_t ro = (size_t)row * u.ldc + col0;
                f32x4 rv[2][2];
#pragma unroll
                for (int bj = 0; bj < 2; ++bj) {
                    if constexpr (RES16) { const u32x4 t = *(const u32x4*)((const bf16_t*)res + ro + bj * HALF);
                        rv[bj][0] = (f32x4){bf_lo(t.x), bf_hi(t.x), bf_lo(t.y), bf_hi(t.y)}; rv[bj][1] = (f32x4){bf_lo(t.z), bf_hi(t.z), bf_lo(t.w), bf_hi(t.w)}; }
                    else { rv[bj][0] = *(const f32x4*)((const float*)res + ro + bj * HALF); rv[bj][1] = *(const f32x4*)((const float*)res + ro + bj * HALF + 4); } }
                float s = 0.f;
#pragma unroll
                for (int bj = 0; bj < 2; ++bj) { const f32x4 v0 = acc[ai][bj][m][0] + rv[bj][0], v1 = acc[ai][bj][m][1] + rv[bj][1];
                    u32x4 w; w.x = cvt_pk_bf16(v0[0], v0[1]); w.y = cvt_pk_bf16(v0[2], v0[3]); w.z = cvt_pk_bf16(v1[0], v1[1]); w.w = cvt_pk_bf16(v1[2], v1[3]);
                    *(u32x4*)(base + ro + bj * HALF) = w;
                    s += ((v0[0] * v0[0] + v0[1] * v0[1]) + (v0[2] * v0[2] + v0[3] * v0[3])) + ((v1[0] * v1[0] + v1[1] * v1[1]) + (v1[2] * v1[2] + v1[3] * v1[3])); }
                if (ssq) { s += __shfl_xor(s, 16); s += __shfl_xor(s, 32);
                    if (fq == 0) ssq[(size_t)row * 32 + u.pn * 4 + wc] = s; } }
    }
};
struct EpiBf16RowScale {
    static constexpr bool PERM = true;
    const float* ssq; float inv_n, eps;
    __device__ __forceinline__ void operator()(const f32x4 (&acc)[2][2][4][2], const Unit& u, int wr, int wc, int fr, int fq) const {
        bf16_t* base = (bf16_t*)u.out; const int row0 = u.pm * BM + wr * 64 + fr, col0 = u.pn * BM + wc * 32 + 8 * fq;
#pragma unroll
        for (int ai = 0; ai < 2; ++ai)
#pragma unroll
            for (int m = 0; m < 4; ++m) { const int row = row0 + ai * HALF + m * 16; bf16_t* rowp = base + (size_t)row * u.ldc + col0;
                const f32x4 pa = *(const f32x4*)(ssq + (size_t)row * 32 + 8 * fq), pb = *(const f32x4*)(ssq + (size_t)row * 32 + 8 * fq + 4);
                float ps = ((pa[0] + pa[1]) + (pa[2] + pa[3])) + ((pb[0] + pb[1]) + (pb[2] + pb[3]));
                ps += __shfl_xor(ps, 16); ps += __shfl_xor(ps, 32);
                const float rs = rsqrtf(ps * inv_n + eps);
#pragma unroll
                for (int bj = 0; bj < 2; ++bj) { const f32x4 v0 = acc[ai][bj][m][0] * rs, v1 = acc[ai][bj][m][1] * rs;
                    u32x4 w; w.x = cvt_pk_bf16(v0[0], v0[1]); w.y = cvt_pk_bf16(v0[2], v0[3]); w.z = cvt_pk_bf16(v1[0], v1[1]); w.w = cvt_pk_bf16(v1[2], v1[3]);
                    *(u32x4*)(rowp + bj * HALF) = w; } }
    }
};

struct EpiBf16Rs {
    static constexpr bool PERM = true;
    const float* rs;
    __device__ __forceinline__ void operator()(const f32x4 (&acc)[2][2][4][2], const Unit& u, int wr, int wc, int fr, int fq) const {
        bf16_t* base = (bf16_t*)u.out; const int row0 = u.pm * BM + wr * 64 + fr, col0 = u.pn * BM + wc * 32 + 8 * fq;
#pragma unroll
        for (int ai = 0; ai < 2; ++ai)
#pragma unroll
            for (int m = 0; m < 4; ++m) { const int row = row0 + ai * HALF + m * 16; bf16_t* rowp = base + (size_t)row * u.ldc + col0; const float r = rs[row];
#pragma unroll
                for (int bj = 0; bj < 2; ++bj) { const f32x4 v0 = acc[ai][bj][m][0] * r, v1 = acc[ai][bj][m][1] * r;
                    u32x4 w; w.x = cvt_pk_bf16(v0[0], v0[1]); w.y = cvt_pk_bf16(v0[2], v0[3]); w.z = cvt_pk_bf16(v1[0], v1[1]); w.w = cvt_pk_bf16(v1[2], v1[3]);
                    *(u32x4*)(rowp + bj * HALF) = w; } }
    }
};
struct EpiPairRs {
    static constexpr bool PERM = true;
    const float* rs;
    __device__ __forceinline__ void operator()(const f32x4 (&acc)[2][2][4][2], const Unit& u, int wr, int wc, int fr, int fq) const {
        bf16_t* base = (bf16_t*)u.out; const int row0 = u.pm * BM + wr * 64 + fr, col0 = u.pn * HALF + wc * 32 + 8 * fq;
#pragma unroll
        for (int ai = 0; ai < 2; ++ai)
#pragma unroll
            for (int m = 0; m < 4; ++m) { const int row = row0 + ai * HALF + m * 16; bf16_t* rowp = base + (size_t)row * u.ldc + col0; const float q = rs[row], q2 = q * q;
                float r[8];
#pragma unroll
                for (int n = 0; n < 2; ++n)
#pragma unroll
                    for (int j = 0; j < 4; ++j) r[n * 4 + j] = acc[ai][0][m][n][j] * acc[ai][1][m][n][j] * q2;
                u32x4 w; w.x = cvt_pk_bf16(r[0], r[1]); w.y = cvt_pk_bf16(r[2], r[3]); w.z = cvt_pk_bf16(r[4], r[5]); w.w = cvt_pk_bf16(r[6], r[7]);
                *(u32x4*)rowp = w; }
    }
};

template <class Epi, class Sched, bool ALIGN_EPI>
__device__ __forceinline__ void gemm_phase(LAS unsigned char* lds, const int K, const int lda, const int ldb, const Sched& S, const Epi& E) {
    const int tid = fresh_tid(), wid = __builtin_amdgcn_readfirstlane(tid >> 6), lane = tid & 63, wr = wid >> 2, wc = wid & 3, fr = lane & 15, fq = lane >> 4;
    const int nt = K / BK;
    int sR[2], sC[2]; unsigned voffB[2], vA[2][2], nvA[2][2];
#pragma unroll
    for (int i = 0; i < 2; ++i) { stage_rc(tid * 16 + i * 8192, sR[i], sC[i]); const int Rb = Epi::PERM ? ((sR[i] & ~31) + perm32(sR[i] & 31)) : sR[i];
        voffB[i] = (unsigned)(Rb * ldb + sC[i]) * 2u; }
    const size_t kstep = (size_t)(BK * 2);
    const unsigned ldsb = (unsigned)__builtin_amdgcn_readfirstlane((int)(unsigned)(__UINTPTR_TYPE__)lds) + (unsigned)wid * 1024u;
    const size_t hstepA = (size_t)HALF * lda * 2;
    const int aoff = lds_byte(wr * 64 + fr, fq * 8), boff = lds_byte(wc * 32 + fr, fq * 8);
#define PG8_SA(b, h) (((b) * 2 + (h)) * HTB)
#define PG8_SB(b, h) ((4 + (b) * 2 + (h)) * HTB)
#define PG8_STAGE(bufoff, gbase, voff) do { _Pragma("unroll") for (int _i = 0; _i < 2; ++_i) \
        glds16((const char*)(gbase), (voff)[_i], ldsb + (unsigned)(bufoff) + (unsigned)(_i * 8192)); } while (0)
#define PG8_STAGE_A(bufoff, gbase, h, VA) do { if constexpr (Sched::GATHER) { PG8_STAGE(bufoff, gbase, (VA)[h]); } else { PG8_STAGE(bufoff, (gbase) + (h) * hstepA, (VA)[0]); } } while (0)
#define PG8_LDA(dst, b, h) do { _Pragma("unroll") for (int m = 0; m < 4; ++m) _Pragma("unroll") for (int k = 0; k < 2; ++k) dst[m][k] = *(const LAS bf16x8*)(lds + PG8_SA(b, h) + aoff + m * 2048 + k * 1024); } while (0)
#define PG8_LDB(dst, b, h) do { _Pragma("unroll") for (int n = 0; n < 2; ++n) _Pragma("unroll") for (int k = 0; k < 2; ++k) dst[n][k] = *(const LAS bf16x8*)(lds + PG8_SB(b, h) + boff + n * 2048 + k * 1024); } while (0)
#define PG8_MMA(ai, bj, At, Bt) do { __builtin_amdgcn_s_setprio(1); _Pragma("unroll") for (int m = 0; m < 4; ++m) _Pragma("unroll") for (int n = 0; n < 2; ++n) _Pragma("unroll") for (int k = 0; k < 2; ++k) \
        acc[ai][bj][m][n] = __builtin_amdgcn_mfma_f32_16x16x32_bf16(Bt[n][k], At[m][k], acc[ai][bj][m][n], 0, 0, 0); __builtin_amdgcn_s_setprio(0); } while (0)
#define PG8_WAIT_V(n) asm volatile("s_waitcnt vmcnt(" #n ")" ::: "memory")
#define PG8_WAIT_L(n) asm volatile("s_waitcnt lgkmcnt(" #n ")" ::: "memory")
#define PG8_BAR __builtin_amdgcn_s_barrier()
#define PG8_SCHED __builtin_amdgcn_sched_barrier(0)
    Unit cur, nxt; int ui = 0;
    if (!S.next(0, cur)) return;
#pragma unroll
    for (int h = 0; h < 2; ++h)
#pragma unroll
        for (int i = 0; i < 2; ++i) vA[h][i] = Sched::GATHER ? (unsigned)(S.arow(cur, h * HALF + sR[i]) * lda + sC[i]) * 2u : (unsigned)(sR[i] * lda + sC[i]) * 2u;
    f32x4 acc[2][2][4][2];
#pragma unroll
    for (int a = 0; a < 2; ++a)
#pragma unroll
        for (int b = 0; b < 2; ++b)
#pragma unroll
            for (int m = 0; m < 4; ++m)
#pragma unroll
                for (int n = 0; n < 2; ++n) acc[a][b][m][n] = (f32x4){0.f, 0.f, 0.f, 0.f};
    bf16x8 At[4][2], B0[2][2], B1[2][2];
    PG8_STAGE(PG8_SB(0, 0), cur.b0, voffB); PG8_STAGE(PG8_SB(0, 1), cur.b1, voffB); PG8_STAGE_A(PG8_SA(0, 0), cur.a, 0, vA); PG8_STAGE_A(PG8_SA(0, 1), cur.a, 1, vA);
    if (wr == 1) PG8_BAR;
    PG8_WAIT_V(2); PG8_BAR;
    PG8_STAGE(PG8_SB(1, 0), cur.b0 + kstep, voffB); PG8_STAGE_A(PG8_SA(1, 0), cur.a + kstep, 0, vA); PG8_STAGE(PG8_SB(1, 1), cur.b1 + kstep, voffB);
    PG8_WAIT_V(6); PG8_BAR;
    for (;;) {
        const bool has_next = S.next(ui + 1, nxt);
        const char* nA = has_next ? nxt.a : cur.a; const char* nB0 = has_next ? nxt.b0 : cur.b0; const char* nB1 = has_next ? nxt.b1 : cur.b1;
        if constexpr (Sched::GATHER) {
#pragma unroll
            for (int h = 0; h < 2; ++h)
#pragma unroll
                for (int i = 0; i < 2; ++i) nvA[h][i] = has_next ? (unsigned)(S.arow(nxt, h * HALF + sR[i]) * lda + sC[i]) * 2u : vA[h][i];
        }
        for (int t = 0; t < nt; t += 2) {
            const bool last = (t == nt - 2);
            const char* a1 = cur.a + (size_t)(t + 1) * kstep;
            const char* a2 = last ? nA : cur.a + (size_t)(t + 2) * kstep;
            const char* b20 = last ? nB0 : cur.b0 + (size_t)(t + 2) * kstep; const char* b21 = last ? nB1 : cur.b1 + (size_t)(t + 2) * kstep;
            const char* a3 = a2 + kstep; const char* b30 = b20 + kstep; const char* b31 = b21 + kstep;
            unsigned wA[2][2];
#pragma unroll
            for (int h = 0; h < 2; ++h)
#pragma unroll
                for (int i = 0; i < 2; ++i) wA[h][i] = (Sched::GATHER && last) ? nvA[h][i] : vA[h][i];
            PG8_LDB(B0, 0, 0); PG8_LDB(B1, 0, 1); PG8_SCHED; PG8_LDA(At, 0, 0); PG8_STAGE_A(PG8_SA(1, 1), a1, 1, vA);
            PG8_WAIT_V(8); PG8_WAIT_L(0); PG8_BAR; PG8_MMA(0, 0, At, B0); PG8_MMA(0, 1, At, B1); PG8_BAR; PG8_SCHED;
            PG8_LDA(At, 0, 1); PG8_STAGE(PG8_SB(0, 0), b20, voffB); PG8_STAGE(PG8_SB(0, 1), b21, voffB); PG8_STAGE_A(PG8_SA(0, 0), a2, 0, wA);
            PG8_WAIT_V(8); PG8_WAIT_L(0); PG8_BAR; PG8_MMA(1, 0, At, B0); PG8_MMA(1, 1, At, B1); PG8_BAR; PG8_SCHED;
            PG8_LDB(B0, 1, 0); PG8_LDB(B1, 1, 1); PG8_SCHED; PG8_LDA(At, 1, 0); PG8_STAGE_A(PG8_SA(0, 1), a2, 1, wA);
            PG8_WAIT_V(8); PG8_WAIT_L(0); PG8_BAR; PG8_MMA(0, 0, At, B0); PG8_MMA(0, 1, At, B1); PG8_BAR; PG8_SCHED;
            PG8_LDA(At, 1, 1); PG8_STAGE(PG8_SB(1, 0), b30, voffB); PG8_STAGE(PG8_SB(1, 1), b31, voffB); PG8_STAGE_A(PG8_SA(1, 0), a3, 0, wA);
            PG8_WAIT_V(8); PG8_WAIT_L(0); PG8_BAR; PG8_MMA(1, 0, At, B0); PG8_MMA(1, 1, At, B1); PG8_BAR; PG8_SCHED;
        }
        if constexpr (ALIGN_EPI) { if (wr == 0) PG8_BAR; }
        E(acc, cur, wr, wc, fr, fq);
        if (!has_next) break;
#pragma unroll
        for (int a = 0; a < 2; ++a)
#pragma unroll
            for (int b = 0; b < 2; ++b)
#pragma unroll
                for (int m = 0; m < 4; ++m)
#pragma unroll
                    for (int n = 0; n < 2; ++n) acc[a][b][m][n] = (f32x4){0.f, 0.f, 0.f, 0.f};
        cur = nxt; ++ui;
        if constexpr (Sched::GATHER) {
#pragma unroll
            for (int h = 0; h < 2; ++h)
#pragma unroll
                for (int i = 0; i < 2; ++i) vA[h][i] = nvA[h][i];
        }
        if constexpr (ALIGN_EPI) { if (wr == 1) PG8_BAR; }
    }
    PG8_WAIT_V(0);
    if constexpr (!ALIGN_EPI) { if (wr == 0) PG8_BAR; }
    PG8_BAR;
#undef PG8_SA
#undef PG8_SB
#undef PG8_STAGE
#undef PG8_STAGE_A
#undef PG8_LDA
#undef PG8_LDB
#undef PG8_MMA
#undef PG8_WAIT_V
#undef PG8_WAIT_L
#undef PG8_BAR
#undef PG8_SCHED
}
}
#define XB_TMO      128
#define XB_XCNT(j)  (256  + 64 * (j))
#define XB_XSUB(j)  (1280 + 64 * (j))
#define XB_XGEN(j)  (2304 + 64 * (j))
#define XB_TOP      3328
#define XB_TOPGEN   3392
#define XCD_BAR_WORDS 3456
#define XB_SPIN_CAP (1u << 21)

__device__ __forceinline__ unsigned xb_ld(unsigned* p)              { return __hip_atomic_load(p, __ATOMIC_RELAXED, __HIP_MEMORY_SCOPE_AGENT); }
__device__ __forceinline__ unsigned xb_add(unsigned* p, unsigned v) { return __hip_atomic_fetch_add(p, v, __ATOMIC_RELAXED, __HIP_MEMORY_SCOPE_AGENT); }
__device__ __forceinline__ unsigned xb_xcc_id() { return (unsigned)__builtin_amdgcn_s_getreg((3 << 11) | 20) & 0xFu; }
#define XB_SPIN(cond, bar) do { unsigned _sp = 0; while (cond) { __builtin_amdgcn_s_sleep(1); \
    if ((++_sp & 255u) == 0u) { if (xb_ld(&(bar)[XB_TMO])) break; if (_sp > XB_SPIN_CAP) { atomicAdd(&(bar)[XB_TMO], 1u); break; } } } } while (0)

struct XcdBarrier {
    unsigned* bar; unsigned x;
    volatile LAS unsigned* st;
};

__device__ __forceinline__ XcdBarrier xcd_barrier_post(unsigned* bar, volatile LAS unsigned* st) {
    XcdBarrier b; b.bar = bar; b.x = xb_xcc_id(); b.st = st;
    if (threadIdx.x == 0) (void)xb_add(&bar[XB_XCNT(b.x)], 1u);
    return b;
}
__device__ __forceinline__ void xcd_barrier_complete(unsigned* bar, unsigned x, unsigned& nloc, unsigned& nx) {
    const unsigned G = gridDim.x * gridDim.y * gridDim.z;
    unsigned sum, cnt, mine, sp = 0u;
    for (;;) {
        sum = 0u; cnt = 0u; mine = 0u;
#pragma unroll
        for (unsigned j = 0; j < 16; ++j) { const unsigned c = xb_ld(&bar[XB_XCNT(j)]); sum += c; cnt += (c > 0u) ? 1u : 0u; mine = (j == x) ? c : mine; }
        if (sum == G) break;
        __builtin_amdgcn_s_sleep(1);
        if ((++sp & 255u) == 0u) { if (xb_ld(&bar[XB_TMO])) break; if (sp > XB_SPIN_CAP) { atomicAdd(&bar[XB_TMO], 1u); break; } }
    }
    nloc = mine > 0u ? mine : 1u; nx = cnt > 0u ? cnt : 1u;
}

__device__ __forceinline__ void xcd_barrier(const XcdBarrier& b) {
    asm volatile("s_waitcnt vmcnt(0)" ::: "memory");
    __syncthreads();
    if (threadIdx.x == 0) {
        unsigned* bar = b.bar;
        __builtin_amdgcn_s_waitcnt(0);
        unsigned nloc = b.st[0], nx = b.st[1];
        if (nloc == 0u) { xcd_barrier_complete(bar, b.x, nloc, nx); b.st[0] = nloc; b.st[1] = nx; }
        const unsigned old = xb_add(&bar[XB_XSUB(b.x)], 1u);
        const unsigned gen = old / nloc;
        if (old + 1u == (gen + 1u) * nloc) {
            __builtin_amdgcn_fence(__ATOMIC_RELEASE, "agent");
            asm volatile("s_waitcnt vmcnt(0)" ::: "memory");
            const unsigned og = xb_add(&bar[XB_TOP], 1u);
            const unsigned tg = og / nx;
            if (og + 1u == (tg + 1u) * nx) xb_add(&bar[XB_TOPGEN], 1u);
            else XB_SPIN(xb_ld(&bar[XB_TOPGEN]) == tg, bar);
            __builtin_amdgcn_fence(__ATOMIC_ACQUIRE, "agent");
            xb_add(&bar[XB_XGEN(b.x)], 1u);
            asm volatile("s_waitcnt vmcnt(0)" ::: "memory");
        } else {
            XB_SPIN(xb_ld(&bar[XB_XGEN(b.x)]) == gen, bar);
            __builtin_amdgcn_fence(__ATOMIC_ACQUIRE, "agent");
            asm volatile("s_waitcnt vmcnt(0)" ::: "memory");
        }
    }
    __syncthreads();
}

constexpr int T = 8192, D = 2048, NMEM = 256;
constexpr int EVW = 5128, EVN = 5120, ODN = 6144;
constexpr int NH = 4, DH = 256, CH = 128, NCH = 64;
constexpr int XH = 4, XD = 512;
constexpr int NEXP = 32, DEXP = 1024, LISTCAP = 8192;
constexpr float EPS = 1e-6f;
constexpr int NWAVES = 8, NTHR = 512;

constexpr size_t MiB = 1u << 20;
constexpr size_t WS_CTL = 0, CTL_ZERO_BYTES = 192 * 1024, CTL_SSQ = 64 * 1024;
constexpr size_t WS_WEVIN = 1 * MiB, WS_WEVOUT = 21 * MiB, WS_WODIN = 29 * MiB, WS_WODOUT = 53 * MiB;
constexpr size_t WS_WXQ = 61 * MiB, WS_WXK = 77 * MiB, WS_WXV = 93 * MiB, WS_WXO = 109 * MiB, WS_WPOOL = 125 * MiB;
constexpr size_t WS_MEMN = 126 * MiB, WS_KX = 128 * MiB, WS_VX = 130 * MiB, WS_SMALL = 132 * MiB;
constexpr size_t WS_WEXP = 136 * MiB, WEXP_LAYER = 384 * MiB, WEXP_MAT = 128 * MiB, WEXP_ONE = (size_t)DEXP * D * 2;
constexpr size_t WS_HN = 904 * MiB, WS_Z = 936 * MiB, WS_YCAT = 1032 * MiB, WS_DPOOL = 1064 * MiB, WS_KC = 1080 * MiB, WS_CST = 1144 * MiB;
constexpr size_t WS_QX = 1192 * MiB, WS_OATT = 1224 * MiB, WS_HID = 1256 * MiB, WS_YB = 1304 * MiB, WS_LIST = 1400 * MiB, WS_TOKINFO = 1402 * MiB, WS_H16 = 1404 * MiB, WS_END = 1436 * MiB;
constexpr size_t SM_GATES = 0, SM_BCUM = 256 * 1024, SM_GI = 384 * 1024, SM_MARR = 512 * 1024, SM_APREV = 516 * 1024, SM_BL = 520 * 1024, SM_KN = 1 * MiB, SM_NST = 1 * MiB + 256 * 1024, SM_SSQP = 2 * MiB;
constexpr int CW_BAR = 4096;
constexpr int CW_CNT = 8192;
constexpr int LDS_BYTES = 159744, MISC_OFF = 159232, TBL_OFF = 157696;

__device__ __forceinline__ float wave_sum(float v) {
#pragma unroll
    for (int o = 1; o < 64; o <<= 1) v += __shfl_xor(v, o);
    return v;
}
__device__ __forceinline__ float wave_max(float v) {
#pragma unroll
    for (int o = 1; o < 64; o <<= 1) v = fmaxf(v, __shfl_xor(v, o));
    return v;
}
template <int N, int BIT> struct WRed {
    static __device__ __forceinline__ void run(float* v, int lane) {
        const bool up = (lane & BIT) != 0;
#pragma unroll
        for (int i = 0; i < N / 2; ++i) { const float keep = up ? v[i + N / 2] : v[i]; const float send = up ? v[i] : v[i + N / 2]; v[i] = keep + __shfl_xor(send, BIT); }
        WRed<N / 2, BIT / 2>::run(v, lane);
    }
};
template <int BIT> struct WRed<1, BIT> { static __device__ __forceinline__ void run(float*, int) {} };
template <int N> struct Log2 { static constexpr int v = 1 + Log2<N / 2>::v; };
template <> struct Log2<1> { static constexpr int v = 0; };
template <int N> __device__ __forceinline__ float wave_reduce_pow2(float (&v)[N], int lane) {
    WRed<N, 32>::run(v, lane);
    float r = v[0];
#pragma unroll
    for (int s = Log2<N>::v; s < 6; ++s) r += __shfl_xor(r, 32 >> s);
    return r;
}
__device__ __forceinline__ float logsigf(float x) { return fminf(x, 0.f) - log1pf(expf(-fabsf(x))); }

__device__ __forceinline__ void transpose_item64(const float* W, int ldw, int K, bf16_t* WT, int kb, int nb, LAS float* scr, int lane, const float* gain) {
    const int k0 = kb * 64, n0 = nb * 64;
    const float* src = W + (size_t)(k0 + (lane >> 4)) * ldw + n0 + 4 * (lane & 15);
    f32x4 v[16];
#pragma unroll
    for (int i = 0; i < 16; ++i) v[i] = *(const f32x4*)(src + (size_t)(4 * i) * ldw);
    if (gain) {
#pragma unroll
        for (int i = 0; i < 16; ++i) v[i] = v[i] * gain[k0 + 4 * i + (lane >> 4)]; }
#pragma unroll
    for (int i = 0; i < 16; ++i) { LAS float* d = scr + (4 * i + (lane >> 4)) * 65 + 4 * (lane & 15); d[0] = v[i][0]; d[1] = v[i][1]; d[2] = v[i][2]; d[3] = v[i][3]; }
    asm volatile("s_waitcnt lgkmcnt(0)" ::: "memory");
    const int kc = lane & 7;
#pragma unroll
    for (int j = 0; j < 8; ++j) { const int n = (lane >> 3) + 8 * j; const LAS float* s = scr + (8 * kc) * 65 + n;
        u32x4 o; o.x = cvt_pk_bf16(s[0], s[65]); o.y = cvt_pk_bf16(s[130], s[195]); o.z = cvt_pk_bf16(s[260], s[325]); o.w = cvt_pk_bf16(s[390], s[455]);
        *(u32x4*)(WT + (size_t)(n0 + n) * K + k0 + 8 * kc) = o; }
    asm volatile("s_waitcnt lgkmcnt(0)" ::: "memory");
}

template <int ROWS, int COLS, int PAD> __device__ __forceinline__ void stage_tile(LAS unsigned char* dst, const bf16_t* src, size_t ld, int tid) {
    constexpr int CPR = COLS / 8, TOTAL = ROWS * CPR, RS = (COLS + PAD) * 2, NI = TOTAL / NTHR;
    static_assert(TOTAL % NTHR == 0, "stage_tile");
    u32x4 v[NI];
#pragma unroll
    for (int i = 0; i < NI; ++i) { const int idx = tid + i * NTHR, r = idx / CPR, c = idx % CPR; v[i] = *(const u32x4*)(src + (size_t)r * ld + c * 8); }
#pragma unroll
    for (int i = 0; i < NI; ++i) { const int idx = tid + i * NTHR, r = idx / CPR, c = idx % CPR; *(LAS u32x4*)(dst + r * RS + c * 16) = v[i]; }
}
template <int ROWS, int COLS> __device__ __forceinline__ void stage_load(u32x4 (&v)[ROWS * (COLS / 8) / NTHR], const bf16_t* src, size_t ld, int tid) {
    constexpr int CPR = COLS / 8, NI = ROWS * CPR / NTHR;
#pragma unroll
    for (int i = 0; i < NI; ++i) { const int idx = tid + i * NTHR, r = idx / CPR, c = idx % CPR; v[i] = *(const u32x4*)(src + (size_t)r * ld + c * 8); }
}
template <int ROWS, int COLS, int PAD> __device__ __forceinline__ void stage_store(LAS unsigned char* dst, const u32x4 (&v)[ROWS * (COLS / 8) / NTHR], int tid) {
    constexpr int CPR = COLS / 8, NI = ROWS * CPR / NTHR, RS = (COLS + PAD) * 2;
#pragma unroll
    for (int i = 0; i < NI; ++i) { const int idx = tid + i * NTHR, r = idx / CPR, c = idx % CPR; *(LAS u32x4*)(dst + r * RS + c * 16) = v[i]; }
}
__device__ __forceinline__ bf16x8 row_frag(const LAS unsigned char* tile, int RS, int n0, int k0, int lane) {
    return *(const LAS bf16x8*)(tile + (n0 + (lane & 15)) * RS + (k0 + 8 * (lane >> 4)) * 2);
}
__device__ __forceinline__ s16x4 tr4(const LAS unsigned char* p) { return __builtin_bit_cast(s16x4, __builtin_amdgcn_ds_read_tr16_b64_v4i16((LAS v4i16_t*)p)); }
__device__ __forceinline__ bf16x8 tr_frag(const LAS unsigned char* tile, int RS, int k0, int n0, int lane) {
    const int g = lane >> 4, i = lane & 15, q = i >> 2, pp = i & 3;
    const LAS unsigned char* a = tile + (k0 + 8 * g + q) * RS + (n0 + 4 * pp) * 2;
    const s16x4 lo = tr4(a), hi = tr4(a + 4 * RS);
    return (bf16x8){lo[0], lo[1], lo[2], lo[3], hi[0], hi[1], hi[2], hi[3]};
}
#define MFMA16(b, a, c) __builtin_amdgcn_mfma_f32_16x16x32_bf16((b), (a), (c), 0, 0, 0)

enum { RM_PLAIN = 0, RM_GATES = 1, RM_ROUTE = 2, RM_COMBINE = 3 };
struct RowArgs {
    const float* hin; float* hout; const bf16_t* hin16; bf16_t* hout16; const float* gain; bf16_t* hn; float* fout;
    const float* wgate; const float* bgate; float* gates;
    const float* rgw; const float* rgb; const float* rew; const float* reb; unsigned* cnt; int* list; int* tokinfo;
    const bf16_t* yb; const int* tokinfo_in;
    float* rsl;
    const bf16_t* wr;
};
template <int MODE, bool OUTF32, bool HIN16 = false, bool HOUT16 = false>
__device__ __forceinline__ void row_phase(LAS unsigned char* lds, const RowArgs& a, int G) {
    constexpr int NRED = 40, RG = (MODE == RM_ROUTE) ? 4 : 32;
    const int tid = fresh_tid(), lane = tid & 63, wave = __builtin_amdgcn_readfirstlane(tid >> 6);
    LAS float* red = (LAS float*)lds;
    LAS float* rstd_l = (LAS float*)(lds + 40960);
    LAS float* fin = (LAS float*)(lds + 41088);
    LAS int* cntl = (LAS int*)(lds + 46208);
    LAS int* basel = (LAS int*)(lds + 46336);
    const LAS int* tbl = (const LAS int*)(lds + TBL_OFF);
    const f32x4 g4 = *(const f32x4*)(a.gain + 4 * tid);
    for (int rb = fresh_bx(); rb < T / 32; rb += G) {
        const int row0 = rb * 32;
    float wg8[4][8]; float we[4][32]; float wgr[4][4];
    if constexpr (MODE == RM_GATES) {
#pragma unroll
        for (int i = 0; i < 4; ++i) { const f32x4 lo = *(const f32x4*)(a.wgate + (size_t)(4 * tid + i) * EVW + EVN), hi = *(const f32x4*)(a.wgate + (size_t)(4 * tid + i) * EVW + EVN + 4);
#pragma unroll
            for (int o = 0; o < 4; ++o) { wg8[i][o] = lo[o] * g4[i]; wg8[i][4 + o] = hi[o] * g4[i]; } }
    }
    if constexpr (MODE == RM_ROUTE && !HIN16) {
#pragma unroll
        for (int i = 0; i < 4; ++i) {
#pragma unroll
            for (int o4 = 0; o4 < 8; ++o4) { const f32x4 w = *(const f32x4*)(a.rew + (size_t)(4 * tid + i) * NEXP + 4 * o4);
#pragma unroll
                for (int o = 0; o < 4; ++o) we[i][4 * o4 + o] = w[o] * g4[i]; }
            const f32x4 w = *(const f32x4*)(a.rgw + (size_t)(4 * tid + i) * 4);
#pragma unroll
            for (int o = 0; o < 4; ++o) wgr[i][o] = w[o] * g4[i];
        }
    }
        if (MODE == RM_ROUTE && tid < 32) cntl[tid] = 0;
        f32x4 xs[RG];
        if constexpr (MODE == RM_ROUTE && HIN16) {
            const int fr = lane & 15, fq = lane >> 4;
            f32x4 acc[2][3]; float sq[2] = {0.f, 0.f};
#pragma unroll
            for (int mt = 0; mt < 2; ++mt)
#pragma unroll
                for (int nt = 0; nt < 3; ++nt) acc[mt][nt] = (f32x4){0.f, 0.f, 0.f, 0.f};
#pragma unroll 2
            for (int ks = 0; ks < 8; ++ks) { const int k0 = 256 * wave + 32 * ks + 8 * fq;
                bf16x8 af[2], bh[3], bl[3];
#pragma unroll
                for (int mt = 0; mt < 2; ++mt) af[mt] = *(const bf16x8*)(a.hin16 + (size_t)(row0 + 16 * mt + fr) * D + k0);
#pragma unroll
                for (int nt = 0; nt < 3; ++nt) { bh[nt] = *(const bf16x8*)(a.wr + (size_t)(16 * nt + fr) * D + k0); bl[nt] = *(const bf16x8*)(a.wr + (size_t)(48 + 16 * nt + fr) * D + k0); }
#pragma unroll
                for (int mt = 0; mt < 2; ++mt) {
#pragma unroll
                    for (int e = 0; e < 8; ++e) { const float v = bf2f((unsigned short)af[mt][e]); sq[mt] += v * v; }
#pragma unroll
                    for (int nt = 0; nt < 3; ++nt) { acc[mt][nt] = MFMA16(bh[nt], af[mt], acc[mt][nt]); acc[mt][nt] = MFMA16(bl[nt], af[mt], acc[mt][nt]); } }
            }
#pragma unroll
            for (int mt = 0; mt < 2; ++mt) { const int r = 16 * mt + fr;
#pragma unroll
                for (int nt = 0; nt < 3; ++nt)
#pragma unroll
                    for (int i = 0; i < 4; ++i) { const int o = 16 * nt + 4 * fq + i; if (o < 36) red[(r * 8 + wave) * NRED + o] = acc[mt][nt][i]; }
                float s = sq[mt]; s += __shfl_xor(s, 16); s += __shfl_xor(s, 32);
                if (fq == 0) red[(r * 8 + wave) * NRED + 36] = s; }
        } else {
        u32x2 xnext[(MODE == RM_ROUTE && HIN16) ? RG : 1];
        if constexpr (MODE == RM_ROUTE && HIN16) {
#pragma unroll
            for (int i = 0; i < RG; ++i) xnext[i] = *(const u32x2*)(a.hin16 + (size_t)(row0 + i) * D + 4 * tid);
        }
        for (int grp = 0; grp < 32 / RG; ++grp) {
            if constexpr (MODE == RM_ROUTE && HIN16) {
#pragma unroll
                for (int i = 0; i < RG; ++i) xs[i] = (f32x4){bf_lo(xnext[i].x), bf_hi(xnext[i].x), bf_lo(xnext[i].y), bf_hi(xnext[i].y)};
                const int gn = (grp + 1 < 32 / RG) ? grp + 1 : grp;
#pragma unroll
                for (int i = 0; i < RG; ++i) xnext[i] = *(const u32x2*)(a.hin16 + (size_t)(row0 + gn * RG + i) * D + 4 * tid);
            } else {
#pragma unroll
            for (int i = 0; i < RG; ++i) {
                if constexpr (HIN16) { const u32x2 t = *(const u32x2*)(a.hin16 + (size_t)(row0 + grp * RG + i) * D + 4 * tid); xs[i] = (f32x4){bf_lo(t.x), bf_hi(t.x), bf_lo(t.y), bf_hi(t.y)}; }
                else xs[i] = *(const f32x4*)(a.hin + (size_t)(row0 + grp * RG + i) * D + 4 * tid); }
            }
            if constexpr (MODE == RM_COMBINE) {
#pragma unroll
                for (int i = 0; i < RG; ++i) { const int row = row0 + grp * RG + i; const int* ti = a.tokinfo_in + (size_t)row * 8;
                    const int e0 = ti[0], p0 = ti[1], e1 = ti[3], p1 = ti[4]; const float w0 = __builtin_bit_cast(float, ti[2]), w1 = __builtin_bit_cast(float, ti[5]);
                    const size_t s0 = (size_t)tbl[e0] * 256 + p0, s1 = (size_t)tbl[e1] * 256 + p1;
                    const u32x2 y0 = *(const u32x2*)(a.yb + s0 * D + 4 * tid), y1 = *(const u32x2*)(a.yb + s1 * D + 4 * tid);
                    f32x4 x = xs[i];
                    x[0] += w0 * bf_lo(y0.x) + w1 * bf_lo(y1.x); x[1] += w0 * bf_hi(y0.x) + w1 * bf_hi(y1.x);
                    x[2] += w0 * bf_lo(y0.y) + w1 * bf_lo(y1.y); x[3] += w0 * bf_hi(y0.y) + w1 * bf_hi(y1.y);
                    xs[i] = x;
                    if constexpr (HOUT16) { u32x2 w; w.x = cvt_pk_bf16(x[0], x[1]); w.y = cvt_pk_bf16(x[2], x[3]); *(u32x2*)(a.hout16 + (size_t)row * D + 4 * tid) = w; }
                    else *(f32x4*)(a.hout + (size_t)row * D + 4 * tid) = x; }
            }
#pragma unroll
            for (int i = 0; i < RG; ++i) {
                const f32x4 x = xs[i]; const int r = grp * RG + i;
                float ssq[1]; ssq[0] = (x[0] * x[0] + x[1] * x[1]) + (x[2] * x[2] + x[3] * x[3]);
                if constexpr (MODE == RM_GATES) {
                    float v[8];
#pragma unroll
                    for (int o = 0; o < 8; ++o) v[o] = (x[0] * wg8[0][o] + x[1] * wg8[1][o]) + (x[2] * wg8[2][o] + x[3] * wg8[3][o]);
                    const float rv = wave_reduce_pow2<8>(v, lane);
                    if ((lane & 7) == 0) red[(r * 8 + wave) * NRED + (lane >> 3)] = rv;
                }
                if constexpr (MODE == RM_ROUTE) {
                    float v[32];
#pragma unroll
                    for (int o = 0; o < 32; ++o) v[o] = (x[0] * we[0][o] + x[1] * we[1][o]) + (x[2] * we[2][o] + x[3] * we[3][o]);
                    const float rv = wave_reduce_pow2<32>(v, lane);
                    if ((lane & 1) == 0) red[(r * 8 + wave) * NRED + (lane >> 1)] = rv;
                    float u[4];
#pragma unroll
                    for (int o = 0; o < 4; ++o) u[o] = (x[0] * wgr[0][o] + x[1] * wgr[1][o]) + (x[2] * wgr[2][o] + x[3] * wgr[3][o]);
                    const float ru = wave_reduce_pow2<4>(u, lane);
                    if ((lane & 15) == 0) red[(r * 8 + wave) * NRED + 32 + (lane >> 4)] = ru;
                }
                const float rs = wave_reduce_pow2<1>(ssq, lane);
                if (lane == 0) red[(r * 8 + wave) * NRED + 36] = rs;
            }
        }
        }
        __syncthreads();
        int fe0 = 0, fe1 = 0, lp0 = 0, lp1 = 0; float fw0 = 0.f, fw1 = 0.f, frs = 0.f;
        if (tid < 32) {
            const int r = tid, row = row0 + r;
            float s = 0.f;
#pragma unroll
            for (int w = 0; w < 8; ++w) s += red[(r * 8 + w) * NRED + 36];
            const float rstd = rsqrtf(s * (1.0f / D) + EPS);
            rstd_l[r] = rstd; frs = rstd;
            if constexpr (MODE == RM_GATES) {
#pragma unroll
                for (int o = 0; o < 8; ++o) { float d = 0.f;
#pragma unroll
                    for (int w = 0; w < 8; ++w) d += red[(r * 8 + w) * NRED + o];
                    a.gates[(size_t)row * 8 + o] = d * rstd + a.bgate[o]; }
            }
            if constexpr (MODE == RM_ROUTE) {
#pragma unroll
                for (int o = 0; o < 36; ++o) { float d = 0.f;
#pragma unroll
                    for (int w = 0; w < 8; ++w) d += red[(r * 8 + w) * NRED + o];
                    fin[r * NRED + o] = d * rstd + (o < 32 ? a.reb[o] : a.rgb[o - 32]); }
                const float l0 = fin[r * NRED + 32], l1 = fin[r * NRED + 33], l2 = fin[r * NRED + 34], l3 = fin[r * NRED + 35];
                int gsel = 0; float mx = l0;
                if (l1 > mx) { mx = l1; gsel = 1; }
                if (l2 > mx) { mx = l2; gsel = 2; }
                if (l3 > mx) { mx = l3; gsel = 3; }
                const float gp = 1.0f / (expf(l0 - mx) + expf(l1 - mx) + expf(l2 - mx) + expf(l3 - mx));
                float v1 = -INFINITY, v2 = -INFINITY; int i1 = 0, i2 = 0;
                for (int j = 0; j < 8; ++j) { const float v = fin[r * NRED + gsel * 8 + j]; if (v > v1) { v1 = v; i1 = j; } }
                for (int j = 0; j < 8; ++j) { const float v = fin[r * NRED + gsel * 8 + j]; if (j != i1 && v > v2) { v2 = v; i2 = j; } }
                const float e21 = expf(v2 - v1), inv = 1.0f / (1.0f + e21);
                fw0 = gp * inv; fw1 = gp * e21 * inv; fe0 = gsel * 8 + i1; fe1 = gsel * 8 + i2;
                lp0 = atomicAdd((int*)&cntl[fe0], 1); lp1 = atomicAdd((int*)&cntl[fe1], 1);
            }
        }
        __syncthreads();
        if constexpr (MODE == RM_ROUTE) {
            if (tid < 32) { const int c = cntl[tid]; basel[tid] = c ? (int)__hip_atomic_fetch_add(a.cnt + tid * 64, (unsigned)c, __ATOMIC_RELAXED, __HIP_MEMORY_SCOPE_AGENT) : 0; }
            __syncthreads();
            if (tid < 32) { const int row = row0 + tid; const int p0 = basel[fe0] + lp0, p1 = basel[fe1] + lp1;
                a.list[(size_t)fe0 * LISTCAP + p0] = row; a.list[(size_t)fe1 * LISTCAP + p1] = row;
                if constexpr (HIN16) { a.rsl[(size_t)fe0 * LISTCAP + p0] = frs; a.rsl[(size_t)fe1 * LISTCAP + p1] = frs; }
                int* ti = a.tokinfo + (size_t)row * 8;
                ti[0] = fe0; ti[1] = p0; ti[2] = __builtin_bit_cast(int, fw0); ti[3] = fe1; ti[4] = p1; ti[5] = __builtin_bit_cast(int, fw1); ti[6] = 0; ti[7] = 0; }
        }
        constexpr bool SRC16 = (MODE == RM_COMBINE) ? HOUT16 : HIN16;
        const float* src2 = (MODE == RM_COMBINE) ? (const float*)a.hout : a.hin; const bf16_t* src216 = (MODE == RM_COMBINE) ? (const bf16_t*)a.hout16 : a.hin16;
        if constexpr (MODE == RM_ROUTE && HIN16) {
        } else if constexpr (RG == 32) {
            if constexpr (OUTF32) {
#pragma unroll
                for (int i = 0; i < 32; ++i) { const int row = row0 + i; const float rs = rstd_l[i]; const f32x4 y = xs[i] * rs * g4; *(f32x4*)(a.fout + (size_t)row * D + 4 * tid) = y; }
            } else {
#pragma unroll
                for (int i = 0; i < 32; i += 2) { u32x2 ab[2];
#pragma unroll
                    for (int n = 0; n < 2; ++n) { const float rs = rstd_l[i + n]; const f32x4 y = xs[i + n] * rs * g4; ab[n].x = cvt_pk_bf16(y[0], y[1]); ab[n].y = cvt_pk_bf16(y[2], y[3]); }
                    const bool odd = tid & 1; const u32x2 give = odd ? ab[0] : ab[1];
                    u32x2 got; got.x = (unsigned)__shfl_xor((int)give.x, 1); got.y = (unsigned)__shfl_xor((int)give.y, 1);
                    u32x4 w; if (odd) { w.x = got.x; w.y = got.y; w.z = ab[1].x; w.w = ab[1].y; } else { w.x = ab[0].x; w.y = ab[0].y; w.z = got.x; w.w = got.y; }
                    *(u32x4*)(a.hn + (size_t)(row0 + i + (odd ? 1 : 0)) * D + 4 * (tid & ~1)) = w; }
            }
        } else {
        for (int grp = 0; grp < 4; ++grp) {
            f32x4 ys[8];
#pragma unroll
            for (int i = 0; i < 8; ++i) {
                if constexpr (SRC16) { const u32x2 t = *(const u32x2*)(src216 + (size_t)(row0 + grp * 8 + i) * D + 4 * tid); ys[i] = (f32x4){bf_lo(t.x), bf_hi(t.x), bf_lo(t.y), bf_hi(t.y)}; }
                else ys[i] = *(const f32x4*)(src2 + (size_t)(row0 + grp * 8 + i) * D + 4 * tid); }
#pragma unroll
            for (int i = 0; i < 8; ++i) { const int row = row0 + grp * 8 + i; const float rs = rstd_l[grp * 8 + i]; const f32x4 y = ys[i] * rs * g4;
                if constexpr (OUTF32) *(f32x4*)(a.fout + (size_t)row * D + 4 * tid) = y;
                else { u32x2 w; w.x = cvt_pk_bf16(y[0], y[1]); w.y = cvt_pk_bf16(y[2], y[3]); *(u32x2*)(a.hn + (size_t)row * D + 4 * tid) = w; } }
        }
        }
        __syncthreads();
    }
}

template <bool FINAL>
__device__ __forceinline__ void combine_phase(LAS unsigned char* lds, bf16_t* h16, const bf16_t* yb, const int* tokinfo, const float* gain, float* rsout, float* fout, int G) {
    const int tid = fresh_tid(), lane = tid & 63, wave = __builtin_amdgcn_readfirstlane(tid >> 6);
    const LAS int* tbl = (const LAS int*)(lds + TBL_OFF);
    const int gw = fresh_bx() * NWAVES + wave, NGW = G * NWAVES;
    auto ldti = [&](int r, int (&t)[6]) { const int* ti = tokinfo + (size_t)r * 8;
#pragma unroll
        for (int i = 0; i < 6; ++i) t[i] = ti[i]; };
    auto issue = [&](int r, const int (&t)[6], u32x4 (&hv)[4], u32x4 (&y0)[4], u32x4 (&y1)[4]) {
        const size_t s0 = (size_t)tbl[t[0]] * 256 + t[1], s1 = (size_t)tbl[t[3]] * 256 + t[4];
#pragma unroll
        for (int j = 0; j < 4; ++j) { const int col = 8 * lane + 512 * j;
            hv[j] = *(const u32x4*)(h16 + (size_t)r * D + col); y0[j] = *(const u32x4*)(yb + s0 * D + col); y1[j] = *(const u32x4*)(yb + s1 * D + col); } };
    int row = gw;
    if (row < T) {
        int tc[6], tn[6] = {0, 0, 0, 0, 0, 0};
        u32x4 hv[4], y0[4], y1[4], hvn[4], y0n[4], y1n[4];
        ldti(row, tc);
        if (row + NGW < T) ldti(row + NGW, tn);
        issue(row, tc, hv, y0, y1);
#pragma unroll 1
        for (;;) {
            const int rn = row + NGW; const bool more = rn < T;
            int tnn[6] = {0, 0, 0, 0, 0, 0};
            if (more && rn + NGW < T) ldti(rn + NGW, tnn);
            if (more) issue(rn, tn, hvn, y0n, y1n);
            const float w0 = __builtin_bit_cast(float, tc[2]), w1 = __builtin_bit_cast(float, tc[5]);
            float x[4][8]; float ss = 0.f;
#pragma unroll
            for (int j = 0; j < 4; ++j) {
                const unsigned hw[4] = {hv[j].x, hv[j].y, hv[j].z, hv[j].w}, aw[4] = {y0[j].x, y0[j].y, y0[j].z, y0[j].w}, bw[4] = {y1[j].x, y1[j].y, y1[j].z, y1[j].w};
#pragma unroll
                for (int q = 0; q < 4; ++q) { x[j][2 * q] = bf_lo(hw[q]) + w0 * bf_lo(aw[q]) + w1 * bf_lo(bw[q]); x[j][2 * q + 1] = bf_hi(hw[q]) + w0 * bf_hi(aw[q]) + w1 * bf_hi(bw[q]); }
#pragma unroll
                for (int q = 0; q < 8; ++q) ss += x[j][q] * x[j][q];
            }
            const float rs = rsqrtf(wave_sum(ss) * (1.0f / D) + EPS);
#pragma unroll
            for (int j = 0; j < 4; ++j) { const int col = 8 * lane + 512 * j;
                if constexpr (!FINAL) { u32x4 w; w.x = cvt_pk_bf16(x[j][0], x[j][1]); w.y = cvt_pk_bf16(x[j][2], x[j][3]); w.z = cvt_pk_bf16(x[j][4], x[j][5]); w.w = cvt_pk_bf16(x[j][6], x[j][7]);
                    *(u32x4*)(h16 + (size_t)row * D + col) = w; }
                if constexpr (FINAL) { const f32x4 g0 = *(const f32x4*)(gain + col), g1 = *(const f32x4*)(gain + col + 4);
                    const f32x4 a0 = (f32x4){x[j][0], x[j][1], x[j][2], x[j][3]} * rs * g0, a1 = (f32x4){x[j][4], x[j][5], x[j][6], x[j][7]} * rs * g1;
                    *(f32x4*)(fout + (size_t)row * D + col) = a0; *(f32x4*)(fout + (size_t)row * D + col + 4) = a1; }
            }
            if constexpr (!FINAL) { if (lane == 0) rsout[row] = rs; }
            if (!more) break;
            row = rn;
#pragma unroll
            for (int i = 0; i < 6; ++i) { tc[i] = tn[i]; tn[i] = tnn[i]; }
#pragma unroll
            for (int j = 0; j < 4; ++j) { hv[j] = hvn[j]; y0[j] = y0n[j]; y1[j] = y1n[j]; }
        }
    }
}
constexpr int MOE_PT_OFF = 80, MOE_PARTS = 128;
__device__ __forceinline__ void moe_tables(LAS unsigned char* lds, const unsigned* cnt) {
    LAS int* tbl = (LAS int*)(lds + TBL_OFF);
    __syncthreads();
    const int tq = fresh_tid();
    if (tq < 64) {
        const int e = tq & 31; const int c = (tq < 32) ? (int)__hip_atomic_load(cnt + e * 64, __ATOMIC_RELAXED, __HIP_MEMORY_SCOPE_AGENT) : 0;
        const int t256 = (c + 255) >> 8, t16 = (c + 15) >> 4, np = (t16 + 23) / 24;
        int s1 = t256, s2 = np;
#pragma unroll
        for (int d = 1; d < 32; d <<= 1) { const int a = __shfl_up(s1, d), b = __shfl_up(s2, d); if (tq >= d) { s1 += a; s2 += b; } }
        if (tq < 32) { tbl[e] = s1 - t256; tbl[33 + e] = c; tbl[MOE_PT_OFF + e] = s2 - np;
            if (e == 31) { tbl[32] = s1; tbl[MOE_PT_OFF + 32] = s2; }
            const int tpp = np ? (t16 + np - 1) / np : 0;
            for (int p = 0; p < np; ++p) { const int t0 = p * tpp, nt = (t16 - t0) < tpp ? (t16 - t0) : tpp; tbl[MOE_PARTS + (s2 - np) + p] = e | (t0 << 5) | (nt << 15); } }
    }
    __syncthreads();
}
struct Moe1Sched {
    static constexpr bool GATHER = true;
    const LAS int* tbl; const int* list; const char* xn; const char* wg; const char* wu; char* hid; int G, c;
    __device__ __forceinline__ bool next(int i, pg8::Unit& u) const {
        const int MT = __builtin_amdgcn_readfirstlane(tbl[32]); const int U = MT * 8; const long L = (long)i * G + c; if (L >= U) return false;
        int wgid = (int)L; { const int q = U / 8, r = U % 8, xcd = wgid % 8, off = wgid / 8; wgid = (xcd < r ? xcd * (q + 1) : r * (q + 1) + (xcd - r) * q) + off; }
        const int mtg = wgid >> 3, nt = wgid & 7; int e = 0;
        for (int k = 1; k < 32; ++k) e += (__builtin_amdgcn_readfirstlane(tbl[k]) <= mtg) ? 1 : 0;
        e = __builtin_amdgcn_readfirstlane(e);
        const int ml = mtg - __builtin_amdgcn_readfirstlane(tbl[e]);
        u.a = xn; u.b0 = wg + (size_t)e * WEXP_ONE + (size_t)nt * (128 * D * 2); u.b1 = wu + (size_t)e * WEXP_ONE + (size_t)nt * (128 * D * 2);
        u.out = hid; u.ldc = DEXP; u.pm = mtg; u.pn = nt; u.e = e | (ml << 8); return true;
    }
    __device__ __forceinline__ int arow(const pg8::Unit& u, int r) const {
        const int e = u.e & 255, ml = u.e >> 8; const int cntv = __builtin_amdgcn_readfirstlane(tbl[33 + e]); int idx = ml * 256 + r; idx = idx < cntv ? idx : 0;
        return list[(size_t)e * LISTCAP + idx];
    }
};
struct Moe2Sched {
    static constexpr bool GATHER = false;
    const LAS int* tbl; const char* hid; const char* wd; char* yb; int G, c;
    __device__ __forceinline__ bool next(int i, pg8::Unit& u) const {
        const int MT = __builtin_amdgcn_readfirstlane(tbl[32]); const int U = MT * 8; const long L = (long)i * G + c; if (L >= U) return false;
        int wgid = (int)L; { const int q = U / 8, r = U % 8, xcd = wgid % 8, off = wgid / 8; wgid = (xcd < r ? xcd * (q + 1) : r * (q + 1) + (xcd - r) * q) + off; }
        const int mtg = wgid >> 3, pn = wgid & 7; int e = 0;
        for (int k = 1; k < 32; ++k) e += (__builtin_amdgcn_readfirstlane(tbl[k]) <= mtg) ? 1 : 0;
        e = __builtin_amdgcn_readfirstlane(e);
        u.a = hid + (size_t)mtg * (256 * DEXP * 2); u.b0 = wd + (size_t)e * WEXP_ONE + (size_t)pn * (256 * DEXP * 2); u.b1 = u.b0 + (size_t)128 * DEXP * 2;
        u.out = yb; u.ldc = D; u.pm = mtg; u.pn = pn; u.e = e; return true;
    }
    __device__ __forceinline__ int arow(const pg8::Unit&, int r) const { return r; }
};
struct KVSched {
    static constexpr bool GATHER = false;
    const char* memn; const char* wk; const char* wv; char* kx; char* vx; int G, c;
    __device__ __forceinline__ bool next(int i, pg8::Unit& u) const {
        const int j = ((c + G - (G >> 1)) % G) + i * G; if (j >= 32) return false;
        const int l = j >> 4, kv = (j >> 3) & 1, idx = j & 7;
        u.a = memn + (size_t)l * (NMEM * D * 2);
        const char* wb = (kv ? wv : wk) + (size_t)l * ((size_t)D * D * 2) + (size_t)idx * (256 * D * 2);
        u.b0 = wb; u.b1 = wb + (size_t)128 * D * 2; u.out = (kv ? vx : kx) + (size_t)l * (NMEM * D * 2); u.ldc = D; u.pm = 0; u.pn = idx; u.e = 0; return true;
    }
    __device__ __forceinline__ int arow(const pg8::Unit&, int r) const { return r; }
};

__device__ __forceinline__ void mlstm_prep(LAS unsigned char* lds, int h, const float* gates, float* bcum, float* gi, float* marr, float* aprev, float* blg) {
    const int tid = fresh_tid(), lane = tid & 63, wave = tid >> 6;
    LAS float* bl = (LAS float*)lds; LAS float* dm = bl + 64;
    for (int c = wave; c < NCH; c += NWAVES) {
        const int t = c * CH + 2 * lane;
        const float i0 = gates[(size_t)t * 8 + h], i1 = gates[(size_t)(t + 1) * 8 + h], f0 = gates[(size_t)t * 8 + 4 + h], f1 = gates[(size_t)(t + 1) * 8 + 4 + h];
        const float l0 = logsigf(f0), l1 = logsigf(f1);
        float p = l0 + l1;
#pragma unroll
        for (int o = 1; o < 64; o <<= 1) { const float n = __shfl_up(p, o); if (lane >= o) p += n; }
        const float bc1 = p, bc0 = p - l1, blast = __shfl(p, 63);
        bcum[(size_t)t * 4 + h] = bc0; bcum[(size_t)(t + 1) * 4 + h] = bc1;
        gi[(size_t)t * 4 + h] = i0 - bc0; gi[(size_t)(t + 1) * 4 + h] = i1 - bc1;
        const float d = wave_max(fmaxf(blast - bc0 + i0, blast - bc1 + i1));
        if (lane == 0) { bl[c] = blast; dm[c] = d; }
    }
    __syncthreads();
    if (tid == 0) {
        float m = 0.f;
        for (int c = 0; c < NCH; ++c) { marr[h * 65 + c] = m; const float b = bl[c], mn = fmaxf(b + m, dm[c]); aprev[h * 64 + c] = expf(b + m - mn); blg[h * 64 + c] = b; m = mn; }
        marr[h * 65 + NCH] = m;
    }
    __syncthreads();
}

__device__ __forceinline__ void mlstm_B(LAS unsigned char* lds, int c, int h, const bf16_t* Z, const float* gi, const float* marr, const float* blg, float* KC, float* KN) {
    constexpr int RS = (DH + 16) * 2;
    const int tid = fresh_tid(), lane = tid & 63, wave = __builtin_amdgcn_readfirstlane(tid >> 6), fr = lane & 15, fq = lane >> 4;
    LAS unsigned char* Vt = lds; LAS unsigned char* Kt = lds + CH * RS; LAS float* asc = (LAS float*)(lds + 2 * CH * RS);
    const int t0 = c * CH;
    __syncthreads();
    if (tid < CH) asc[tid] = expf(blg[h * 64 + c] + gi[(size_t)(t0 + tid) * 4 + h] - marr[h * 65 + c + 1]);
    __syncthreads();
    stage_tile<CH, DH, 16>(Vt, Z + (size_t)t0 * EVN + 3072 + h * DH, EVN, tid);
    {
        u32x4 v[8];
#pragma unroll
        for (int i = 0; i < 8; ++i) { const int idx = tid + i * NTHR, r = idx >> 5, cc = idx & 31; v[i] = *(const u32x4*)(Z + (size_t)(t0 + r) * EVN + 2048 + h * DH + cc * 8); }
#pragma unroll
        for (int i = 0; i < 8; ++i) { const int idx = tid + i * NTHR, r = idx >> 5, cc = idx & 31; const float s = asc[r]; u32x4 o;
            o.x = cvt_pk_bf16(bf_lo(v[i].x) * s, bf_hi(v[i].x) * s); o.y = cvt_pk_bf16(bf_lo(v[i].y) * s, bf_hi(v[i].y) * s);
            o.z = cvt_pk_bf16(bf_lo(v[i].z) * s, bf_hi(v[i].z) * s); o.w = cvt_pk_bf16(bf_lo(v[i].w) * s, bf_hi(v[i].w) * s);
            *(LAS u32x4*)(Kt + r * RS + cc * 16) = o; }
    }
    __syncthreads();
    const int wr2 = wave >> 2, wc2 = wave & 3;
    f32x4 acc[8][4];
#pragma unroll
    for (int mi = 0; mi < 8; ++mi)
#pragma unroll
        for (int nj = 0; nj < 4; ++nj) acc[mi][nj] = (f32x4){0.f, 0.f, 0.f, 0.f};
#pragma unroll
    for (int ks = 0; ks < 4; ++ks) {
        bf16x8 bk[4];
#pragma unroll
        for (int nj = 0; nj < 4; ++nj) bk[nj] = tr_frag(Kt, RS, 32 * ks, 64 * wc2 + 16 * nj, lane);
#pragma unroll
        for (int mi = 0; mi < 8; ++mi) { const bf16x8 av = tr_frag(Vt, RS, 32 * ks, 128 * wr2 + 16 * mi, lane);
#pragma unroll
            for (int nj = 0; nj < 4; ++nj) acc[mi][nj] = MFMA16(bk[nj], av, acc[mi][nj]); }
    }
#define ACC8(m) "+v"(acc[m][0]), "+v"(acc[m][1]), "+v"(acc[m][2]), "+v"(acc[m][3]), "+v"(acc[m + 1][0]), "+v"(acc[m + 1][1]), "+v"(acc[m + 1][2]), "+v"(acc[m + 1][3])
    asm volatile("s_nop 0" : ACC8(0), ACC8(2)); asm volatile("s_nop 0" : ACC8(4), ACC8(6));
    asm volatile("s_nop 7\n\ts_nop 7\n\ts_nop 7" : ACC8(0), ACC8(2)); asm volatile("s_nop 0" : ACC8(4), ACC8(6));
#undef ACC8
    bf16_t* kc = (bf16_t*)KC + (size_t)(c * NH + h) * DH * DH;
#pragma unroll
    for (int mi = 0; mi < 8; ++mi)
#pragma unroll
        for (int nj = 0; nj < 4; ++nj) { u32x2 w; w.x = cvt_pk_bf16(acc[mi][nj][0], acc[mi][nj][1]); w.y = cvt_pk_bf16(acc[mi][nj][2], acc[mi][nj][3]);
            *(u32x2*)(kc + (size_t)(128 * wr2 + 16 * mi + fr) * DH + 64 * wc2 + 16 * nj + 4 * fq) = w; }
    if (tid < DH) { float s = 0.f; for (int r = 0; r < CH; ++r) s += bf2f(*(const LAS unsigned short*)(Kt + r * RS + tid * 2)); KN[(size_t)(c * NH + h) * DH + tid] = s; }
}

__device__ __forceinline__ void mlstm_scan(const float* KC, const float* KN, const float* aprev, bf16_t* CST, float* NST, int G) {
    const int gid = fresh_bx() * NTHR + fresh_tid(), NT = G * NTHR;
    for (int p = gid; p < NH * DH * DH / 2; p += NT) {
        const int h = p / (DH * DH / 2); const size_t e2 = (size_t)(p % (DH * DH / 2)) * 2;
        float s0 = 0.f, s1 = 0.f;
#pragma unroll 1
        for (int c0 = 0; c0 < NCH; c0 += 32) {
            unsigned k[32]; float ap[32];
#pragma unroll
            for (int j = 0; j < 32; ++j) { k[j] = *(const unsigned*)((const bf16_t*)KC + (size_t)((c0 + j) * NH + h) * DH * DH + e2); ap[j] = aprev[h * 64 + c0 + j]; }
#pragma unroll
            for (int j = 0; j < 32; ++j) { const size_t o = (size_t)((c0 + j) * NH + h) * DH * DH + e2;
                *(unsigned*)(CST + o) = cvt_pk_bf16(s0, s1);
                s0 = ap[j] * s0 + bf_lo(k[j]); s1 = ap[j] * s1 + bf_hi(k[j]); }
        }
    }
    for (int p = gid; p < NH * DH; p += NT) {
        const int h = p / DH, dk = p % DH; float s = 0.f;
        for (int c = 0; c < NCH; ++c) { const size_t o = (size_t)(c * NH + h) * DH + dk; NST[o] = s; s = aprev[h * 64 + c] * s + KN[o]; }
    }
}

__device__ __forceinline__ void mlstm_D(LAS unsigned char* lds, int c, int h, const bf16_t* Z, const float* gi, const float* bcum, const float* marr, const bf16_t* CST, const float* NST,
                                        const float* hgain, bf16_t* YCAT) {
    constexpr int XOFF = 0, XBYTES = 69632, POFF = XBYTES, PRS = (CH + 8) * 2, SOFF = POFF + 8 * 16 * PRS;
    const int tid = fresh_tid(), lane = tid & 63, wave = __builtin_amdgcn_readfirstlane(tid >> 6), fr = lane & 15, fq = lane >> 4;
    LAS unsigned char* X = lds + XOFF; LAS unsigned char* Pw = lds + POFF + wave * 16 * PRS;
    LAS float* gS = (LAS float*)(lds + SOFF); LAS float* Mrow = gS + CH; LAS float* nst = Mrow + CH;
    const int t0 = c * CH; const float mc = marr[h * 65 + c];
    __syncthreads();
    if (tid < CH) gS[tid] = gi[(size_t)(t0 + tid) * 4 + h];
    else if (tid < CH + DH) nst[tid - CH] = NST[(size_t)(c * NH + h) * DH + (tid - CH)];
    __syncthreads();
    if (tid < CH) { float m = mc; for (int s = 0; s <= tid; ++s) m = fmaxf(m, gS[s]); Mrow[tid] = m; }
    stage_tile<CH, DH, 8>(X, Z + (size_t)t0 * EVN + 2048 + h * DH, EVN, tid);
    const int tl = 16 * wave + fr; const size_t trow = (size_t)(t0 + tl);
    bf16x8 aq[8];
#pragma unroll
    for (int ks = 0; ks < 8; ++ks) aq[ks] = *(const bf16x8*)(Z + trow * EVN + 1024 + h * DH + 32 * ks + 8 * fq);
    __syncthreads();
    f32x4 S[8];
#pragma unroll
    for (int j = 0; j < 8; ++j) S[j] = (f32x4){0.f, 0.f, 0.f, 0.f};
#pragma unroll
    for (int ks = 0; ks < 8; ++ks)
        {
#pragma unroll
          for (int j = 0; j < 8; ++j) if (j <= wave) S[j] = MFMA16(row_frag(X, (DH + 8) * 2, 16 * j, 32 * ks, lane), aq[ks], S[j]);
          asm volatile("" ::: "memory"); }
    float nq = 0.f;
#pragma unroll
    for (int ks = 0; ks < 8; ++ks)
#pragma unroll
        for (int e = 0; e < 8; ++e) nq += bf2f((unsigned short)aq[ks][e]) * nst[32 * ks + 8 * fq + e];
    nq += __shfl_xor(nq, 16); nq += __shfl_xor(nq, 32);
    const float Mt = Mrow[tl]; const float SC = 0.0625f; const float wi = expf(mc - Mt) * SC;
    float rsum = 0.f;
#pragma unroll
    for (int j = 0; j < 8; ++j) { float pv[4];
#pragma unroll
        for (int i = 0; i < 4; ++i) { const int s = 16 * j + 4 * fq + i; const float p = (s <= tl) ? S[j][i] * SC * expf(gS[s] - Mt) : 0.f; pv[i] = p; rsum += p; }
        u32x2 w; w.x = cvt_pk_bf16(pv[0], pv[1]); w.y = cvt_pk_bf16(pv[2], pv[3]);
        *(LAS u32x2*)(Pw + fr * PRS + (16 * j + 4 * fq) * 2) = w; }
    rsum += __shfl_xor(rsum, 16); rsum += __shfl_xor(rsum, 32);
    const float den = wi * nq + rsum;
    f32x4 acc[16];
#pragma unroll
    for (int j = 0; j < 16; ++j) acc[j] = (f32x4){0.f, 0.f, 0.f, 0.f};
    const bf16_t* cst = CST + (size_t)(c * NH + h) * DH * DH;
#pragma unroll
    for (int half = 0; half < 2; ++half) {
        __syncthreads();
        stage_tile<DH, 128, 8>(X, cst + half * 128, DH, tid);
        __syncthreads();
#pragma unroll
        for (int ks = 0; ks < 4; ++ks)
            { const bf16x8 aqh = *(const bf16x8*)(Z + trow * EVN + 1024 + h * DH + 32 * (half * 4 + ks) + 8 * fq);
#pragma unroll
              for (int j = 0; j < 16; ++j) acc[j] = MFMA16(row_frag(X, (128 + 8) * 2, 16 * j, 32 * ks, lane), aqh, acc[j]);
              asm volatile("" ::: "memory"); }
    }
#pragma unroll
    for (int j = 0; j < 16; ++j) acc[j] = acc[j] * wi;
    __syncthreads();
    stage_tile<CH, DH, 16>(X, Z + (size_t)t0 * EVN + 3072 + h * DH, EVN, tid);
    __syncthreads();
#pragma unroll 1
    for (int ks = 0; ks < 4; ++ks) { const bf16x8 ap = *(const LAS bf16x8*)(Pw + fr * PRS + (32 * ks + 8 * fq) * 2);
#pragma unroll
        for (int j = 0; j < 16; ++j) acc[j] = MFMA16(tr_frag(X, (DH + 16) * 2, 32 * ks, 16 * j, lane), ap, acc[j]); }
    const float mt = bcum[trow * 4 + h] + Mt; const float inv = 1.0f / fmaxf(fabsf(den), expf(-mt));
    float ss = 0.f;
#pragma unroll
    for (int j = 0; j < 16; ++j) { acc[j] = acc[j] * inv; ss += (acc[j][0] * acc[j][0] + acc[j][1] * acc[j][1]) + (acc[j][2] * acc[j][2] + acc[j][3] * acc[j][3]); }
    ss += __shfl_xor(ss, 16); ss += __shfl_xor(ss, 32);
    const float rs = rsqrtf(ss * (1.0f / DH) + EPS);
#pragma unroll
    for (int j = 0; j < 16; j += 2) { u32x2 ab[2];
#pragma unroll
        for (int n = 0; n < 2; ++n) { const int col = h * DH + 16 * (j + n) + 4 * fq;
            const f32x4 gn = *(const f32x4*)(hgain + col); const u32x2 ov = *(const u32x2*)(Z + trow * EVN + 4096 + col);
            const float o0 = bf_lo(ov.x), o1 = bf_hi(ov.x), o2 = bf_lo(ov.y), o3 = bf_hi(ov.y);
            const float y0 = acc[j + n][0] * rs * gn[0] / (1.0f + expf(-o0)), y1 = acc[j + n][1] * rs * gn[1] / (1.0f + expf(-o1));
            const float y2 = acc[j + n][2] * rs * gn[2] / (1.0f + expf(-o2)), y3 = acc[j + n][3] * rs * gn[3] / (1.0f + expf(-o3));
            ab[n].x = cvt_pk_bf16(y0, y1); ab[n].y = cvt_pk_bf16(y2, y3); }
        const bool odd = fq & 1; const u32x2 give = odd ? ab[0] : ab[1];
        u32x2 got; got.x = (unsigned)__shfl_xor((int)give.x, 16); got.y = (unsigned)__shfl_xor((int)give.y, 16);
        u32x4 w; if (odd) { w.x = got.x; w.y = got.y; w.z = ab[1].x; w.w = ab[1].y; } else { w.x = ab[0].x; w.y = ab[0].y; w.z = got.x; w.w = got.y; }
        *(u32x4*)(YCAT + trow * D + 1024 + h * DH + 16 * (j + (odd ? 1 : 0)) + 4 * (fq & 2)) = w; if ((j & 3) == 2) asm volatile("" ::: "memory"); }
}

__device__ __forceinline__ void pool_diffs(const bf16_t* Z, bf16_t* DP, int G) {
    const int gid = fresh_bx() * NTHR + fresh_tid(), NT = G * NTHR;
    for (int it = gid; it < T * 128; it += NT) {
        const int t = it >> 7, col = (it & 127) * 8, w = 2 << (col >> 8), cnt = (t + 1 < w) ? t + 1 : w;
        float s[8];
#pragma unroll
        for (int e = 0; e < 8; ++e) s[e] = 0.f;
        u32x4 v = (u32x4){0u, 0u, 0u, 0u};
        for (int k = cnt - 1; k >= 0; --k) { v = *(const u32x4*)(Z + (size_t)(t - k) * EVN + col);
            s[0] += bf_lo(v.x); s[1] += bf_hi(v.x); s[2] += bf_lo(v.y); s[3] += bf_hi(v.y); s[4] += bf_lo(v.z); s[5] += bf_hi(v.z); s[6] += bf_lo(v.w); s[7] += bf_hi(v.w); }
        const float ic = 1.0f / (float)cnt; u32x4 o;
        o.x = cvt_pk_bf16(s[0] * ic - bf_lo(v.x), s[1] * ic - bf_hi(v.x)); o.y = cvt_pk_bf16(s[2] * ic - bf_lo(v.y), s[3] * ic - bf_hi(v.y));
        o.z = cvt_pk_bf16(s[4] * ic - bf_lo(v.z), s[5] * ic - bf_hi(v.z)); o.w = cvt_pk_bf16(s[6] * ic - bf_lo(v.w), s[7] * ic - bf_hi(v.w));
        *(u32x4*)(DP + (size_t)t * 1024 + col) = o;
    }
}
__device__ __forceinline__ void conv_gate(const bf16_t* ZB, const bf16_t* ZC, const float* cw, bf16_t* Y, int G) {
    const int gid = fresh_bx() * NTHR + fresh_tid(), NT = G * NTHR;
    const int col = (gid & 255) * 8;
    const f32x4 wa0 = *(const f32x4*)(cw + col), wa1 = *(const f32x4*)(cw + col + 4), wb0 = *(const f32x4*)(cw + D + col), wb1 = *(const f32x4*)(cw + D + col + 4),
                wc0 = *(const f32x4*)(cw + 2 * D + col), wc1 = *(const f32x4*)(cw + 2 * D + col + 4);
    for (int it0 = gid; it0 < T * 256; it0 += 4 * NT) {
        u32x4 z0[4], z1[4], z2[4], gb[4];
#pragma unroll
        for (int k = 0; k < 4; ++k) { const int it = it0 + k * NT; const bool ok = it < T * 256; const int t = ok ? (it >> 8) : 0; const size_t o = (size_t)t * D + col;
            z0[k] = *(const u32x4*)(ZC + o); gb[k] = *(const u32x4*)(ZB + o);
            z1[k] = (t >= 1) ? *(const u32x4*)(ZC + o - D) : (u32x4){0u, 0u, 0u, 0u}; z2[k] = (t >= 2) ? *(const u32x4*)(ZC + o - 2 * D) : (u32x4){0u, 0u, 0u, 0u}; }
#pragma unroll
        for (int k = 0; k < 4; ++k) { const int it = it0 + k * NT; if (it >= T * 256) break; const size_t o = (size_t)(it >> 8) * D + col;
            float r[8];
            r[0] = bf_lo(gb[k].x) * (wa0[0] * bf_lo(z2[k].x) + wb0[0] * bf_lo(z1[k].x) + wc0[0] * bf_lo(z0[k].x)); r[1] = bf_hi(gb[k].x) * (wa0[1] * bf_hi(z2[k].x) + wb0[1] * bf_hi(z1[k].x) + wc0[1] * bf_hi(z0[k].x));
            r[2] = bf_lo(gb[k].y) * (wa0[2] * bf_lo(z2[k].y) + wb0[2] * bf_lo(z1[k].y) + wc0[2] * bf_lo(z0[k].y)); r[3] = bf_hi(gb[k].y) * (wa0[3] * bf_hi(z2[k].y) + wb0[3] * bf_hi(z1[k].y) + wc0[3] * bf_hi(z0[k].y));
            r[4] = bf_lo(gb[k].z) * (wa1[0] * bf_lo(z2[k].z) + wb1[0] * bf_lo(z1[k].z) + wc1[0] * bf_lo(z0[k].z)); r[5] = bf_hi(gb[k].z) * (wa1[1] * bf_hi(z2[k].z) + wb1[1] * bf_hi(z1[k].z) + wc1[1] * bf_hi(z0[k].z));
            r[6] = bf_lo(gb[k].w) * (wa1[2] * bf_lo(z2[k].w) + wb1[2] * bf_lo(z1[k].w) + wc1[2] * bf_lo(z0[k].w)); r[7] = bf_hi(gb[k].w) * (wa1[3] * bf_hi(z2[k].w) + wb1[3] * bf_hi(z1[k].w) + wc1[3] * bf_hi(z0[k].w));
            u32x4 w; w.x = cvt_pk_bf16(r[0], r[1]); w.y = cvt_pk_bf16(r[2], r[3]); w.z = cvt_pk_bf16(r[4], r[5]); w.w = cvt_pk_bf16(r[6], r[7]);
            *(u32x4*)(Y + o) = w; }
    }
}

__device__ __forceinline__ void xattn_unit(LAS unsigned char* lds, int hd, int qt, const bf16_t* QX, const bf16_t* KX, const bf16_t* VX, bf16_t* O) {
    constexpr int XBYTES = 73728, PRS = (NMEM + 8) * 2;
    const int tid = fresh_tid(), lane = tid & 63, wave = __builtin_amdgcn_readfirstlane(tid >> 6), fr = lane & 15, fq = lane >> 4;
    LAS unsigned char* X = lds; LAS unsigned char* Pw = lds + XBYTES + wave * 16 * PRS;
    const size_t trow = (size_t)qt * 128 + 16 * wave + fr;
    f32x4 S[16];
#pragma unroll
    for (int j = 0; j < 16; ++j) S[j] = (f32x4){0.f, 0.f, 0.f, 0.f};
    u32x4 pf[8];
    stage_load<NMEM, 128>(pf, KX + hd * XD, D, tid);
#pragma unroll 1
    for (int kc = 0; kc < 4; ++kc) {
        __syncthreads();
        stage_store<NMEM, 128, 8>(X, pf, tid);
        bf16x8 aq[4];
#pragma unroll
        for (int ks = 0; ks < 4; ++ks) aq[ks] = *(const bf16x8*)(QX + trow * D + hd * XD + kc * 128 + 32 * ks + 8 * fq);
        if (kc < 3) stage_load<NMEM, 128>(pf, KX + hd * XD + (kc + 1) * 128, D, tid);
        __syncthreads();
#pragma unroll
        for (int ks = 0; ks < 4; ++ks)
#pragma unroll
            for (int j = 0; j < 16; ++j) S[j] = MFMA16(row_frag(X, (128 + 8) * 2, 16 * j, 32 * ks, lane), aq[ks], S[j]);
    }
    float mx = -INFINITY;
#pragma unroll
    for (int j = 0; j < 16; ++j) mx = fmaxf(mx, fmaxf(fmaxf(S[j][0], S[j][1]), fmaxf(S[j][2], S[j][3])));
    mx = fmaxf(mx, __shfl_xor(mx, 16)); mx = fmaxf(mx, __shfl_xor(mx, 32));
    const float SC = 0.044194173824159216f;
    float sum = 0.f;
#pragma unroll
    for (int j = 0; j < 16; ++j) { float pv[4];
#pragma unroll
        for (int i = 0; i < 4; ++i) { pv[i] = __expf((S[j][i] - mx) * SC); sum += pv[i]; }
        u32x2 w; w.x = cvt_pk_bf16(pv[0], pv[1]); w.y = cvt_pk_bf16(pv[2], pv[3]);
        *(LAS u32x2*)(Pw + fr * PRS + (16 * j + 4 * fq) * 2) = w; }
    sum += __shfl_xor(sum, 16); sum += __shfl_xor(sum, 32);
    const float inv = 1.0f / sum;
    asm volatile("s_waitcnt lgkmcnt(0)" ::: "memory");
    stage_load<NMEM, 128>(pf, VX + hd * XD, D, tid);
    bf16x8 ap[8];
#pragma unroll
    for (int ks = 0; ks < 8; ++ks) ap[ks] = *(const LAS bf16x8*)(Pw + fr * PRS + (32 * ks + 8 * fq) * 2);
#pragma unroll 1
    for (int vc = 0; vc < 4; ++vc) {
        __syncthreads();
        stage_store<NMEM, 128, 16>(X, pf, tid);
        if (vc < 3) stage_load<NMEM, 128>(pf, VX + hd * XD + (vc + 1) * 128, D, tid);
        __syncthreads();
        f32x4 oa[8];
#pragma unroll
        for (int j = 0; j < 8; ++j) oa[j] = (f32x4){0.f, 0.f, 0.f, 0.f};
#pragma unroll
        for (int ks = 0; ks < 8; ++ks)
#pragma unroll
            for (int j = 0; j < 8; ++j) oa[j] = MFMA16(tr_frag(X, (128 + 16) * 2, 32 * ks, 16 * j, lane), ap[ks], oa[j]);
#pragma unroll
        for (int j = 0; j < 8; j += 2) { u32x2 a, b; a.x = cvt_pk_bf16(oa[j][0] * inv, oa[j][1] * inv); a.y = cvt_pk_bf16(oa[j][2] * inv, oa[j][3] * inv);
            b.x = cvt_pk_bf16(oa[j + 1][0] * inv, oa[j + 1][1] * inv); b.y = cvt_pk_bf16(oa[j + 1][2] * inv, oa[j + 1][3] * inv);
            const bool odd = fq & 1; const u32x2 give = odd ? a : b;
            u32x2 got; got.x = (unsigned)__shfl_xor((int)give.x, 16); got.y = (unsigned)__shfl_xor((int)give.y, 16);
            u32x4 w; if (odd) { w.x = got.x; w.y = got.y; w.z = b.x; w.w = b.y; } else { w.x = a.x; w.y = a.y; w.z = got.x; w.w = got.y; }
            *(u32x4*)(O + trow * D + hd * XD + vc * 128 + 16 * (j + (odd ? 1 : 0)) + 4 * (fq & 2)) = w; }
    }
}

__device__ __forceinline__ float vec_elem_f32(u32x4 v, int j) { const unsigned u = v[j]; return __builtin_bit_cast(float, u); }
__device__ __forceinline__ void glds4(const char* base, unsigned voff, unsigned lds_dst) {
    unsigned keep;
    asm volatile("s_mov_b32 %0, m0\n\ts_mov_b32 m0, %3\n\ts_nop 0\n\tglobal_load_lds_dword %1, %2\n\ts_mov_b32 m0, %0" : "=&s"(keep) : "v"(voff), "s"(base), "s"(lds_dst) : "memory");
}
struct MoeDesc { int valid, e, sl, t0, nt, cnt, slot0; const char* Ab; bf16_t* out; const float* W0; const float* W1; };
template <int MODE, int NMT, int ABL>
__device__ __forceinline__ void moe_unit(LAS unsigned char* lds, const char* Abase, u32x4 wrsrc, unsigned wsoff, int bvoff, const unsigned (&voff)[6], unsigned asb, bf16_t* out, int w, int fr, int fq, int bwoff, int bsw,
                                         const LAS unsigned char* pa0, const LAS unsigned char* pa1, const LAS unsigned char* pb0, const LAS unsigned char* pb1,
                                         int t0, int cnt, int slot0, int sl,
                                         bool pre, u32x4 (&bst)[2][4], u32x4 wrsrc_n, unsigned wsoff_n, const char* Abase_n, const LAS int* stash, unsigned kco0, unsigned kco1, const LAS float* gtab, const LAS float* rstash) {
    constexpr int K = (MODE == 2) ? DEXP : D, KS = K / 64, LDA = K, NW = (MODE == 1) ? DEXP : D, LDO = (MODE == 1) ? DEXP : D;
    constexpr int BS_OFF = 0, AS_OFF = 32768, AW = 6144;
        f32x4 acc[NMT][8];
#pragma unroll
        for (int mi = 0; mi < NMT; ++mi)
#pragma unroll
            for (int j = 0; j < 8; ++j) acc[mi][j] = (f32x4){0.f, 0.f, 0.f, 0.f};
        constexpr unsigned BSTEP = 64u * NW * 4u;
#define MOE_LOADB(set, rs, so) do { if constexpr (ABL == 2) break; const unsigned _so = (so); _Pragma("unroll") for (int kk = 0; kk < 4; ++kk) \
            asm volatile("buffer_load_dwordx4 %0, %1, %2, %3 offen" : "=v"(bst[set][kk]) : "v"(bvoff), "s"(rs), "s"(_so + (unsigned)kk * (NW * 4u)) : "memory"); } while (0)
#define MOE_WAITB(set, n) asm volatile("s_waitcnt vmcnt(%4)" : "+v"(bst[set][0]), "+v"(bst[set][1]), "+v"(bst[set][2]), "+v"(bst[set][3]) : "n"(n) : "memory")
#define MOE_DMAA(buf, step) do { if constexpr (ABL == 2) break; _Pragma("unroll") for (int q = 0; q < 2 * NMT; ++q) glds16(Abase + (size_t)(step) * 128, voff[q], asb + (unsigned)(buf) * (8 * AW) + (unsigned)q * 1024u); } while (0)
#define MOE_WRITEB(set, buf, step) do { LAS unsigned char* _b = lds + BS_OFF + (buf) * 16384; \
        if constexpr (MODE == 1) { const f32x4 _g = *(const LAS f32x4*)(gtab + (step) * 64);     \
            _Pragma("unroll") for (int j = 0; j < 4; ++j) { u32x2 o; \
                o.x = cvt_pk_bf16(vec_elem_f32(bst[set][0], j) * _g[0], vec_elem_f32(bst[set][1], j) * _g[1]); o.y = cvt_pk_bf16(vec_elem_f32(bst[set][2], j) * _g[2], vec_elem_f32(bst[set][3], j) * _g[3]); \
                *(LAS u32x2*)(_b + bwoff + j * 128 + (((bsw) ^ (((j) >> 1) & 1)) * 16)) = o; } \
        } else { \
        _Pragma("unroll") for (int j = 0; j < 4; ++j) { u32x2 o; \
            o.x = cvt_pk_bf16(vec_elem_f32(bst[set][0], j), vec_elem_f32(bst[set][1], j)); o.y = cvt_pk_bf16(vec_elem_f32(bst[set][2], j), vec_elem_f32(bst[set][3], j)); \
            *(LAS u32x2*)(_b + bwoff + j * 128 + (((bsw) ^ (((j) >> 1) & 1)) * 16)) = o; } } } while (0)
#define MOE_COMPUTE(buf) do { if constexpr (ABL == 1) break; \
        _Pragma("unroll") for (int ks = 0; ks < 2; ++ks) { bf16x8 af[NMT]; const LAS unsigned char* _pa = (ks ? pa1 : pa0) + (buf) * (8 * AW); const LAS unsigned char* _pb = (ks ? pb1 : pb0) + (buf) * 16384; \
            _Pragma("unroll") for (int mi = 0; mi < NMT; ++mi) af[mi] = *(const LAS bf16x8*)(_pa + mi * 2048); \
            _Pragma("unroll") for (int j = 0; j < 8; ++j) { const bf16x8 bf = *(const LAS bf16x8*)(_pb + j * 2048); \
                _Pragma("unroll") for (int mi = 0; mi < NMT; ++mi) acc[mi][j] = MFMA16(bf, af[mi], acc[mi][j]); } } } while (0)
        if (!pre) {
            __syncthreads();
            MOE_LOADB(0, wrsrc, wsoff); MOE_LOADB(1, wrsrc, wsoff + BSTEP); MOE_DMAA(0, 0);
            asm volatile("s_waitcnt vmcnt(0)" : "+v"(bst[0][0]), "+v"(bst[0][1]), "+v"(bst[0][2]), "+v"(bst[0][3]), "+v"(bst[1][0]), "+v"(bst[1][1]), "+v"(bst[1][2]), "+v"(bst[1][3]) :: "memory");
            MOE_WRITEB(0, 0, 0);
            asm volatile("s_waitcnt lgkmcnt(0)" ::: "memory"); __builtin_amdgcn_s_barrier(); asm volatile("" ::: "memory");
        }
#pragma unroll 1
        for (int t = 0; t < KS; t += 2) {
            const bool nb = (t + 2 >= KS);
            { const u32x4 rs = nb ? wrsrc_n : wrsrc; const unsigned so = nb ? wsoff_n : wsoff + (unsigned)(t + 2) * BSTEP;
              MOE_DMAA(1, t + 1); MOE_LOADB(0, rs, so);
              asm volatile("s_waitcnt vmcnt(%0)" :: "n"(8 + 2 * NMT) : "memory");
              MOE_COMPUTE(0);
              MOE_WAITB(1, 4 + 2 * NMT);
              MOE_WRITEB(1, 1, t + 1);
              asm volatile("s_waitcnt lgkmcnt(0)" ::: "memory"); __builtin_amdgcn_s_barrier(); asm volatile("" ::: "memory"); }
            { const u32x4 rs = nb ? wrsrc_n : wrsrc; const unsigned so = nb ? wsoff_n + BSTEP : wsoff + (unsigned)(t + 3) * BSTEP;
              if (nb) {
                  unsigned vn[6];
#pragma unroll
                  for (int q = 0; q < 6; ++q) vn[q] = (unsigned)stash[q * 64] * (unsigned)(LDA * 2) + ((q & 1) ? kco1 : kco0);
#pragma unroll
                  for (int q = 0; q < 6; ++q) if constexpr (ABL != 2) glds16(Abase_n, vn[q], asb + (unsigned)q * 1024u);
              } else MOE_DMAA(0, t + 2);
              MOE_LOADB(1, rs, so);
              asm volatile("s_waitcnt vmcnt(%0)" :: "n"(8 + 2 * NMT) : "memory");
              MOE_COMPUTE(1);
              MOE_WAITB(0, 4 + 2 * NMT);
              MOE_WRITEB(0, 0, (nb ? 0 : t + 2));
              asm volatile("s_waitcnt lgkmcnt(0)" ::: "memory"); __builtin_amdgcn_s_barrier(); asm volatile("" ::: "memory"); }
        }
        MOE_WAITB(1, 0);
#pragma unroll
        for (int mi = 0; mi < NMT; ++mi) {
            const int prow = (t0 + mi * 8 + w) * 16 + fr;
            if (prow < cnt) {
                bf16_t* op = out + (size_t)(slot0 + prow) * LDO;
                if constexpr (MODE == 1) { const float rs = rstash[mi * 64];
#pragma unroll
                    for (int pp = 0; pp < 2; ++pp) { float r[8];
#pragma unroll
                        for (int n = 0; n < 2; ++n)
#pragma unroll
                            for (int i = 0; i < 4; ++i) { const float g = acc[mi][2 * pp + n][i] * rs, up = acc[mi][4 + 2 * pp + n][i] * rs; r[4 * n + i] = (g * __builtin_amdgcn_rcpf(1.0f + __expf(-g))) * up; }
                        u32x4 o; o.x = cvt_pk_bf16(r[0], r[1]); o.y = cvt_pk_bf16(r[2], r[3]); o.z = cvt_pk_bf16(r[4], r[5]); o.w = cvt_pk_bf16(r[6], r[7]);
                        *(u32x4*)(op + sl * 64 + 32 * pp + 8 * fq) = o; }
                } else {
#pragma unroll
                    for (int pp = 0; pp < 4; ++pp) { u32x4 o; o.x = cvt_pk_bf16(acc[mi][2 * pp][0], acc[mi][2 * pp][1]); o.y = cvt_pk_bf16(acc[mi][2 * pp][2], acc[mi][2 * pp][3]);
                        o.z = cvt_pk_bf16(acc[mi][2 * pp + 1][0], acc[mi][2 * pp + 1][1]); o.w = cvt_pk_bf16(acc[mi][2 * pp + 1][2], acc[mi][2 * pp + 1][3]);
                        *(u32x4*)(op + sl * 128 + 32 * pp + 8 * fq) = o; }
                }
            }
        }
#undef MOE_LOADB
#undef MOE_WAITB
#undef MOE_DMAA
#undef MOE_WRITEB
#undef MOE_COMPUTE
}
template <int MODE, int ABL = 0>
__device__ __forceinline__ void moe_phase(LAS unsigned char* lds, const int* list, const char* Abase, const float* W0, const float* W1, bf16_t* out, int G, int c, const float* gain = nullptr, const float* rsl = nullptr) {
    constexpr int K = (MODE == 2) ? DEXP : D, KS = K / 64, LDA = K, NW = (MODE == 1) ? DEXP : D  , LDO = (MODE == 1) ? DEXP : D;
    constexpr int BS_OFF = 0, AS_OFF = 32768, AW = 6144;
    const int tid = fresh_tid(), lane = tid & 63, w = __builtin_amdgcn_readfirstlane(tid >> 6), fr = lane & 15, fq = lane >> 4;
    const LAS int* tbl = (const LAS int*)(lds + TBL_OFF);
    const unsigned ldsb = (unsigned)__builtin_amdgcn_readfirstlane((int)(unsigned)(__UINTPTR_TYPE__)lds);
    const unsigned asb = ldsb + AS_OFF + (unsigned)w * AW;
    const int NU = (MODE == 3) ? 64 : __builtin_amdgcn_readfirstlane(tbl[MOE_PT_OFF + 32]) * 16;
    const int bL = lane & 15, bn = 32 * (2 * (w & 1) + (bL >> 3)) + 16 * (bL & 1) + 4 * ((bL & 7) >> 1), bk0 = 16 * (w >> 1), bk4 = lane >> 4;
    const int bkc = 2 * (w >> 1) + (bk4 >> 1);
    const int bwoff = bn * 128 + 8 * (bk4 & 1), bsw = bkc ^ ((bn >> 1) & 7);
    const int sw0 = (fq ^ ((fr >> 1) & 7)) * 16, sw1 = sw0 ^ 64;
    const LAS unsigned char* pa0 = lds + AS_OFF + w * AW + fr * 128 + sw0; const LAS unsigned char* pa1 = lds + AS_OFF + w * AW + fr * 128 + sw1;
    const LAS unsigned char* pb0 = lds + BS_OFF + fr * 128 + sw0; const LAS unsigned char* pb1 = lds + BS_OFF + fr * 128 + sw1;
    auto desc = [&](int ui) -> MoeDesc {
        MoeDesc d; d.valid = 0; d.e = 0; d.sl = 0; d.t0 = 0; d.nt = 0; d.cnt = 1; d.slot0 = 0; d.Ab = Abase; d.out = out; d.W0 = W0; d.W1 = W1;
        if constexpr (MODE == 3) {
            const int j = ((c + G - (G >> 1)) % G) + ui * G;
            if (j < NU) { const int l = j >> 5, kv = (j >> 4) & 1; d.sl = j & 15; d.cnt = NMEM; d.nt = NMEM / 16;
                d.Ab = Abase + (size_t)l * NMEM * D * 2; d.out = out + (size_t)(kv * 2 + l) * NMEM * D; d.W0 = (kv ? W1 : W0) + (size_t)l * D * D; d.valid = 1; }
        } else {
            const long L = (long)ui * G + c;
            if (L < NU) {
                int wg = (int)L; { const int q = NU / 8, r = NU % 8, xcd = wg % 8, off = wg / 8; wg = (xcd < r ? xcd * (q + 1) : r * (q + 1) + (xcd - r) * q) + off; }
                d.sl = wg & 15;
                const int pk = __builtin_amdgcn_readfirstlane(tbl[MOE_PARTS + (wg >> 4)]); const int e = pk & 31;
                d.e = e; d.t0 = (pk >> 5) & 1023; d.nt = pk >> 15;
                d.cnt = __builtin_amdgcn_readfirstlane(tbl[33 + e]);
                d.slot0 = __builtin_amdgcn_readfirstlane(tbl[e]) * 256;
                d.valid = 1;
            }
        }
        return d;
    };
    constexpr int STASH_OFF = AS_OFF + 2 * 8 * AW;
    LAS int* stash = (LAS int*)(lds + STASH_OFF + w * 1536) + lane;
    const unsigned stash_b = ldsb + STASH_OFF + (unsigned)w * 1536u;
    const unsigned kco0 = (unsigned)(((lane & 7) ^ (lane >> 4)) * 16), kco1 = (unsigned)(((lane & 7) ^ (4 + (lane >> 4))) * 16);
    auto fill = [&](const MoeDesc& d) {
#pragma unroll
        for (int q = 0; q < 6; ++q) { int idx = (d.t0 + (q >> 1) * 8 + w) * 16 + (q & 1) * 8 + (lane >> 3); idx = idx < d.cnt ? idx : 0;
            if constexpr (MODE == 1) glds4((const char*)list, (unsigned)(d.e * LISTCAP + idx) * 4u, stash_b + (unsigned)q * 256u);
            else stash[q * 64] = d.slot0 + idx; }
    };
    constexpr int GT_OFF = STASH_OFF + 8 * 1536, RS_OFF = GT_OFF + 8192;
    LAS float* gt = (LAS float*)(lds + GT_OFF);
    const LAS float* gtab = gt + bk0 + 4 * bk4;
    const LAS float* rstash = (const LAS float*)(lds + RS_OFF + w * 768) + lane;
    const unsigned rs_b = ldsb + RS_OFF + (unsigned)w * 768u;
    if constexpr (MODE == 1) { *(LAS f32x4*)(gt + 4 * tid) = *(const f32x4*)(gain + 4 * tid); }
    auto fill_rs = [&](const MoeDesc& d) {
        if constexpr (MODE == 1) {
#pragma unroll
            for (int mi = 0; mi < 3; ++mi) { int idx = (d.t0 + mi * 8 + w) * 16 + (lane & 15); idx = idx < d.cnt ? idx : 0;
                glds4((const char*)rsl, (unsigned)(d.e * LISTCAP + idx) * 4u, rs_b + (unsigned)mi * 256u); }
        }
    };
    MoeDesc cur = desc(0);
    if (cur.valid) {
    fill(cur);
    bool pre = false; u32x4 bst[2][4];
#pragma unroll 1
    for (int ui = 0;; ++ui) {
        const MoeDesc nxt = desc(ui + 1);
        if (MODE == 1 && !pre) asm volatile("s_waitcnt vmcnt(0)" ::: "memory");
        unsigned voff[6];
#pragma unroll
        for (int q = 0; q < 6; ++q) voff[q] = (unsigned)stash[q * 64] * (unsigned)(LDA * 2) + ((q & 1) ? kco1 : kco0);
        asm volatile("s_waitcnt lgkmcnt(0)" ::: "memory");
        if (nxt.valid) fill(nxt);
        fill_rs(cur);
        const int nt = cur.nt, nmt = (nt > 16 + w) ? 3 : (nt > 8 + w) ? 2 : (nt > w) ? 1 : 0;
        const MoeDesc& dn = nxt.valid ? nxt : cur;
        const float* wmat = ((MODE == 1 && (w & 1)) ? cur.W1 : cur.W0) + (size_t)cur.e * K * NW;
        const float* wmat_n = ((MODE == 1 && (w & 1)) ? dn.W1 : dn.W0) + (size_t)dn.e * K * NW;
        const unsigned long long wa = (unsigned long long)wmat, wan = (unsigned long long)wmat_n;
        const u32x4 wrsrc = {(unsigned)__builtin_amdgcn_readfirstlane((int)(unsigned)wa), (unsigned)__builtin_amdgcn_readfirstlane((int)(unsigned)(wa >> 32)) & 0xffffu, (unsigned)(K * NW * 4), 0x00020000u};
        const u32x4 wrsrc_n = {(unsigned)__builtin_amdgcn_readfirstlane((int)(unsigned)wan), (unsigned)__builtin_amdgcn_readfirstlane((int)(unsigned)(wan >> 32)) & 0xffffu, (unsigned)(K * NW * 4), 0x00020000u};
        const unsigned wsoff = (unsigned)__builtin_amdgcn_readfirstlane((bk0 * NW + ((MODE == 1) ? cur.sl * 64 : cur.sl * 128 + 64 * (w & 1))) * 4);
        const unsigned wsoff_n = (unsigned)__builtin_amdgcn_readfirstlane((bk0 * NW + ((MODE == 1) ? dn.sl * 64 : dn.sl * 128 + 64 * (w & 1))) * 4);
        const int bvoff = (4 * bk4 * NW + 4 * (lane & 15)) * 4;
#define MOE_CALL(N) moe_unit<MODE, N, ABL>(lds, cur.Ab, wrsrc, wsoff, bvoff, voff, asb, cur.out, w, fr, fq, bwoff, bsw, pa0, pa1, pb0, pb1, cur.t0, cur.cnt, cur.slot0, cur.sl, pre, bst, wrsrc_n, wsoff_n, dn.Ab, stash, kco0, kco1, gtab, rstash)
        if constexpr (MODE == 3) MOE_CALL(2);
        else if (nmt == 3) MOE_CALL(3);
        else if (nmt == 2) MOE_CALL(2);
        else MOE_CALL(1);
#undef MOE_CALL
        if (!nxt.valid) break;
        cur = nxt; pre = true;
    }
    asm volatile("s_waitcnt vmcnt(0)" ::: "memory");
    }
}

#ifndef MK_PER_PHASE
#define MK_PER_PHASE 0
#endif
#ifndef NEWMOE
#define NEWMOE 3
#endif
#ifndef PHMASK
#define PHMASK 0x3fff
#endif
#define PH(n) (((PHMASK) >> (n)) & 1)
#ifndef REPMASK
#define REPMASK 0
#endif
#define NREP(n) ((((REPMASK) >> (n)) & 1) ? 2 : 1)
#ifndef SUBMASK
#define SUBMASK 0xff
#endif
#define SUB(n) (((SUBMASK) >> (n)) & 1)
constexpr int NPH = 27;
struct Args { const float* in[27]; float* out; unsigned char* ws; int ph_lo, ph_hi, fused, pad; };

__global__ void __launch_bounds__(NTHR, 2) mk_fwd(Args args) {
    extern __shared__ __attribute__((aligned(16))) unsigned char lds_raw[];
    LAS unsigned char* lds0 = (LAS unsigned char*)lds_raw;
    const int tid = threadIdx.x, lane = tid & 63, wave = __builtin_amdgcn_readfirstlane(tid >> 6);
    unsigned* const ctl = (unsigned*)(args.ws + WS_CTL);
    for (int u = tid; u < (LDS_BYTES - MISC_OFF) / 4; u += NTHR) ((LAS unsigned*)(lds0 + MISC_OFF))[u] = 0u;
    __syncthreads();
    XcdBarrier bar; bar.bar = ctl + CW_BAR; bar.x = 0; bar.st = nullptr;
    if (args.fused) bar = xcd_barrier_post(ctl + CW_BAR, (volatile LAS unsigned*)(lds0 + MISC_OFF));
    const int lo = args.ph_lo;
#define IN(k) (args.fused || lo == (k))
#ifdef SEAM2X
#define SEAM() do { if (args.fused) { XcdBarrier b2 = bar; asm volatile("" : "+s"(b2.bar), "+s"(b2.x)); xcd_barrier(b2); xcd_barrier(b2); xcd_barrier(b2); } } while (0)
#else
#define SEAM() do { if (args.fused) { XcdBarrier b2 = bar; asm volatile("" : "+s"(b2.bar), "+s"(b2.x)); xcd_barrier(b2); } } while (0)
#endif

#define CAS __attribute__((address_space(4)))
#define KARG() ({ const CAS char* _k = (const CAS char*)__builtin_amdgcn_kernarg_segment_ptr(); asm volatile("" : "+s"(_k)); _k; })
#define INP(k) (*(const float* const CAS*)(ka + 8 * (k)))
#define hbuf (*(float* const CAS*)(ka + 216))
#define DEF_W LAS unsigned char* lds = lds0; asm volatile("" : "+s"(lds)); const LAS int* tbl = (const LAS int*)(lds + TBL_OFF); const int bx = fresh_bx(), G = fresh_s((int)gridDim.x); const CAS char* ka = KARG(); unsigned char* ws = *(unsigned char* const CAS*)(ka + 224);
#define W_EVIN ((bf16_t*)(ws + WS_WEVIN))
#define W_EVOUT ((bf16_t*)(ws + WS_WEVOUT))
#define W_ODIN ((bf16_t*)(ws + WS_WODIN))
#define W_ODOUT ((bf16_t*)(ws + WS_WODOUT))
#define W_XQ ((bf16_t*)(ws + WS_WXQ))
#define W_XK ((bf16_t*)(ws + WS_WXK))
#define W_XV ((bf16_t*)(ws + WS_WXV))
#define W_XO ((bf16_t*)(ws + WS_WXO))
#define W_POOL ((bf16_t*)(ws + WS_WPOOL))
#define MEMN ((bf16_t*)(ws + WS_MEMN))
#define KX ((bf16_t*)(ws + WS_KX))
#define VX ((bf16_t*)(ws + WS_VX))
#define GATES ((float*)(ws + WS_SMALL + SM_GATES))
#define BCUM ((float*)(ws + WS_SMALL + SM_BCUM))
#define GI ((float*)(ws + WS_SMALL + SM_GI))
#define MARR ((float*)(ws + WS_SMALL + SM_MARR))
#define APREV ((float*)(ws + WS_SMALL + SM_APREV))
#define BLG ((float*)(ws + WS_SMALL + SM_BL))
#define KN ((float*)(ws + WS_SMALL + SM_KN))
#define NST ((float*)(ws + WS_SMALL + SM_NST))
#define HN ((bf16_t*)(ws + WS_HN))
#define Z ((bf16_t*)(ws + WS_Z))
#define YCAT ((bf16_t*)(ws + WS_YCAT))
#define DPOOL ((bf16_t*)(ws + WS_DPOOL))
#define KC ((float*)(ws + WS_KC))
#define CST ((bf16_t*)(ws + WS_CST))
#define QX ((bf16_t*)(ws + WS_QX))
#define OATT ((bf16_t*)(ws + WS_OATT))
#define HID ((bf16_t*)(ws + WS_HID))
#define H16 ((bf16_t*)(ws + WS_H16))
#define WRT ((bf16_t*)(ws + WS_WEXP))
#define YB ((bf16_t*)(ws + WS_YB))
#define LIST ((int*)(ws + WS_LIST + (size_t)layer * MiB))
#define RSTD1 ((float*)(ws + WS_WEXP + (size_t)10 * MiB))
#define RSL ((float*)(ws + WS_WEXP + (size_t)(8 + layer) * MiB))
#define TOKINFO ((int*)(ws + WS_TOKINFO + (size_t)layer * 256 * 1024))
#define WG ((const bf16_t*)(ws + WS_WEXP + (size_t)layer * WEXP_LAYER))
#define WU (WG + WEXP_MAT / 2)
#define WD (WG + WEXP_MAT)
#define x_in INP(0)
#define mem_in INP(1)
#define mix_norm INP(2)
#define xattn_norm INP(3)
#define mem_norm INP(4)
#define ffn_norm INP(5)
#define final_norm INP(6)
#define ev_w_in INP(7)
#define ev_b_gates INP(8)
#define ev_pool_w INP(9)
#define ev_pool_scale INP(10)
#define ev_head_norm INP(11)
#define ev_w_out INP(12)
#define od_w_in INP(13)
#define od_conv_w INP(14)
#define od_w_out INP(15)
#define xa_wq INP(16)
#define xa_wk INP(17)
#define xa_wv INP(18)
#define xa_wo INP(19)
#define rt_group_w INP(20)
#define rt_group_b INP(21)
#define rt_expert_w INP(22)
#define rt_expert_b INP(23)
#define ex_w_gate INP(24)
#define ex_w_up INP(25)
#define ex_w_down INP(26)

    constexpr int I_EVIN = (D / 64) * (EVN / 64), I_SQ = (D / 64) * (D / 64), I_ODIN = (D / 64) * (ODN / 64), I_POOL = 4 * 4 * 4;
    constexpr int NP_ITEMS = I_EVIN + I_POOL, NITEMS = NP_ITEMS + I_ODIN + 6 * I_SQ;
#define TRANSPOSE_ITEMS(first, stride, lo, hi) \
        for (int it = (lo) + (first); it < (hi); it += (stride)) { \
            int r = it; const float* src; int ldw, K, N; bf16_t* dst; const float* gain = nullptr; \
            if (r < I_EVIN) { src = ev_w_in; ldw = EVW; K = D; N = EVN; dst = W_EVIN; } \
            else if ((r -= I_EVIN) < I_POOL) { const int m = r / 16; r -= m * 16; src = ev_pool_w + (size_t)m * 65536; ldw = 256; K = 256; N = 256; dst = W_POOL + (size_t)m * 65536; } \
            else if ((r -= I_POOL) < I_SQ) { src = ev_w_out; ldw = D; K = D; N = D; dst = W_EVOUT; } \
            else if ((r -= I_SQ) < I_SQ) { src = xa_wq; ldw = D; K = D; N = D; dst = W_XQ; gain = xattn_norm; } \
            else if ((r -= I_SQ) < I_SQ) { src = xa_wo; ldw = D; K = D; N = D; dst = W_XO; } \
            else if ((r -= I_SQ) < I_ODIN) { src = od_w_in; ldw = ODN; K = D; N = ODN; dst = W_ODIN; gain = mix_norm + D; } \
            else if ((r -= I_ODIN) < I_SQ) { src = od_w_out; ldw = D; K = D; N = D; dst = W_ODOUT; } \
            else if ((r -= I_SQ) < I_SQ) { src = xa_wq + (size_t)D * D; ldw = D; K = D; N = D; dst = W_XQ + (size_t)D * D; gain = xattn_norm + D; } \
            else { r -= I_SQ; src = xa_wo + (size_t)D * D; ldw = D; K = D; N = D; dst = W_XO + (size_t)D * D; } \
            const int nbn = N / 64; \
            transpose_item64(src, ldw, K, dst, r / nbn, r % nbn, scr, lane, gain); }

    if (PH(13) && IN(0)) { DEF_W
        LAS float* scr = (LAS float*)(lds + wave * 16640);
        const int gw = bx * NWAVES + wave, NGW = G * NWAVES;
        for (int rep = 0; rep < NREP(13); ++rep) { TRANSPOSE_ITEMS(gw, NGW, 0, NP_ITEMS) }
        for (int r = gw; r < 2 * NMEM; r += NGW) { const int l = r >> 8, row = r & 255; const float* s = mem_in + (size_t)row * D; const float* g = mem_norm + (size_t)l * D;
            f32x4 v[8]; float ss = 0.f;
#pragma unroll
            for (int j = 0; j < 8; ++j) { v[j] = *(const f32x4*)(s + 4 * lane + 256 * j); ss += (v[j][0] * v[j][0] + v[j][1] * v[j][1]) + (v[j][2] * v[j][2] + v[j][3] * v[j][3]); }
            const float rs = rsqrtf(wave_sum(ss) * (1.0f / D) + EPS);
#pragma unroll
            for (int j = 0; j < 8; ++j) { const f32x4 gg = *(const f32x4*)(g + 4 * lane + 256 * j); const f32x4 y = v[j] * rs * gg; u32x2 w; w.x = cvt_pk_bf16(y[0], y[1]); w.y = cvt_pk_bf16(y[2], y[3]);
                *(u32x2*)(MEMN + (size_t)l * NMEM * D + (size_t)row * D + 4 * lane + 256 * j) = w; } }
        for (int idx = bx * NTHR + tid; idx < 2 * 48 * D; idx += G * NTHR) { const int l = idx / (48 * D), n = (idx / D) % 48, k = idx % D;
            float wv = 0.f;
            if (n < 32) wv = rt_expert_w[((size_t)l * D + k) * NEXP + n]; else if (n < 36) wv = rt_group_w[((size_t)l * D + k) * 4 + (n - 32)];
            wv *= ffn_norm[(size_t)l * D + k];
            const unsigned hi = cvt_pk_bf16(wv, 0.f) & 0xffffu; const float rem = wv - bf2f((unsigned short)hi); const unsigned lo = cvt_pk_bf16(rem, 0.f) & 0xffffu;
            WRT[((size_t)l * 2 + 0) * 48 * D + (size_t)n * D + k] = (bf16_t)hi; WRT[((size_t)l * 2 + 1) * 48 * D + (size_t)n * D + k] = (bf16_t)lo; }
        __syncthreads();
        RowArgs ra{}; ra.hin = x_in; ra.gain = mix_norm; ra.hn = HN; ra.wgate = ev_w_in; ra.bgate = ev_b_gates; ra.gates = GATES;
        row_phase<RM_GATES, false>(lds, ra, G);
        SEAM();
    }

    { constexpr int layer = 0;
        const int pb = 1 + 13 * layer;
#define cnt_p ((unsigned*)(ws + WS_CTL) + CW_CNT + layer * 32 * 64)
        if (PH(0) && IN(pb + 0)) { DEF_W
            for (int rep = 0; rep < NREP(0); ++rep) {
            if (layer == 0) {
                if (SUB(4)) for (int h = bx; h < NH; h += G) mlstm_prep(lds, h, GATES, BCUM, GI, MARR, APREV, BLG);
                if (SUB(0)) { pg8::DenseSched S{(const char*)HN, (size_t)256 * D * 2, 0, (const char*)W_EVIN, (const char*)W_EVIN + (size_t)128 * D * 2, (size_t)256 * D * 2, (char*)Z, EVN, T / 256, EVN / 256, G, bx};
                  pg8::EpiBf16 E{}; pg8::gemm_phase<pg8::EpiBf16, pg8::DenseSched, true>(lds, D, D, D, S, E); }
                if (SUB(1)) moe_phase<3>(lds, nullptr, (const char*)MEMN, xa_wk, xa_wv, KX, G, bx);
                if (SUB(1) && bx >= (G >> 1)) {
                    __syncthreads();
                    const int tid_ = fresh_tid(), lane = tid_ & 63, wave = __builtin_amdgcn_readfirstlane(tid_ >> 6);
                    LAS float* scr = (LAS float*)(lds + wave * 16640);
                    const int b = bx - (G >> 1), nbu = G - (G >> 1), nkv = nbu < 64 ? nbu : 64, WA = nkv * NWAVES, WB = (nbu - nkv) * NWAVES;
                    const int NL = NITEMS - NP_ITEMS, NA = (int)((long)NL * WA / (WA + 5 * WB));
                    if (b < nkv) { TRANSPOSE_ITEMS(b * NWAVES + wave, WA, NP_ITEMS, NP_ITEMS + NA) }
                    else { TRANSPOSE_ITEMS((b - nkv) * NWAVES + wave, WB, NP_ITEMS + NA, NITEMS) }
                }
            } else {
                if (SUB(2)) { pg8::DenseSched S{(const char*)H16, (size_t)256 * D * 2, 0, (const char*)W_ODIN, (const char*)W_ODIN + (size_t)128 * D * 2, (size_t)256 * D * 2, (char*)Z, D, T / 256, D / 256, G, bx};
                  pg8::EpiBf16Rs E{RSTD1}; pg8::gemm_phase<pg8::EpiBf16Rs, pg8::DenseSched, true>(lds, D, D, D, S, E); }
                if (SUB(3)) { pg8::DenseSched S{(const char*)H16, (size_t)256 * D * 2, 0, (const char*)W_ODIN + (size_t)2048 * D * 2, (const char*)W_ODIN + (size_t)4096 * D * 2, (size_t)128 * D * 2, (char*)(Z + (size_t)T * D), D, T / 256, D / 128, G, bx};
                  pg8::EpiPairRs E{RSTD1}; pg8::gemm_phase<pg8::EpiPairRs, pg8::DenseSched, true>(lds, D, D, D, S, E); }
            }
            }
            SEAM();
        }
        if (PH(1) && IN(pb + 1)) { DEF_W
            for (int rep = 0; rep < NREP(1); ++rep) {
            if (layer == 0) {
                for (int u = bx; u < NCH * NH; u += G) mlstm_B(lds, u >> 2, u & 3, Z, GI, MARR, BLG, KC, KN);
                pool_diffs(Z, DPOOL, G);
            } else conv_gate(Z, Z + (size_t)T * D, od_conv_w, YCAT, G);
            }
            SEAM();
        }
        if (PH(2) && layer == 0 && IN(pb + 2)) { DEF_W
            for (int rep = 0; rep < NREP(2); ++rep) {
            if (SUB(5)) mlstm_scan(KC, KN, APREV, CST, NST, G);
            if (SUB(6)) { pg8::DenseSched S{(const char*)DPOOL, (size_t)256 * 1024 * 2, (size_t)256 * 2, (const char*)W_POOL, (const char*)W_POOL + (size_t)128 * 256 * 2, (size_t)256 * 256 * 2, (char*)YCAT, D, T / 256, 4, G, bx};
              pg8::EpiBf16Scale E{ev_pool_scale}; pg8::gemm_phase<pg8::EpiBf16Scale, pg8::DenseSched, true>(lds, 256, 1024, 256, S, E); }
            }
            SEAM();
        }
        if (PH(3) && layer == 0 && IN(pb + 3)) { DEF_W
            for (int rep = 0; rep < NREP(3); ++rep) {
            for (int u = bx; u < NCH * NH; u += G) mlstm_D(lds, u >> 2, u & 3, Z, GI, BCUM, MARR, CST, NST, ev_head_norm, YCAT);
            }
            SEAM();
        }
        if (PH(4) && IN(pb + 4)) { DEF_W
            pg8::DenseSched S{(const char*)YCAT, (size_t)256 * D * 2, 0, (const char*)(layer == 0 ? W_EVOUT : W_ODOUT), (const char*)(layer == 0 ? W_EVOUT : W_ODOUT) + (size_t)128 * D * 2, (size_t)256 * D * 2, (char*)H16, D, T / 256, D / 256, G, bx};
            float* ssq = (float*)(ws + WS_SMALL + SM_SSQP) + (size_t)layer * T * 32;
            if (layer == 0) { pg8::EpiResSsq<false> E{(const void*)x_in, ssq}; pg8::gemm_phase<pg8::EpiResSsq<false>, pg8::DenseSched, true>(lds, D, D, D, S, E); }
            else { pg8::EpiResSsq<true> E{(const void*)H16, ssq}; pg8::gemm_phase<pg8::EpiResSsq<true>, pg8::DenseSched, true>(lds, D, D, D, S, E); }
            SEAM();
        }
        if (PH(6) && IN(pb + 6)) { DEF_W
            for (int rep = 0; rep < NREP(6); ++rep) {
            const bf16_t* W = W_XQ + (size_t)layer * D * D;
            pg8::DenseSched S{(const char*)H16, (size_t)256 * D * 2, 0, (const char*)W, (const char*)W + (size_t)128 * D * 2, (size_t)256 * D * 2, (char*)QX, D, T / 256, D / 256, G, bx};
            pg8::EpiBf16RowScale E{(const float*)(ws + WS_SMALL + SM_SSQP) + (size_t)layer * T * 32, 1.0f / D, EPS}; pg8::gemm_phase<pg8::EpiBf16RowScale, pg8::DenseSched, true>(lds, D, D, D, S, E);
            }
            SEAM();
        }
        if (PH(7) && IN(pb + 7)) { DEF_W
            for (int rep = 0; rep < NREP(7); ++rep) {
            for (int u = bx; u < XH * (T / 128); u += G) xattn_unit(lds, u & 3, u >> 2, QX, KX + (size_t)layer * NMEM * D, VX + (size_t)layer * NMEM * D, OATT);
            }
            SEAM();
        }
        if (PH(8) && IN(pb + 8)) { DEF_W
            const bf16_t* W = W_XO + (size_t)layer * D * D;
            pg8::DenseSched S{(const char*)OATT, (size_t)256 * D * 2, 0, (const char*)W, (const char*)W + (size_t)128 * D * 2, (size_t)256 * D * 2, (char*)H16, D, T / 256, D / 256, G, bx};
            pg8::EpiResSsq<true> E{(const void*)H16, nullptr}; pg8::gemm_phase<pg8::EpiResSsq<true>, pg8::DenseSched, true>(lds, D, D, D, S, E);
            SEAM();
        }
        if (PH(9) && IN(pb + 9)) { DEF_W
            RowArgs ra{}; ra.hin16 = H16; ra.gain = ffn_norm + (size_t)layer * D; ra.hn = HN;
            ra.rgw = rt_group_w + (size_t)layer * D * 4; ra.rgb = rt_group_b + layer * 4; ra.rew = rt_expert_w + (size_t)layer * D * NEXP; ra.reb = rt_expert_b + layer * NEXP;
            ra.cnt = cnt_p; ra.list = LIST; ra.tokinfo = TOKINFO; ra.wr = WRT + (size_t)layer * 2 * 48 * D; ra.rsl = RSL;
            row_phase<RM_ROUTE, false, true, false>(lds, ra, G);
            SEAM();
        }
        if (PH(10) && IN(pb + 10)) { DEF_W
            moe_tables(lds, cnt_p);
#if (NEWMOE & 1)
            moe_phase<1>(lds, LIST, (const char*)H16, ex_w_gate + (size_t)layer * NEXP * D * DEXP, ex_w_up + (size_t)layer * NEXP * D * DEXP, HID, G, bx, ffn_norm + (size_t)layer * D, RSL);
#ifdef MOE_ABLV
            if (NREP(10) > 1) moe_phase<1, MOE_ABLV>(lds, LIST, (const char*)H16, ex_w_gate + (size_t)layer * NEXP * D * DEXP, ex_w_up + (size_t)layer * NEXP * D * DEXP, YB, G, bx, ffn_norm + (size_t)layer * D, RSL);
#else
            if (NREP(10) > 1) moe_phase<1>(lds, LIST, (const char*)H16, ex_w_gate + (size_t)layer * NEXP * D * DEXP, ex_w_up + (size_t)layer * NEXP * D * DEXP, YB, G, bx, ffn_norm + (size_t)layer * D, RSL);
#endif
#else
            Moe1Sched S{tbl, LIST, (const char*)HN, (const char*)WG, (const char*)WU, (char*)HID, G, bx};
            pg8::EpiPair<true> E{}; for (int rep = 0; rep < NREP(10); ++rep) pg8::gemm_phase<pg8::EpiPair<true>, Moe1Sched, true>(lds, D, D, D, S, E);
#endif
            SEAM();
        }
        if (PH(11) && IN(pb + 11)) { DEF_W
            if (!args.fused) moe_tables(lds, cnt_p);
#if (NEWMOE & 2)
            moe_phase<2>(lds, nullptr, (const char*)HID, ex_w_down + (size_t)layer * NEXP * D * DEXP, nullptr, YB, G, bx);
#ifdef MOE_ABLV
            if (NREP(11) > 1) moe_phase<2, MOE_ABLV>(lds, nullptr, (const char*)HID, ex_w_down + (size_t)layer * NEXP * D * DEXP, nullptr, Z, G, bx);
#else
            if (NREP(11) > 1) moe_phase<2>(lds, nullptr, (const char*)HID, ex_w_down + (size_t)layer * NEXP * D * DEXP, nullptr, Z, G, bx);
#endif
#else
            Moe2Sched S{tbl, (const char*)HID, (const char*)WD, (char*)YB, G, bx};
            pg8::EpiBf16 E{}; for (int rep = 0; rep < NREP(11); ++rep) pg8::gemm_phase<pg8::EpiBf16, Moe2Sched, true>(lds, DEXP, DEXP, DEXP, S, E);
#endif
            SEAM();
        }
        if (PH(12) && IN(pb + 12)) { DEF_W
            if (!args.fused) moe_tables(lds, cnt_p);
            if (layer == 0) { combine_phase<false>(lds, H16, YB, TOKINFO, nullptr, RSTD1, nullptr, G); SEAM(); }
            else combine_phase<true>(lds, H16, YB, TOKINFO, final_norm, nullptr, hbuf, G);
        }
    }
    { constexpr int layer = 1;
        const int pb = 1 + 13 * layer;
#define cnt_p ((unsigned*)(ws + WS_CTL) + CW_CNT + layer * 32 * 64)
        if (PH(0) && IN(pb + 0)) { DEF_W
            for (int rep = 0; rep < NREP(0); ++rep) {
            if (layer == 0) {
                if (SUB(4)) for (int h = bx; h < NH; h += G) mlstm_prep(lds, h, GATES, BCUM, GI, MARR, APREV, BLG);
                if (SUB(0)) { pg8::DenseSched S{(const char*)HN, (size_t)256 * D * 2, 0, (const char*)W_EVIN, (const char*)W_EVIN + (size_t)128 * D * 2, (size_t)256 * D * 2, (char*)Z, EVN, T / 256, EVN / 256, G, bx};
                  pg8::EpiBf16 E{}; pg8::gemm_phase<pg8::EpiBf16, pg8::DenseSched, true>(lds, D, D, D, S, E); }
                if (SUB(1)) moe_phase<3>(lds, nullptr, (const char*)MEMN, xa_wk, xa_wv, KX, G, bx);
                if (SUB(1) && bx >= (G >> 1)) {
                    __syncthreads();
                    const int tid_ = fresh_tid(), lane = tid_ & 63, wave = __builtin_amdgcn_readfirstlane(tid_ >> 6);
                    LAS float* scr = (LAS float*)(lds + wave * 16640);
                    const int b = bx - (G >> 1), nbu = G - (G >> 1), nkv = nbu < 64 ? nbu : 64, WA = nkv * NWAVES, WB = (nbu - nkv) * NWAVES;
                    const int NL = NITEMS - NP_ITEMS, NA = (int)((long)NL * WA / (WA + 5 * WB));
                    if (b < nkv) { TRANSPOSE_ITEMS(b * NWAVES + wave, WA, NP_ITEMS, NP_ITEMS + NA) }
                    else { TRANSPOSE_ITEMS((b - nkv) * NWAVES + wave, WB, NP_ITEMS + NA, NITEMS) }
                }
            } else {
                if (SUB(2)) { pg8::DenseSched S{(const char*)H16, (size_t)256 * D * 2, 0, (const char*)W_ODIN, (const char*)W_ODIN + (size_t)128 * D * 2, (size_t)256 * D * 2, (char*)Z, D, T / 256, D / 256, G, bx};
                  pg8::EpiBf16Rs E{RSTD1}; pg8::gemm_phase<pg8::EpiBf16Rs, pg8::DenseSched, true>(lds, D, D, D, S, E); }
                if (SUB(3)) { pg8::DenseSched S{(const char*)H16, (size_t)256 * D * 2, 0, (const char*)W_ODIN + (size_t)2048 * D * 2, (const char*)W_ODIN + (size_t)4096 * D * 2, (size_t)128 * D * 2, (char*)(Z + (size_t)T * D), D, T / 256, D / 128, G, bx};
                  pg8::EpiPairRs E{RSTD1}; pg8::gemm_phase<pg8::EpiPairRs, pg8::DenseSched, true>(lds, D, D, D, S, E); }
            }
            }
            SEAM();
        }
        if (PH(1) && IN(pb + 1)) { DEF_W
            for (int rep = 0; rep < NREP(1); ++rep) {
            if (layer == 0) {
                for (int u = bx; u < NCH * NH; u += G) mlstm_B(lds, u >> 2, u & 3, Z, GI, MARR, BLG, KC, KN);
                pool_diffs(Z, DPOOL, G);
            } else conv_gate(Z, Z + (size_t)T * D, od_conv_w, YCAT, G);
            }
            SEAM();
        }
        if (PH(2) && layer == 0 && IN(pb + 2)) { DEF_W
            for (int rep = 0; rep < NREP(2); ++rep) {
            if (SUB(5)) mlstm_scan(KC, KN, APREV, CST, NST, G);
            if (SUB(6)) { pg8::DenseSched S{(const char*)DPOOL, (size_t)256 * 1024 * 2, (size_t)256 * 2, (const char*)W_POOL, (const char*)W_POOL + (size_t)128 * 256 * 2, (size_t)256 * 256 * 2, (char*)YCAT, D, T / 256, 4, G, bx};
              pg8::EpiBf16Scale E{ev_pool_scale}; pg8::gemm_phase<pg8::EpiBf16Scale, pg8::DenseSched, true>(lds, 256, 1024, 256, S, E); }
            }
            SEAM();
        }
        if (PH(3) && layer == 0 && IN(pb + 3)) { DEF_W
            for (int rep = 0; rep < NREP(3); ++rep) {
            for (int u = bx; u < NCH * NH; u += G) mlstm_D(lds, u >> 2, u & 3, Z, GI, BCUM, MARR, CST, NST, ev_head_norm, YCAT);
            }
            SEAM();
        }
        if (PH(4) && IN(pb + 4)) { DEF_W
            pg8::DenseSched S{(const char*)YCAT, (size_t)256 * D * 2, 0, (const char*)(layer == 0 ? W_EVOUT : W_ODOUT), (const char*)(layer == 0 ? W_EVOUT : W_ODOUT) + (size_t)128 * D * 2, (size_t)256 * D * 2, (char*)H16, D, T / 256, D / 256, G, bx};
            float* ssq = (float*)(ws + WS_SMALL + SM_SSQP) + (size_t)layer * T * 32;
            if (layer == 0) { pg8::EpiResSsq<false> E{(const void*)x_in, ssq}; pg8::gemm_phase<pg8::EpiResSsq<false>, pg8::DenseSched, true>(lds, D, D, D, S, E); }
            else { pg8::EpiResSsq<true> E{(const void*)H16, ssq}; pg8::gemm_phase<pg8::EpiResSsq<true>, pg8::DenseSched, true>(lds, D, D, D, S, E); }
            SEAM();
        }
        if (PH(6) && IN(pb + 6)) { DEF_W
            for (int rep = 0; rep < NREP(6); ++rep) {
            const bf16_t* W = W_XQ + (size_t)layer * D * D;
            pg8::DenseSched S{(const char*)H16, (size_t)256 * D * 2, 0, (const char*)W, (const char*)W + (size_t)128 * D * 2, (size_t)256 * D * 2, (char*)QX, D, T / 256, D / 256, G, bx};
            pg8::EpiBf16RowScale E{(const float*)(ws + WS_SMALL + SM_SSQP) + (size_t)layer * T * 32, 1.0f / D, EPS}; pg8::gemm_phase<pg8::EpiBf16RowScale, pg8::DenseSched, true>(lds, D, D, D, S, E);
            }
            SEAM();
        }
        if (PH(7) && IN(pb + 7)) { DEF_W
            for (int rep = 0; rep < NREP(7); ++rep) {
            for (int u = bx; u < XH * (T / 128); u += G) xattn_unit(lds, u & 3, u >> 2, QX, KX + (size_t)layer * NMEM * D, VX + (size_t)layer * NMEM * D, OATT);
            }
            SEAM();
        }
        if (PH(8) && IN(pb + 8)) { DEF_W
            const bf16_t* W = W_XO + (size_t)layer * D * D;
            pg8::DenseSched S{(const char*)OATT, (size_t)256 * D * 2, 0, (const char*)W, (const char*)W + (size_t)128 * D * 2, (size_t)256 * D * 2, (char*)H16, D, T / 256, D / 256, G, bx};
            pg8::EpiResSsq<true> E{(const void*)H16, nullptr}; pg8::gemm_phase<pg8::EpiResSsq<true>, pg8::DenseSched, true>(lds, D, D, D, S, E);
            SEAM();
        }
        if (PH(9) && IN(pb + 9)) { DEF_W
            RowArgs ra{}; ra.hin16 = H16; ra.gain = ffn_norm + (size_t)layer * D; ra.hn = HN;
            ra.rgw = rt_group_w + (size_t)layer * D * 4; ra.rgb = rt_group_b + layer * 4; ra.rew = rt_expert_w + (size_t)layer * D * NEXP; ra.reb = rt_expert_b + layer * NEXP;
            ra.cnt = cnt_p; ra.list = LIST; ra.tokinfo = TOKINFO; ra.wr = WRT + (size_t)layer * 2 * 48 * D; ra.rsl = RSL;
            row_phase<RM_ROUTE, false, true, false>(lds, ra, G);
            SEAM();
        }
        if (PH(10) && IN(pb + 10)) { DEF_W
            moe_tables(lds, cnt_p);
#if (NEWMOE & 1)
            moe_phase<1>(lds, LIST, (const char*)H16, ex_w_gate + (size_t)layer * NEXP * D * DEXP, ex_w_up + (size_t)layer * NEXP * D * DEXP, HID, G, bx, ffn_norm + (size_t)layer * D, RSL);
#ifdef MOE_ABLV
            if (NREP(10) > 1) moe_phase<1, MOE_ABLV>(lds, LIST, (const char*)H16, ex_w_gate + (size_t)layer * NEXP * D * DEXP, ex_w_up + (size_t)layer * NEXP * D * DEXP, YB, G, bx, ffn_norm + (size_t)layer * D, RSL);
#else
            if (NREP(10) > 1) moe_phase<1>(lds, LIST, (const char*)H16, ex_w_gate + (size_t)layer * NEXP * D * DEXP, ex_w_up + (size_t)layer * NEXP * D * DEXP, YB, G, bx, ffn_norm + (size_t)layer * D, RSL);
#endif
#else
            Moe1Sched S{tbl, LIST, (const char*)HN, (const char*)WG, (const char*)WU, (char*)HID, G, bx};
            pg8::EpiPair<true> E{}; for (int rep = 0; rep < NREP(10); ++rep) pg8::gemm_phase<pg8::EpiPair<true>, Moe1Sched, true>(lds, D, D, D, S, E);
#endif
            SEAM();
        }
        if (PH(11) && IN(pb + 11)) { DEF_W
            if (!args.fused) moe_tables(lds, cnt_p);
#if (NEWMOE & 2)
            moe_phase<2>(lds, nullptr, (const char*)HID, ex_w_down + (size_t)layer * NEXP * D * DEXP, nullptr, YB, G, bx);
#ifdef MOE_ABLV
            if (NREP(11) > 1) moe_phase<2, MOE_ABLV>(lds, nullptr, (const char*)HID, ex_w_down + (size_t)layer * NEXP * D * DEXP, nullptr, Z, G, bx);
#else
            if (NREP(11) > 1) moe_phase<2>(lds, nullptr, (const char*)HID, ex_w_down + (size_t)layer * NEXP * D * DEXP, nullptr, Z, G, bx);
#endif
#else
            Moe2Sched S{tbl, (const char*)HID, (const char*)WD, (char*)YB, G, bx};
            pg8::EpiBf16 E{}; for (int rep = 0; rep < NREP(11); ++rep) pg8::gemm_phase<pg8::EpiBf16, Moe2Sched, true>(lds, DEXP, DEXP, DEXP, S, E);
#endif
            SEAM();
        }
        if (PH(12) && IN(pb + 12)) { DEF_W
            if (!args.fused) moe_tables(lds, cnt_p);
            if (layer == 0) { combine_phase<false>(lds, H16, YB, TOKINFO, nullptr, RSTD1, nullptr, G); SEAM(); }
            else combine_phase<true>(lds, H16, YB, TOKINFO, final_norm, nullptr, hbuf, G);
        }
    }
#undef IN
#undef SEAM
#undef KARG
#undef hbuf
#undef INP
#undef DEF_W
#undef W_EVIN
#undef W_EVOUT
#undef W_ODIN
#undef W_ODOUT
#undef W_XQ
#undef W_XK
#undef W_XV
#undef W_XO
#undef W_POOL
#undef MEMN
#undef KX
#undef VX
#undef GATES
#undef BCUM
#undef GI
#undef MARR
#undef APREV
#undef BLG
#undef KN
#undef NST
#undef HN
#undef Z
#undef YCAT
#undef DPOOL
#undef KC
#undef CST
#undef QX
#undef OATT
#undef HID
#undef H16
#undef WRT
#undef YB
#undef LIST
#undef RSL
#undef RSTD1
#undef TOKINFO
#undef WG
#undef WU
#undef WD
#undef cnt_p
#undef x_in
#undef mem_in
#undef mix_norm
#undef xattn_norm
#undef mem_norm
#undef ffn_norm
#undef final_norm
#undef ev_w_in
#undef ev_b_gates
#undef ev_pool_w
#undef ev_pool_scale
#undef ev_head_norm
#undef ev_w_out
#undef od_w_in
#undef od_conv_w
#undef od_w_out
#undef xa_wq
#undef xa_wk
#undef xa_wv
#undef xa_wo
#undef rt_group_w
#undef rt_group_b
#undef rt_expert_w
#undef rt_expert_b
#undef ex_w_gate
#undef ex_w_up
#undef ex_w_down
}

extern "C" void kernel_launch(void* const* d_in, const int* in_sizes, int n_in, void* d_out, int out_size, void* d_ws, size_t ws_size, hipStream_t stream) {
    static int grid = 0;
    if (grid == 0) {
        if (n_in != 27 || in_sizes[0] != T * D || out_size != T * D || ws_size < WS_END) { fprintf(stderr, "kernel_launch: unexpected shapes (n_in %d, in0 %d, out %d, ws %zu < %zu); nothing launched\n", n_in, n_in > 0 ? in_sizes[0] : -1, out_size, ws_size, (size_t)WS_END); grid = -1; return; }
        int dev = 0, cus = 0, per_cu = 0;
        if (hipGetDevice(&dev) != hipSuccess || hipDeviceGetAttribute(&cus, hipDeviceAttributeMultiprocessorCount, dev) != hipSuccess) { fprintf(stderr, "kernel_launch: device query failed\n"); grid = -1; return; }
        if (hipFuncSetAttribute((const void*)mk_fwd, hipFuncAttributeMaxDynamicSharedMemorySize, LDS_BYTES) != hipSuccess) { fprintf(stderr, "kernel_launch: hipFuncSetAttribute(%d B LDS) failed\n", LDS_BYTES); grid = -1; return; }
        if (hipOccupancyMaxActiveBlocksPerMultiprocessor(&per_cu, (const void*)mk_fwd, NTHR, LDS_BYTES) != hipSuccess || per_cu < 1) fprintf(stderr, "kernel_launch: note: occupancy query reports %d workgroups per CU\n", per_cu);
        (void)hipGetLastError();
        grid = cus;
    }
    if (grid < 0) return;
    if (hipMemsetAsync((char*)d_ws + WS_CTL, 0, CTL_ZERO_BYTES, stream) != hipSuccess) { fprintf(stderr, "kernel_launch: memset failed\n"); return; }
    Args a{};
    for (int i = 0; i < 27; ++i) a.in[i] = (const float*)d_in[i];
    a.out = (float*)d_out; a.ws = (unsigned char*)d_ws;
#if MK_PER_PHASE
    for (int p = 0; p < NPH; ++p) {
        if (p == 16 || p == 17) continue;
        a.ph_lo = p; a.ph_hi = p + 1; a.fused = 0;
        hipLaunchKernelGGL(mk_fwd, dim3(grid), dim3(NTHR), LDS_BYTES, stream, a);
    }
#else
    a.ph_lo = 0; a.ph_hi = NPH; a.fused = 1;
    hipLaunchKernelGGL(mk_fwd, dim3(grid), dim3(NTHR), LDS_BYTES, stream, a);
#endif
    const hipError_t le = hipPeekAtLastError();
    if (le != hipSuccess) fprintf(stderr, "kernel_launch: launch failed: %s (grid %d)\n", hipGetErrorName(le), grid);
}
```

```cpp
#include <hip/hip_runtime.h>
#include <cstdio>
#include <cstdint>

#define LAS __attribute__((address_space(3)))
typedef unsigned short bf16_t;
typedef short bf16x8 __attribute__((ext_vector_type(8)));
typedef short s16x4 __attribute__((ext_vector_type(4)));
typedef short v4i16_t __attribute__((ext_vector_type(4)));
typedef float f32x4 __attribute__((ext_vector_type(4)));
typedef float f32x2 __attribute__((ext_vector_type(2)));
typedef unsigned u32x4 __attribute__((ext_vector_type(4)));
typedef unsigned u32x2 __attribute__((ext_vector_type(2)));

__device__ __forceinline__ unsigned cvt_pk_bf16(float lo, float hi) { unsigned r; asm volatile("v_cvt_pk_bf16_f32 %0, %1, %2" : "=v"(r) : "v"(lo), "v"(hi)); return r; }
__device__ __forceinline__ float bf_lo(unsigned u) { return __builtin_bit_cast(float, u << 16); }
__device__ __forceinline__ float bf_hi(unsigned u) { return __builtin_bit_cast(float, u & 0xffff0000u); }
__device__ __forceinline__ float bf2f(unsigned short b) { return __builtin_bit_cast(float, ((unsigned)b) << 16); }

__device__ __forceinline__ int fresh_tid() { int t = threadIdx.x; asm volatile("" : "+v"(t)); return t; }
__device__ __forceinline__ int fresh_bx() { int t = blockIdx.x; asm volatile("" : "+s"(t)); return t; }
__device__ __forceinline__ int fresh_s(int t) { asm volatile("" : "+s"(t)); return t; }
__device__ __forceinline__ void glds16(const char* base, unsigned voff, unsigned lds_dst) {
    unsigned keep;
    asm volatile("s_mov_b32 %0, m0\n\ts_mov_b32 m0, %3\n\ts_nop 0\n\tglobal_load_lds_dwordx4 %1, %2\n\ts_mov_b32 m0, %0" : "=&s"(keep) : "v"(voff), "s"(base), "s"(lds_dst) : "memory");
}
namespace pg8 {
constexpr int BM = 256, BK = 64, HALF = 128, HTB = HALF * BK * 2  , STAGE_BYTES = 8 * HTB, NXCD = 8, WGM = 8;
__host__ __device__ __forceinline__ int lds_byte(int r, int c) { const int st = (r >> 4) * 2 + (c >> 5), rr = r & 15, cc = c & 31, ob = rr * 64 + cc * 2; return st * 1024 + (ob ^ (((ob >> 9) & 1) << 5)); }
__host__ __device__ __forceinline__ void stage_rc(int b, int& R, int& C) { const int st = b / 1024, sb = b % 1024, swz = sb ^ (((sb >> 9) & 1) << 5); R = (st >> 1) * 16 + swz / 64; C = (st & 1) * 32 + (swz % 64) / 2; }
__host__ __device__ __forceinline__ int perm32(int rho) { const int n = rho >> 4, i = rho & 15; return 8 * (i >> 2) + 4 * n + (i & 3); }

struct Unit { const char* a; const char* b0; const char* b1; char* out; int ldc, pm, pn, e; };

__device__ __forceinline__ bool tile_of(int i, int G, int c, int nM, int nN, int& pm, int& pn) {
    const int nwg = nM * nN; const long L = (long)i * G + c; if (L >= nwg) return false;
    int wgid = (int)L; { const int q = nwg / NXCD, r = nwg % NXCD, xcd = wgid % NXCD, off = wgid / NXCD; wgid = (xcd < r ? xcd * (q + 1) : r * (q + 1) + (xcd - r) * q) + off; }
    const int nig = WGM * nN, gid = wgid / nig, fm = gid * WGM, gsz = (nM - fm) < WGM ? (nM - fm) : WGM;
    pm = fm + ((wgid % nig) % gsz); pn = (wgid % nig) / gsz; return true;
}
struct DenseSched {
    static constexpr bool GATHER = false;
    const char* A; size_t a_mstep, a_nstep; const char* B0; const char* B1; size_t b_nstep; char* out; int ldc, nM, nN, G, c;
    __device__ __forceinline__ bool next(int i, Unit& u) const {
        int pm, pn; if (!tile_of(i, G, c, nM, nN, pm, pn)) return false;
        u.a = A + (size_t)pm * a_mstep + (size_t)pn * a_nstep; u.b0 = B0 + (size_t)pn * b_nstep; u.b1 = B1 + (size_t)pn * b_nstep; u.out = out; u.ldc = ldc; u.pm = pm; u.pn = pn; u.e = 0; return true;
    }
    __device__ __forceinline__ int arow(const Unit&, int r) const { return r; }
};

struct EpiBf16 {
    static constexpr bool PERM = true;
    __device__ __forceinline__ void operator()(const f32x4 (&acc)[2][2][4][2], const Unit& u, int wr, int wc, int fr, int fq) const {
        bf16_t* base = (bf16_t*)u.out; const int row0 = u.pm * BM + wr * 64 + fr, col0 = u.pn * BM + wc * 32 + 8 * fq;
#pragma unroll
        for (int ai = 0; ai < 2; ++ai)
#pragma unroll
            for (int m = 0; m < 4; ++m) { bf16_t* rowp = base + (size_t)(row0 + ai * HALF + m * 16) * u.ldc + col0;
#pragma unroll
                for (int bj = 0; bj < 2; ++bj) { const f32x4 v0 = acc[ai][bj][m][0], v1 = acc[ai][bj][m][1];
                    u32x4 w; w.x = cvt_pk_bf16(v0[0], v0[1]); w.y = cvt_pk_bf16(v0[2], v0[3]); w.z = cvt_pk_bf16(v1[0], v1[1]); w.w = cvt_pk_bf16(v1[2], v1[3]);
                    *(u32x4*)(rowp + bj * HALF) = w; } }
    }
};
struct EpiBf16Scale {
    static constexpr bool PERM = true;
    const float* scale;
    __device__ __forceinline__ void operator()(const f32x4 (&acc)[2][2][4][2], const Unit& u, int wr, int wc, int fr, int fq) const {
        bf16_t* base = (bf16_t*)u.out; const int row0 = u.pm * BM + wr * 64 + fr, col0 = u.pn * BM + wc * 32 + 8 * fq;
        f32x4 sv[2][2];
#pragma unroll
        for (int bj = 0; bj < 2; ++bj)
#pragma unroll
            for (int n = 0; n < 2; ++n) sv[bj][n] = *(const f32x4*)(scale + col0 + bj * HALF + 4 * n);
#pragma unroll
        for (int ai = 0; ai < 2; ++ai)
#pragma unroll
            for (int m = 0; m < 4; ++m) { bf16_t* rowp = base + (size_t)(row0 + ai * HALF + m * 16) * u.ldc + col0;
#pragma unroll
                for (int bj = 0; bj < 2; ++bj) { const f32x4 v0 = acc[ai][bj][m][0] * sv[bj][0], v1 = acc[ai][bj][m][1] * sv[bj][1];
                    u32x4 w; w.x = cvt_pk_bf16(v0[0], v0[1]); w.y = cvt_pk_bf16(v0[2], v0[3]); w.z = cvt_pk_bf16(v1[0], v1[1]); w.w = cvt_pk_bf16(v1[2], v1[3]);
                    *(u32x4*)(rowp + bj * HALF) = w; } }
    }
};
template <bool SILU> struct EpiPair {
    static constexpr bool PERM = true;
    __device__ __forceinline__ void operator()(const f32x4 (&acc)[2][2][4][2], const Unit& u, int wr, int wc, int fr, int fq) const {
        bf16_t* base = (bf16_t*)u.out; const int row0 = u.pm * BM + wr * 64 + fr, col0 = u.pn * HALF + wc * 32 + 8 * fq;
#pragma unroll
        for (int ai = 0; ai < 2; ++ai)
#pragma unroll
            for (int m = 0; m < 4; ++m) { bf16_t* rowp = base + (size_t)(row0 + ai * HALF + m * 16) * u.ldc + col0;
                float r[8];
#pragma unroll
                for (int n = 0; n < 2; ++n)
#pragma unroll
                    for (int j = 0; j < 4; ++j) { const float g = acc[ai][0][m][n][j], up = acc[ai][1][m][n][j];
                        r[n * 4 + j] = SILU ? (g * __builtin_amdgcn_rcpf(1.0f + __expf(-g))) * up : g * up; }
                u32x4 w; w.x = cvt_pk_bf16(r[0], r[1]); w.y = cvt_pk_bf16(r[2], r[3]); w.z = cvt_pk_bf16(r[4], r[5]); w.w = cvt_pk_bf16(r[6], r[7]);
                *(u32x4*)rowp = w; }
    }
};
struct EpiRes {
    static constexpr bool PERM = false;
    const float* res;
    __device__ __forceinline__ void operator()(const f32x4 (&acc)[2][2][4][2], const Unit& u, int wr, int wc, int fr, int fq) const {
        float* base = (float*)u.out; const int row0 = u.pm * BM + wr * 64 + fr, col0 = u.pn * BM + wc * 32 + 4 * fq;
#pragma unroll
        for (int ai = 0; ai < 2; ++ai)
#pragma unroll
            for (int m = 0; m < 4; ++m) { const size_t ro = (size_t)(row0 + ai * HALF + m * 16) * u.ldc + col0;
                f32x4 rv[2][2];
#pragma unroll
                for (int bj = 0; bj < 2; ++bj)
#pragma unroll
                    for (int n = 0; n < 2; ++n) rv[bj][n] = *(const f32x4*)(res + ro + bj * HALF + n * 16);
#pragma unroll
                for (int bj = 0; bj < 2; ++bj)
#pragma unroll
                    for (int n = 0; n < 2; ++n) *(f32x4*)(base + ro + bj * HALF + n * 16) = acc[ai][bj][m][n] + rv[bj][n]; }
    }
};

template <bool RES16> struct EpiResSsq {
    static constexpr bool PERM = true;
    const void* res; float* ssq;
    __device__ __forceinline__ void operator()(const f32x4 (&acc)[2][2][4][2], const Unit& u, int wr, int wc, int fr, int fq) const {
        bf16_t* base = (bf16_t*)u.out; const int row0 = u.pm * BM + wr * 64 + fr, col0 = u.pn * BM + wc * 32 + 8 * fq;
#pragma unroll
        for (int ai = 0; ai < 2; ++ai)
#pragma unroll
            for (int m = 0; m < 4; ++m) { const int row = row0 + ai * HALF + m * 16; const size_t ro = (size_t)row * u.ldc + col0;
                f32x4 rv[2][2];
#pragma unroll
                for (int bj = 0; bj < 2; ++bj) {
                    if constexpr (RES16) { const u32x4 t = *(const u32x4*)((const bf16_t*)res + ro + bj * HALF);
                        rv[bj][0] = (f32x4){bf_lo(t.x), bf_hi(t.x), bf_lo(t.y), bf_hi(t.y)}; rv[bj][1] = (f32x4){bf_lo(t.z), bf_hi(t.z), bf_lo(t.w), bf_hi(t.w)}; }
                    else { rv[bj][0] = *(const f32x4*)((const float*)res + ro + bj * HALF); rv[bj][1] = *(const f32x4*)((const float*)res + ro + bj * HALF + 4); } }
                float s = 0.f;
#pragma unroll
                for (int bj = 0; bj < 2; ++bj) { const f32x4 v0 = acc[ai][bj][m][0] + rv[bj][0], v1 = acc[ai][bj][m][1] + rv[bj][1];
                    u32x4 w; w.x = cvt_pk_bf16(v0[0], v0[1]); w.y = cvt_pk_bf16(v0[2], v0[3]); w.z = cvt_pk_bf16(v1[0], v1[1]); w.w = cvt_pk_bf16(v1[2], v1[3]);
                    *(u32x4*)(base + ro + bj * HALF) = w;
                    s += ((v0[0] * v0[0] + v0[1] * v0[1]) + (v0[2] * v0[2] + v0[3] * v0[3])) + ((v1[0] * v1[0] + v1[1] * v1[1]) + (v1[2] * v1[2] + v1[3] * v1[3])); }
                if (ssq) { s += __shfl_xor(s, 16); s += __shfl_xor(s, 32);
                    if (fq == 0) ssq[(size_t)row * 32 + u.pn * 4 + wc] = s; } }
    }
};
struct EpiBf16RowScale {
    static constexpr bool PERM = true;
    const float* ssq; float inv_n, eps;
    __device__ __forceinline__ void operator()(const f32x4 (&acc)[2][2][4][2], const Unit& u, int wr, int wc, int fr, int fq) const {
        bf16_t* base = (bf16_t*)u.out; const int row0 = u.pm * BM + wr * 64 + fr, col0 = u.pn * BM + wc * 32 + 8 * fq;
#pragma unroll
        for (int ai = 0; ai < 2; ++ai)
#pragma unroll
            for (int m = 0; m < 4; ++m) { const int row = row0 + ai * HALF + m * 16; bf16_t* rowp = base + (size_t)row * u.ldc + col0;
                const f32x4 pa = *(const f32x4*)(ssq + (size_t)row * 32 + 8 * fq), pb = *(const f32x4*)(ssq + (size_t)row * 32 + 8 * fq + 4);
                float ps = ((pa[0] + pa[1]) + (pa[2] + pa[3])) + ((pb[0] + pb[1]) + (pb[2] + pb[3]));
                ps += __shfl_xor(ps, 16); ps += __shfl_xor(ps, 32);
                const float rs = rsqrtf(ps * inv_n + eps);
#pragma unroll
                for (int bj = 0; bj < 2; ++bj) { const f32x4 v0 = acc[ai][bj][m][0] * rs, v1 = acc[ai][bj][m][1] * rs;
                    u32x4 w; w.x = cvt_pk_bf16(v0[0], v0[1]); w.y = cvt_pk_bf16(v0[2], v0[3]); w.z = cvt_pk_bf16(v1[0], v1[1]); w.w = cvt_pk_bf16(v1[2], v1[3]);
                    *(u32x4*)(rowp + bj * HALF) = w; } }
    }
};

struct EpiBf16Rs {
    static constexpr bool PERM = true;
    const float* rs;
    __device__ __forceinline__ void operator()(const f32x4 (&acc)[2][2][4][2], const Unit& u, int wr, int wc, int fr, int fq) const {
        bf16_t* base = (bf16_t*)u.out; const int row0 = u.pm * BM + wr * 64 + fr, col0 = u.pn * BM + wc * 32 + 8 * fq;
#pragma unroll
        for (int ai = 0; ai < 2; ++ai)
#pragma unroll
            for (int m = 0; m < 4; ++m) { const int row = row0 + ai * HALF + m * 16; bf16_t* rowp = base + (size_t)row * u.ldc + col0; const float r = rs[row];
#pragma unroll
                for (int bj = 0; bj < 2; ++bj) { const f32x4 v0 = acc[ai][bj][m][0] * r, v1 = acc[ai][bj][m][1] * r;
                    u32x4 w; w.x = cvt_pk_bf16(v0[0], v0[1]); w.y = cvt_pk_bf16(v0[2], v0[3]); w.z = cvt_pk_bf16(v1[0], v1[1]); w.w = cvt_pk_bf16(v1[2], v1[3]);
                    *(u32x4*)(rowp + bj * HALF) = w; } }
    }
};
struct EpiPairRs {
    static constexpr bool PERM = true;
    const float* rs;
    __device__ __forceinline__ void operator()(const f32x4 (&acc)[2][2][4][2], const Unit& u, int wr, int wc, int fr, int fq) const {
        bf16_t* base = (bf16_t*)u.out; const int row0 = u.pm * BM + wr * 64 + fr, col0 = u.pn * HALF + wc * 32 + 8 * fq;
#pragma unroll
        for (int ai = 0; ai < 2; ++ai)
#pragma unroll
            for (int m = 0; m < 4; ++m) { const int row = row0 + ai * HALF + m * 16; bf16_t* rowp = base + (size_t)row * u.ldc + col0; const float q = rs[row], q2 = q * q;
                float r[8];
#pragma unroll
                for (int n = 0; n < 2; ++n)
#pragma unroll
                    for (int j = 0; j < 4; ++j) r[n * 4 + j] = acc[ai][0][m][n][j] * acc[ai][1][m][n][j] * q2;
                u32x4 w; w.x = cvt_pk_bf16(r[0], r[1]); w.y = cvt_pk_bf16(r[2], r[3]); w.z = cvt_pk_bf16(r[4], r[5]); w.w = cvt_pk_bf16(r[6], r[7]);
                *(u32x4*)rowp = w; }
    }
};

template <class Epi, class Sched, bool ALIGN_EPI>
__device__ __forceinline__ void gemm_phase(LAS unsigned char* lds, const int K, const int lda, const int ldb, const Sched& S, const Epi& E) {
    const int tid = fresh_tid(), wid = __builtin_amdgcn_readfirstlane(tid >> 6), lane = tid & 63, wr = wid >> 2, wc = wid & 3, fr = lane & 15, fq = lane >> 4;
    const int nt = K / BK;
    int sR[2], sC[2]; unsigned voffB[2], vA[2][2], nvA[2][2];
#pragma unroll
    for (int i = 0; i < 2; ++i) { stage_rc(tid * 16 + i * 8192, sR[i], sC[i]); const int Rb = Epi::PERM ? ((sR[i] & ~31) + perm32(sR[i] & 31)) : sR[i];
        voffB[i] = (unsigned)(Rb * ldb + sC[i]) * 2u; }
    const size_t kstep = (size_t)(BK * 2);
    const unsigned ldsb = (unsigned)__builtin_amdgcn_readfirstlane((int)(unsigned)(__UINTPTR_TYPE__)lds) + (unsigned)wid * 1024u;
    const size_t hstepA = (size_t)HALF * lda * 2;
    const int aoff = lds_byte(wr * 64 + fr, fq * 8), boff = lds_byte(wc * 32 + fr, fq * 8);
#define PG8_SA(b, h) (((b) * 2 + (h)) * HTB)
#define PG8_SB(b, h) ((4 + (b) * 2 + (h)) * HTB)
#define PG8_STAGE(bufoff, gbase, voff) do { _Pragma("unroll") for (int _i = 0; _i < 2; ++_i) \
        glds16((const char*)(gbase), (voff)[_i], ldsb + (unsigned)(bufoff) + (unsigned)(_i * 8192)); } while (0)
#define PG8_STAGE_A(bufoff, gbase, h, VA) do { if constexpr (Sched::GATHER) { PG8_STAGE(bufoff, gbase, (VA)[h]); } else { PG8_STAGE(bufoff, (gbase) + (h) * hstepA, (VA)[0]); } } while (0)
#define PG8_LDA(dst, b, h) do { _Pragma("unroll") for (int m = 0; m < 4; ++m) _Pragma("unroll") for (int k = 0; k < 2; ++k) dst[m][k] = *(const LAS bf16x8*)(lds + PG8_SA(b, h) + aoff + m * 2048 + k * 1024); } while (0)
#define PG8_LDB(dst, b, h) do { _Pragma("unroll") for (int n = 0; n < 2; ++n) _Pragma("unroll") for (int k = 0; k < 2; ++k) dst[n][k] = *(const LAS bf16x8*)(lds + PG8_SB(b, h) + boff + n * 2048 + k * 1024); } while (0)
#define PG8_MMA(ai, bj, At, Bt) do { __builtin_amdgcn_s_setprio(1); _Pragma("unroll") for (int m = 0; m < 4; ++m) _Pragma("unroll") for (int n = 0; n < 2; ++n) _Pragma("unroll") for (int k = 0; k < 2; ++k) \
        acc[ai][bj][m][n] = __builtin_amdgcn_mfma_f32_16x16x32_bf16(Bt[n][k], At[m][k], acc[ai][bj][m][n], 0, 0, 0); __builtin_amdgcn_s_setprio(0); } while (0)
#define PG8_WAIT_V(n) asm volatile("s_waitcnt vmcnt(" #n ")" ::: "memory")
#define PG8_WAIT_L(n) asm volatile("s_waitcnt lgkmcnt(" #n ")" ::: "memory")
#define PG8_BAR __builtin_amdgcn_s_barrier()
#define PG8_SCHED __builtin_amdgcn_sched_barrier(0)
    Unit cur, nxt; int ui = 0;
    if (!S.next(0, cur)) return;
#pragma unroll
    for (int h = 0; h < 2; ++h)
#pragma unroll
        for (int i = 0; i < 2; ++i) vA[h][i] = Sched::GATHER ? (unsigned)(S.arow(cur, h * HALF + sR[i]) * lda + sC[i]) * 2u : (unsigned)(sR[i] * lda + sC[i]) * 2u;
    f32x4 acc[2][2][4][2];
#pragma unroll
    for (int a = 0; a < 2; ++a)
#pragma unroll
        for (int b = 0; b < 2; ++b)
#pragma unroll
            for (int m = 0; m < 4; ++m)
#pragma unroll
                for (int n = 0; n < 2; ++n) acc[a][b][m][n] = (f32x4){0.f, 0.f, 0.f, 0.f};
    bf16x8 At[4][2], B0[2][2], B1[2][2];
    PG8_STAGE(PG8_SB(0, 0), cur.b0, voffB); PG8_STAGE(PG8_SB(0, 1), cur.b1, voffB); PG8_STAGE_A(PG8_SA(0, 0), cur.a, 0, vA); PG8_STAGE_A(PG8_SA(0, 1), cur.a, 1, vA);
    if (wr == 1) PG8_BAR;
    PG8_WAIT_V(2); PG8_BAR;
    PG8_STAGE(PG8_SB(1, 0), cur.b0 + kstep, voffB); PG8_STAGE_A(PG8_SA(1, 0), cur.a + kstep, 0, vA); PG8_STAGE(PG8_SB(1, 1), cur.b1 + kstep, voffB);
    PG8_WAIT_V(6); PG8_BAR;
    for (;;) {
        const bool has_next = S.next(ui + 1, nxt);
        const char* nA = has_next ? nxt.a : cur.a; const char* nB0 = has_next ? nxt.b0 : cur.b0; const char* nB1 = has_next ? nxt.b1 : cur.b1;
        if constexpr (Sched::GATHER) {
#pragma unroll
            for (int h = 0; h < 2; ++h)
#pragma unroll
                for (int i = 0; i < 2; ++i) nvA[h][i] = has_next ? (unsigned)(S.arow(nxt, h * HALF + sR[i]) * lda + sC[i]) * 2u : vA[h][i];
        }
        for (int t = 0; t < nt; t += 2) {
            const bool last = (t == nt - 2);
            const char* a1 = cur.a + (size_t)(t + 1) * kstep;
            const char* a2 = last ? nA : cur.a + (size_t)(t + 2) * kstep;
            const char* b20 = last ? nB0 : cur.b0 + (size_t)(t + 2) * kstep; const char* b21 = last ? nB1 : cur.b1 + (size_t)(t + 2) * kstep;
            const char* a3 = a2 + kstep; const char* b30 = b20 + kstep; const char* b31 = b21 + kstep;
            unsigned wA[2][2];
#pragma unroll
            for (int h = 0; h < 2; ++h)
#pragma unroll
                for (int i = 0; i < 2; ++i) wA[h][i] = (Sched::GATHER && last) ? nvA[h][i] : vA[h][i];
            PG8_LDB(B0, 0, 0); PG8_LDB(B1, 0, 1); PG8_SCHED; PG8_LDA(At, 0, 0); PG8_STAGE_A(PG8_SA(1, 1), a1, 1, vA);
            PG8_WAIT_V(8); PG8_WAIT_L(0); PG8_BAR; PG8_MMA(0, 0, At, B0); PG8_MMA(0, 1, At, B1); PG8_BAR; PG8_SCHED;
            PG8_LDA(At, 0, 1); PG8_STAGE(PG8_SB(0, 0), b20, voffB); PG8_STAGE(PG8_SB(0, 1), b21, voffB); PG8_STAGE_A(PG8_SA(0, 0), a2, 0, wA);
            PG8_WAIT_V(8); PG8_WAIT_L(0); PG8_BAR; PG8_MMA(1, 0, At, B0); PG8_MMA(1, 1, At, B1); PG8_BAR; PG8_SCHED;
            PG8_LDB(B0, 1, 0); PG8_LDB(B1, 1, 1); PG8_SCHED; PG8_LDA(At, 1, 0); PG8_STAGE_A(PG8_SA(0, 1), a2, 1, wA);
            PG8_WAIT_V(8); PG8_WAIT_L(0); PG8_BAR; PG8_MMA(0, 0, At, B0); PG8_MMA(0, 1, At, B1); PG8_BAR; PG8_SCHED;
            PG8_LDA(At, 1, 1); PG8_STAGE(PG8_SB(1, 0), b30, voffB); PG8_STAGE(PG8_SB(1, 1), b31, voffB); PG8_STAGE_A(PG8_SA(1, 0), a3, 0, wA);
            PG8_WAIT_V(8); PG8_WAIT_L(0); PG8_BAR; PG8_MMA(1, 0, At, B0); PG8_MMA(1, 1, At, B1); PG8_BAR; PG8_SCHED;
        }
        if constexpr (ALIGN_EPI) { if (wr == 0) PG8_BAR; }
        E(acc, cur, wr, wc, fr, fq);
        if (!has_next) break;
#pragma unroll
        for (int a = 0; a < 2; ++a)
#pragma unroll
            for (int b = 0; b < 2; ++b)
#pragma unroll
                for (int m = 0; m < 4; ++m)
#pragma unroll
                    for (int n = 0; n < 2; ++n) acc[a][b][m][n] = (f32x4){0.f, 0.f, 0.f, 0.f};
        cur = nxt; ++ui;
        if constexpr (Sched::GATHER) {
#pragma unroll
            for (int h = 0; h < 2; ++h)
#pragma unroll
                for (int i = 0; i < 2; ++i) vA[h][i] = nvA[h][i];
        }
        if constexpr (ALIGN_EPI) { if (wr == 1) PG8_BAR; }
    }
    PG8_WAIT_V(0);
    if constexpr (!ALIGN_EPI) { if (wr == 0) PG8_BAR; }
    PG8_BAR;
#undef PG8_SA
#undef PG8_SB
#undef PG8_STAGE
#undef PG8_STAGE_A
#undef PG8_LDA
#undef PG8_LDB
#undef PG8_MMA
#undef PG8_WAIT_V
#undef PG8_WAIT_L
#undef PG8_BAR
#undef PG8_SCHED
}
}
#define XB_TMO      128
#define XB_XCNT(j)  (256  + 64 * (j))
#define XB_XSUB(j)  (1280 + 64 * (j))
#define XB_XGEN(j)  (2304 + 64 * (j))
#define XB_TOP      3328
#define XB_TOPGEN   3392
#define XCD_BAR_WORDS 3456
#define XB_SPIN_CAP (1u << 21)

__device__ __forceinline__ unsigned xb_ld(unsigned* p)              { return __hip_atomic_load(p, __ATOMIC_RELAXED, __HIP_MEMORY_SCOPE_AGENT); }
__device__ __forceinline__ unsigned xb_add(unsigned* p, unsigned v) { return __hip_atomic_fetch_add(p, v, __ATOMIC_RELAXED, __HIP_MEMORY_SCOPE_AGENT); }
__device__ __forceinline__ unsigned xb_xcc_id() { return (unsigned)__builtin_amdgcn_s_getreg((3 << 11) | 20) & 0xFu; }
#define XB_SPIN(cond, bar) do { unsigned _sp = 0; while (cond) { __builtin_amdgcn_s_sleep(1); \
    if ((++_sp & 255u) == 0u) { if (xb_ld(&(bar)[XB_TMO])) break; if (_sp > XB_SPIN_CAP) { atomicAdd(&(bar)[XB_TMO], 1u); break; } } } } while (0)

struct XcdBarrier {
    unsigned* bar; unsigned x;
    volatile LAS unsigned* st;
};

__device__ __forceinline__ XcdBarrier xcd_barrier_post(unsigned* bar, volatile LAS unsigned* st) {
    XcdBarrier b; b.bar = bar; b.x = xb_xcc_id(); b.st = st;
    if (threadIdx.x == 0) (void)xb_add(&bar[XB_XCNT(b.x)], 1u);
    return b;
}
__device__ __forceinline__ void xcd_barrier_complete(unsigned* bar, unsigned x, unsigned& nloc, unsigned& nx) {
    const unsigned G = gridDim.x * gridDim.y * gridDim.z;
    unsigned sum, cnt, mine, sp = 0u;
    for (;;) {
        sum = 0u; cnt = 0u; mine = 0u;
#pragma unroll
        for (unsigned j = 0; j < 16; ++j) { const unsigned c = xb_ld(&bar[XB_XCNT(j)]); sum += c; cnt += (c > 0u) ? 1u : 0u; mine = (j == x) ? c : mine; }
        if (sum == G) break;
        __builtin_amdgcn_s_sleep(1);
        if ((++sp & 255u) == 0u) { if (xb_ld(&bar[XB_TMO])) break; if (sp > XB_SPIN_CAP) { atomicAdd(&bar[XB_TMO], 1u); break; } }
    }
    nloc = mine > 0u ? mine : 1u; nx = cnt > 0u ? cnt : 1u;
}

__device__ __forceinline__ void xcd_barrier(const XcdBarrier& b) {
    asm volatile("s_waitcnt vmcnt(0)" ::: "memory");
    __syncthreads();
    if (threadIdx.x == 0) {
        unsigned* bar = b.bar;
        __builtin_amdgcn_s_waitcnt(0);
        unsigned nloc = b.st[0], nx = b.st[1];
        if (nloc == 0u) { xcd_barrier_complete(bar, b.x, nloc, nx); b.st[0] = nloc; b.st[1] = nx; }
        const unsigned old = xb_add(&bar[XB_XSUB(b.x)], 1u);
        const unsigned gen = old / nloc;
        if (old + 1u == (gen + 1u) * nloc) {
            __builtin_amdgcn_fence(__ATOMIC_RELEASE, "agent");
            asm volatile("s_waitcnt vmcnt(0)" ::: "memory");
            const unsigned og = xb_add(&bar[XB_TOP], 1u);
            const unsigned tg = og / nx;
            if (og + 1u == (tg + 1u) * nx) xb_add(&bar[XB_TOPGEN], 1u);
            else XB_SPIN(xb_ld(&bar[XB_TOPGEN]) == tg, bar);
            __builtin_amdgcn_fence(__ATOMIC_ACQUIRE, "agent");
            xb_add(&bar[XB_XGEN(b.x)], 1u);
            asm volatile("s_waitcnt vmcnt(0)" ::: "memory");
        } else {
            XB_SPIN(xb_ld(&bar[XB_XGEN(b.x)]) == gen, bar);
            __builtin_amdgcn_fence(__ATOMIC_ACQUIRE, "agent");
            asm volatile("s_waitcnt vmcnt(0)" ::: "memory");
        }
    }
    __syncthreads();
}

constexpr int T = 8192, D = 2048, NMEM = 256;
constexpr int EVW = 5128, EVN = 5120, ODN = 6144;
constexpr int NH = 4, DH = 256, CH = 128, NCH = 64;
constexpr int XH = 4, XD = 512;
constexpr int NEXP = 32, DEXP = 1024, LISTCAP = 8192;
constexpr float EPS = 1e-6f;
constexpr int NWAVES = 8, NTHR = 512;

constexpr size_t MiB = 1u << 20;
constexpr size_t WS_CTL = 0, CTL_ZERO_BYTES = 192 * 1024, CTL_SSQ = 64 * 1024;
constexpr size_t WS_WEVIN = 1 * MiB, WS_WEVOUT = 21 * MiB, WS_WODIN = 29 * MiB, WS_WODOUT = 53 * MiB;
constexpr size_t WS_WXQ = 61 * MiB, WS_WXK = 77 * MiB, WS_WXV = 93 * MiB, WS_WXO = 109 * MiB, WS_WPOOL = 125 * MiB;
constexpr size_t WS_MEMN = 126 * MiB, WS_KX = 128 * MiB, WS_VX = 130 * MiB, WS_SMALL = 132 * MiB;
constexpr size_t WS_WEXP = 136 * MiB, WEXP_LAYER = 384 * MiB, WEXP_MAT = 128 * MiB, WEXP_ONE = (size_t)DEXP * D * 2;
constexpr size_t WS_HN = 904 * MiB, WS_Z = 936 * MiB, WS_YCAT = 1032 * MiB, WS_DPOOL = 1064 * MiB, WS_KC = 1080 * MiB, WS_CST = 1144 * MiB;
constexpr size_t WS_QX = 1192 * MiB, WS_OATT = 1224 * MiB, WS_HID = 1256 * MiB, WS_YB = 1304 * MiB, WS_LIST = 1400 * MiB, WS_TOKINFO = 1402 * MiB, WS_H16 = 1404 * MiB, WS_END = 1436 * MiB;
constexpr size_t SM_GATES = 0, SM_BCUM = 256 * 1024, SM_GI = 384 * 1024, SM_MARR = 512 * 1024, SM_APREV = 516 * 1024, SM_BL = 520 * 1024, SM_KN = 1 * MiB, SM_NST = 1 * MiB + 256 * 1024, SM_SSQP = 2 * MiB;
constexpr int CW_BAR = 4096;
constexpr int CW_CNT = 8192;
constexpr int LDS_BYTES = 159744, MISC_OFF = 159232, TBL_OFF = 157696;

__device__ __forceinline__ float wave_sum(float v) {
#pragma unroll
    for (int o = 1; o < 64; o <<= 1) v += __shfl_xor(v, o);
    return v;
}
__device__ __forceinline__ float wave_max(float v) {
#pragma unroll
    for (int o = 1; o < 64; o <<= 1) v = fmaxf(v, __shfl_xor(v, o));
    return v;
}
template <int N, int BIT> struct WRed {
    static __device__ __forceinline__ void run(float* v, int lane) {
        const bool up = (lane & BIT) != 0;
#pragma unroll
        for (int i = 0; i < N / 2; ++i) { const float keep = up ? v[i + N / 2] : v[i]; const float send = up ? v[i] : v[i + N / 2]; v[i] = keep + __shfl_xor(send, BIT); }
        WRed<N / 2, BIT / 2>::run(v, lane);
    }
};
template <int BIT> struct WRed<1, BIT> { static __device__ __forceinline__ void run(float*, int) {} };
template <int N> struct Log2 { static constexpr int v = 1 + Log2<N / 2>::v; };
template <> struct Log2<1> { static constexpr int v = 0; };
template <int N> __device__ __forceinline__ float wave_reduce_pow2(float (&v)[N], int lane) {
    WRed<N, 32>::run(v, lane);
    float r = v[0];
#pragma unroll
    for (int s = Log2<N>::v; s < 6; ++s) r += __shfl_xor(r, 32 >> s);
    return r;
}
__device__ __forceinline__ float logsigf(float x) { return fminf(x, 0.f) - log1pf(expf(-fabsf(x))); }

__device__ __forceinline__ void transpose_item64(const float* W, int ldw, int K, bf16_t* WT, int kb, int nb, LAS float* scr, int lane, const float* gain) {
    const int k0 = kb * 64, n0 = nb * 64;
    const float* src = W + (size_t)(k0 + (lane >> 4)) * ldw + n0 + 4 * (lane & 15);
    f32x4 v[16];
#pragma unroll
    for (int i = 0; i < 16; ++i) v[i] = *(const f32x4*)(src + (size_t)(4 * i) * ldw);
    if (gain) {
#pragma unroll
        for (int i = 0; i < 16; ++i) v[i] = v[i] * gain[k0 + 4 * i + (lane >> 4)]; }
#pragma unroll
    for (int i = 0; i < 16; ++i) { LAS float* d = scr + (4 * i + (lane >> 4)) * 65 + 4 * (lane & 15); d[0] = v[i][0]; d[1] = v[i][1]; d[2] = v[i][2]; d[3] = v[i][3]; }
    asm volatile("s_waitcnt lgkmcnt(0)" ::: "memory");
    const int kc = lane & 7;
#pragma unroll
    for (int j = 0; j < 8; ++j) { const int n = (lane >> 3) + 8 * j; const LAS float* s = scr + (8 * kc) * 65 + n;
        u32x4 o; o.x = cvt_pk_bf16(s[0], s[65]); o.y = cvt_pk_bf16(s[130], s[195]); o.z = cvt_pk_bf16(s[260], s[325]); o.w = cvt_pk_bf16(s[390], s[455]);
        *(u32x4*)(WT + (size_t)(n0 + n) * K + k0 + 8 * kc) = o; }
    asm volatile("s_waitcnt lgkmcnt(0)" ::: "memory");
}

template <int ROWS, int COLS, int PAD> __device__ __forceinline__ void stage_tile(LAS unsigned char* dst, const bf16_t* src, size_t ld, int tid) {
    constexpr int CPR = COLS / 8, TOTAL = ROWS * CPR, RS = (COLS + PAD) * 2, NI = TOTAL / NTHR;
    static_assert(TOTAL % NTHR == 0, "stage_tile");
    u32x4 v[NI];
#pragma unroll
    for (int i = 0; i < NI; ++i) { const int idx = tid + i * NTHR, r = idx / CPR, c = idx % CPR; v[i] = *(const u32x4*)(src + (size_t)r * ld + c * 8); }
#pragma unroll
    for (int i = 0; i < NI; ++i) { const int idx = tid + i * NTHR, r = idx / CPR, c = idx % CPR; *(LAS u32x4*)(dst + r * RS + c * 16) = v[i]; }
}
template <int ROWS, int COLS> __device__ __forceinline__ void stage_load(u32x4 (&v)[ROWS * (COLS / 8) / NTHR], const bf16_t* src, size_t ld, int tid) {
    constexpr int CPR = COLS / 8, NI = ROWS * CPR / NTHR;
#pragma unroll
    for (int i = 0; i < NI; ++i) { const int idx = tid + i * NTHR, r = idx / CPR, c = idx % CPR; v[i] = *(const u32x4*)(src + (size_t)r * ld + c * 8); }
}
template <int ROWS, int COLS, int PAD> __device__ __forceinline__ void stage_store(LAS unsigned char* dst, const u32x4 (&v)[ROWS * (COLS / 8) / NTHR], int tid) {
    constexpr int CPR = COLS / 8, NI = ROWS * CPR / NTHR, RS = (COLS + PAD) * 2;
#pragma unroll
    for (int i = 0; i < NI; ++i) { const int idx = tid + i * NTHR, r = idx / CPR, c = idx % CPR; *(LAS u32x4*)(dst + r * RS + c * 16) = v[i]; }
}
__device__ __forceinline__ bf16x8 row_frag(const LAS unsigned char* tile, int RS, int n0, int k0, int lane) {
    return *(const LAS bf16x8*)(tile + (n0 + (lane & 15)) * RS + (k0 + 8 * (lane >> 4)) * 2);
}
__device__ __forceinline__ s16x4 tr4(const LAS unsigned char* p) { return __builtin_bit_cast(s16x4, __builtin_amdgcn_ds_read_tr16_b64_v4i16((LAS v4i16_t*)p)); }
__device__ __forceinline__ bf16x8 tr_frag(const LAS unsigned char* tile, int RS, int k0, int n0, int lane) {
    const int g = lane >> 4, i = lane & 15, q = i >> 2, pp = i & 3;
    const LAS unsigned char* a = tile + (k0 + 8 * g + q) * RS + (n0 + 4 * pp) * 2;
    const s16x4 lo = tr4(a), hi = tr4(a + 4 * RS);
    return (bf16x8){lo[0], lo[1], lo[2], lo[3], hi[0], hi[1], hi[2], hi[3]};
}
#define MFMA16(b, a, c) __builtin_amdgcn_mfma_f32_16x16x32_bf16((b), (a), (c), 0, 0, 0)

enum { RM_PLAIN = 0, RM_GATES = 1, RM_ROUTE = 2, RM_COMBINE = 3 };
struct RowArgs {
    const float* hin; float* hout; const bf16_t* hin16; bf16_t* hout16; const float* gain; bf16_t* hn; float* fout;
    const float* wgate; const float* bgate; float* gates;
    const float* rgw; const float* rgb; const float* rew; const float* reb; unsigned* cnt; int* list; int* tokinfo;
    const bf16_t* yb; const int* tokinfo_in;
    float* rsl;
    const bf16_t* wr;
};
template <int MODE, bool OUTF32, bool HIN16 = false, bool HOUT16 = false>
__device__ __forceinline__ void row_phase(LAS unsigned char* lds, const RowArgs& a, int G) {
    constexpr int NRED = 40, RG = (MODE == RM_ROUTE) ? 4 : 32;
    const int tid = fresh_tid(), lane = tid & 63, wave = __builtin_amdgcn_readfirstlane(tid >> 6);
    LAS float* red = (LAS float*)lds;
    LAS float* rstd_l = (LAS float*)(lds + 40960);
    LAS float* fin = (LAS float*)(lds + 41088);
    LAS int* cntl = (LAS int*)(lds + 46208);
    LAS int* basel = (LAS int*)(lds + 46336);
    const LAS int* tbl = (const LAS int*)(lds + TBL_OFF);
    const f32x4 g4 = *(const f32x4*)(a.gain + 4 * tid);
    for (int rb = fresh_bx(); rb < T / 32; rb += G) {
        const int row0 = rb * 32;
    float wg8[4][8]; float we[4][32]; float wgr[4][4];
    if constexpr (MODE == RM_GATES) {
#pragma unroll
        for (int i = 0; i < 4; ++i) { const f32x4 lo = *(const f32x4*)(a.wgate + (size_t)(4 * tid + i) * EVW + EVN), hi = *(const f32x4*)(a.wgate + (size_t)(4 * tid + i) * EVW + EVN + 4);
#pragma unroll
            for (int o = 0; o < 4; ++o) { wg8[i][o] = lo[o] * g4[i]; wg8[i][4 + o] = hi[o] * g4[i]; } }
    }
    if constexpr (MODE == RM_ROUTE && !HIN16) {
#pragma unroll
        for (int i = 0; i < 4; ++i) {
#pragma unroll
            for (int o4 = 0; o4 < 8; ++o4) { const f32x4 w = *(const f32x4*)(a.rew + (size_t)(4 * tid + i) * NEXP + 4 * o4);
#pragma unroll
                for (int o = 0; o < 4; ++o) we[i][4 * o4 + o] = w[o] * g4[i]; }
            const f32x4 w = *(const f32x4*)(a.rgw + (size_t)(4 * tid + i) * 4);
#pragma unroll
            for (int o = 0; o < 4; ++o) wgr[i][o] = w[o] * g4[i];
        }
    }
        if (MODE == RM_ROUTE && tid < 32) cntl[tid] = 0;
        f32x4 xs[RG];
        if constexpr (MODE == RM_ROUTE && HIN16) {
            const int fr = lane & 15, fq = lane >> 4;
            f32x4 acc[2][3]; float sq[2] = {0.f, 0.f};
#pragma unroll
            for (int mt = 0; mt < 2; ++mt)
#pragma unroll
                for (int nt = 0; nt < 3; ++nt) acc[mt][nt] = (f32x4){0.f, 0.f, 0.f, 0.f};
#pragma unroll 2
            for (int ks = 0; ks < 8; ++ks) { const int k0 = 256 * wave + 32 * ks + 8 * fq;
                bf16x8 af[2], bh[3], bl[3];
#pragma unroll
                for (int mt = 0; mt < 2; ++mt) af[mt] = *(const bf16x8*)(a.hin16 + (size_t)(row0 + 16 * mt + fr) * D + k0);
#pragma unroll
                for (int nt = 0; nt < 3; ++nt) { bh[nt] = *(const bf16x8*)(a.wr + (size_t)(16 * nt + fr) * D + k0); bl[nt] = *(const bf16x8*)(a.wr + (size_t)(48 + 16 * nt + fr) * D + k0); }
#pragma unroll
                for (int mt = 0; mt < 2; ++mt) {
#pragma unroll
                    for (int e = 0; e < 8; ++e) { const float v = bf2f((unsigned short)af[mt][e]); sq[mt] += v * v; }
#pragma unroll
                    for (int nt = 0; nt < 3; ++nt) { acc[mt][nt] = MFMA16(bh[nt], af[mt], acc[mt][nt]); acc[mt][nt] = MFMA16(bl[nt], af[mt], acc[mt][nt]); } }
            }
#pragma unroll
            for (int mt = 0; mt < 2; ++mt) { const int r = 16 * mt + fr;
#pragma unroll
                for (int nt = 0; nt < 3; ++nt)
#pragma unroll
                    for (int i = 0; i < 4; ++i) { const int o = 16 * nt + 4 * fq + i; if (o < 36) red[(r * 8 + wave) * NRED + o] = acc[mt][nt][i]; }
                float s = sq[mt]; s += __shfl_xor(s, 16); s += __shfl_xor(s, 32);
                if (fq == 0) red[(r * 8 + wave) * NRED + 36] = s; }
        } else {
        u32x2 xnext[(MODE == RM_ROUTE && HIN16) ? RG : 1];
        if constexpr (MODE == RM_ROUTE && HIN16) {
#pragma unroll
            for (int i = 0; i < RG; ++i) xnext[i] = *(const u32x2*)(a.hin16 + (size_t)(row0 + i) * D + 4 * tid);
        }
        for (int grp = 0; grp < 32 / RG; ++grp) {
            if constexpr (MODE == RM_ROUTE && HIN16) {
#pragma unroll
                for (int i = 0; i < RG; ++i) xs[i] = (f32x4){bf_lo(xnext[i].x), bf_hi(xnext[i].x), bf_lo(xnext[i].y), bf_hi(xnext[i].y)};
                const int gn = (grp + 1 < 32 / RG) ? grp + 1 : grp;
#pragma unroll
                for (int i = 0; i < RG; ++i) xnext[i] = *(const u32x2*)(a.hin16 + (size_t)(row0 + gn * RG + i) * D + 4 * tid);
            } else {
#pragma unroll
            for (int i = 0; i < RG; ++i) {
                if constexpr (HIN16) { const u32x2 t = *(const u32x2*)(a.hin16 + (size_t)(row0 + grp * RG + i) * D + 4 * tid); xs[i] = (f32x4){bf_lo(t.x), bf_hi(t.x), bf_lo(t.y), bf_hi(t.y)}; }
                else xs[i] = *(const f32x4*)(a.hin + (size_t)(row0 + grp * RG + i) * D + 4 * tid); }
            }
            if constexpr (MODE == RM_COMBINE) {
#pragma unroll
                for (int i = 0; i < RG; ++i) { const int row = row0 + grp * RG + i; const int* ti = a.tokinfo_in + (size_t)row * 8;
                    const int e0 = ti[0], p0 = ti[1], e1 = ti[3], p1 = ti[4]; const float w0 = __builtin_bit_cast(float, ti[2]), w1 = __builtin_bit_cast(float, ti[5]);
                    const size_t s0 = (size_t)tbl[e0] * 256 + p0, s1 = (size_t)tbl[e1] * 256 + p1;
                    const u32x2 y0 = *(const u32x2*)(a.yb + s0 * D + 4 * tid), y1 = *(const u32x2*)(a.yb + s1 * D + 4 * tid);
                    f32x4 x = xs[i];
                    x[0] += w0 * bf_lo(y0.x) + w1 * bf_lo(y1.x); x[1] += w0 * bf_hi(y0.x) + w1 * bf_hi(y1.x);
                    x[2] += w0 * bf_lo(y0.y) + w1 * bf_lo(y1.y); x[3] += w0 * bf_hi(y0.y) + w1 * bf_hi(y1.y);
                    xs[i] = x;
                    if constexpr (HOUT16) { u32x2 w; w.x = cvt_pk_bf16(x[0], x[1]); w.y = cvt_pk_bf16(x[2], x[3]); *(u32x2*)(a.hout16 + (size_t)row * D + 4 * tid) = w; }
                    else *(f32x4*)(a.hout + (size_t)row * D + 4 * tid) = x; }
            }
#pragma unroll
            for (int i = 0; i < RG; ++i) {
                const f32x4 x = xs[i]; const int r = grp * RG + i;
                float ssq[1]; ssq[0] = (x[0] * x[0] + x[1] * x[1]) + (x[2] * x[2] + x[3] * x[3]);
                if constexpr (MODE == RM_GATES) {
                    float v[8];
#pragma unroll
                    for (int o = 0; o < 8; ++o) v[o] = (x[0] * wg8[0][o] + x[1] * wg8[1][o]) + (x[2] * wg8[2][o] + x[3] * wg8[3][o]);
                    const float rv = wave_reduce_pow2<8>(v, lane);
                    if ((lane & 7) == 0) red[(r * 8 + wave) * NRED + (lane >> 3)] = rv;
                }
                if constexpr (MODE == RM_ROUTE) {
                    float v[32];
#pragma unroll
                    for (int o = 0; o < 32; ++o) v[o] = (x[0] * we[0][o] + x[1] * we[1][o]) + (x[2] * we[2][o] + x[3] * we[3][o]);
                    const float rv = wave_reduce_pow2<32>(v, lane);
                    if ((lane & 1) == 0) red[(r * 8 + wave) * NRED + (lane >> 1)] = rv;
                    float u[4];
#pragma unroll
                    for (int o = 0; o < 4; ++o) u[o] = (x[0] * wgr[0][o] + x[1] * wgr[1][o]) + (x[2] * wgr[2][o] + x[3] * wgr[3][o]);
                    const float ru = wave_reduce_pow2<4>(u, lane);
                    if ((lane & 15) == 0) red[(r * 8 + wave) * NRED + 32 + (lane >> 4)] = ru;
                }
                const float rs = wave_reduce_pow2<1>(ssq, lane);
                if (lane == 0) red[(r * 8 + wave) * NRED + 36] = rs;
            }
        }
        }
        __syncthreads();
        int fe0 = 0, fe1 = 0, lp0 = 0, lp1 = 0; float fw0 = 0.f, fw1 = 0.f, frs = 0.f;
        if (tid < 32) {
            const int r = tid, row = row0 + r;
            float s = 0.f;
#pragma unroll
            for (int w = 0; w < 8; ++w) s += red[(r * 8 + w) * NRED + 36];
            const float rstd = rsqrtf(s * (1.0f / D) + EPS);
            rstd_l[r] = rstd; frs = rstd;
            if constexpr (MODE == RM_GATES) {
#pragma unroll
                for (int o = 0; o < 8; ++o) { float d = 0.f;
#pragma unroll
                    for (int w = 0; w < 8; ++w) d += red[(r * 8 + w) * NRED + o];
                    a.gates[(size_t)row * 8 + o] = d * rstd + a.bgate[o]; }
            }
            if constexpr (MODE == RM_ROUTE) {
#pragma unroll
                for (int o = 0; o < 36; ++o) { float d = 0.f;
#pragma unroll
                    for (int w = 0; w < 8; ++w) d += red[(r * 8 + w) * NRED + o];
                    fin[r * NRED + o] = d * rstd + (o < 32 ? a.reb[o] : a.rgb[o - 32]); }
                const float l0 = fin[r * NRED + 32], l1 = fin[r * NRED + 33], l2 = fin[r * NRED + 34], l3 = fin[r * NRED + 35];
                int gsel = 0; float mx = l0;
                if (l1 > mx) { mx = l1; gsel = 1; }
                if (l2 > mx) { mx = l2; gsel = 2; }
                if (l3 > mx) { mx = l3; gsel = 3; }
                const float gp = 1.0f / (expf(l0 - mx) + expf(l1 - mx) + expf(l2 - mx) + expf(l3 - mx));
                float v1 = -INFINITY, v2 = -INFINITY; int i1 = 0, i2 = 0;
                for (int j = 0; j < 8; ++j) { const float v = fin[r * NRED + gsel * 8 + j]; if (v > v1) { v1 = v; i1 = j; } }
                for (int j = 0; j < 8; ++j) { const float v = fin[r * NRED + gsel * 8 + j]; if (j != i1 && v > v2) { v2 = v; i2 = j; } }
                const float e21 = expf(v2 - v1), inv = 1.0f / (1.0f + e21);
                fw0 = gp * inv; fw1 = gp * e21 * inv; fe0 = gsel * 8 + i1; fe1 = gsel * 8 + i2;
                lp0 = atomicAdd((int*)&cntl[fe0], 1); lp1 = atomicAdd((int*)&cntl[fe1], 1);
            }
        }
        __syncthreads();
        if constexpr (MODE == RM_ROUTE) {
            if (tid < 32) { const int c = cntl[tid]; basel[tid] = c ? (int)__hip_atomic_fetch_add(a.cnt + tid * 64, (unsigned)c, __ATOMIC_RELAXED, __HIP_MEMORY_SCOPE_AGENT) : 0; }
            __syncthreads();
            if (tid < 32) { const int row = row0 + tid; const int p0 = basel[fe0] + lp0, p1 = basel[fe1] + lp1;
                a.list[(size_t)fe0 * LISTCAP + p0] = row; a.list[(size_t)fe1 * LISTCAP + p1] = row;
                if constexpr (HIN16) { a.rsl[(size_t)fe0 * LISTCAP + p0] = frs; a.rsl[(size_t)fe1 * LISTCAP + p1] = frs; }
                int* ti = a.tokinfo + (size_t)row * 8;
                ti[0] = fe0; ti[1] = p0; ti[2] = __builtin_bit_cast(int, fw0); ti[3] = fe1; ti[4] = p1; ti[5] = __builtin_bit_cast(int, fw1); ti[6] = 0; ti[7] = 0; }
        }
        constexpr bool SRC16 = (MODE == RM_COMBINE) ? HOUT16 : HIN16;
        const float* src2 = (MODE == RM_COMBINE) ? (const float*)a.hout : a.hin; const bf16_t* src216 = (MODE == RM_COMBINE) ? (const bf16_t*)a.hout16 : a.hin16;
        if constexpr (MODE == RM_ROUTE && HIN16) {
        } else if constexpr (RG == 32) {
            if constexpr (OUTF32) {
#pragma unroll
                for (int i = 0; i < 32; ++i) { const int row = row0 + i; const float rs = rstd_l[i]; const f32x4 y = xs[i] * rs * g4; *(f32x4*)(a.fout + (size_t)row * D + 4 * tid) = y; }
            } else {
#pragma unroll
                for (int i = 0; i < 32; i += 2) { u32x2 ab[2];
#pragma unroll
                    for (int n = 0; n < 2; ++n) { const float rs = rstd_l[i + n]; const f32x4 y = xs[i + n] * rs * g4; ab[n].x = cvt_pk_bf16(y[0], y[1]); ab[n].y = cvt_pk_bf16(y[2], y[3]); }
                    const bool odd = tid & 1; const u32x2 give = odd ? ab[0] : ab[1];
                    u32x2 got; got.x = (unsigned)__shfl_xor((int)give.x, 1); got.y = (unsigned)__shfl_xor((int)give.y, 1);
                    u32x4 w; if (odd) { w.x = got.x; w.y = got.y; w.z = ab[1].x; w.w = ab[1].y; } else { w.x = ab[0].x; w.y = ab[0].y; w.z = got.x; w.w = got.y; }
                    *(u32x4*)(a.hn + (size_t)(row0 + i + (odd ? 1 : 0)) * D + 4 * (tid & ~1)) = w; }
            }
        } else {
        for (int grp = 0; grp < 4; ++grp) {
            f32x4 ys[8];
#pragma unroll
            for (int i = 0; i < 8; ++i) {
                if constexpr (SRC16) { const u32x2 t = *(const u32x2*)(src216 + (size_t)(row0 + grp * 8 + i) * D + 4 * tid); ys[i] = (f32x4){bf_lo(t.x), bf_hi(t.x), bf_lo(t.y), bf_hi(t.y)}; }
                else ys[i] = *(const f32x4*)(src2 + (size_t)(row0 + grp * 8 + i) * D + 4 * tid); }
#pragma unroll
            for (int i = 0; i < 8; ++i) { const int row = row0 + grp * 8 + i; const float rs = rstd_l[grp * 8 + i]; const f32x4 y = ys[i] * rs * g4;
                if constexpr (OUTF32) *(f32x4*)(a.fout + (size_t)row * D + 4 * tid) = y;
                else { u32x2 w; w.x = cvt_pk_bf16(y[0], y[1]); w.y = cvt_pk_bf16(y[2], y[3]); *(u32x2*)(a.hn + (size_t)row * D + 4 * tid) = w; } }
        }
        }
        __syncthreads();
    }
}

template <bool FINAL>
__device__ __forceinline__ void combine_phase(LAS unsigned char* lds, bf16_t* h16, const bf16_t* yb, const int* tokinfo, const float* gain, float* rsout, float* fout, int G) {
    const int tid = fresh_tid(), lane = tid & 63, wave = __builtin_amdgcn_readfirstlane(tid >> 6);
    const LAS int* tbl = (const LAS int*)(lds + TBL_OFF);
    const int gw = fresh_bx() * NWAVES + wave, NGW = G * NWAVES;
    auto ldti = [&](int r, int (&t)[6]) { const int* ti = tokinfo + (size_t)r * 8;
#pragma unroll
        for (int i = 0; i < 6; ++i) t[i] = ti[i]; };
    auto issue = [&](int r, const int (&t)[6], u32x4 (&hv)[4], u32x4 (&y0)[4], u32x4 (&y1)[4]) {
        const size_t s0 = (size_t)tbl[t[0]] * 256 + t[1], s1 = (size_t)tbl[t[3]] * 256 + t[4];
#pragma unroll
        for (int j = 0; j < 4; ++j) { const int col = 8 * lane + 512 * j;
            hv[j] = *(const u32x4*)(h16 + (size_t)r * D + col); y0[j] = *(const u32x4*)(yb + s0 * D + col); y1[j] = *(const u32x4*)(yb + s1 * D + col); } };
    int row = gw;
    if (row < T) {
        int tc[6], tn[6] = {0, 0, 0, 0, 0, 0};
        u32x4 hv[4], y0[4], y1[4], hvn[4], y0n[4], y1n[4];
        ldti(row, tc);
        if (row + NGW < T) ldti(row + NGW, tn);
        issue(row, tc, hv, y0, y1);
#pragma unroll 1
        for (;;) {
            const int rn = row + NGW; const bool more = rn < T;
            int tnn[6] = {0, 0, 0, 0, 0, 0};
            if (more && rn + NGW < T) ldti(rn + NGW, tnn);
            if (more) issue(rn, tn, hvn, y0n, y1n);
            const float w0 = __builtin_bit_cast(float, tc[2]), w1 = __builtin_bit_cast(float, tc[5]);
            float x[4][8]; float ss = 0.f;
#pragma unroll
            for (int j = 0; j < 4; ++j) {
                const unsigned hw[4] = {hv[j].x, hv[j].y, hv[j].z, hv[j].w}, aw[4] = {y0[j].x, y0[j].y, y0[j].z, y0[j].w}, bw[4] = {y1[j].x, y1[j].y, y1[j].z, y1[j].w};
#pragma unroll
                for (int q = 0; q < 4; ++q) { x[j][2 * q] = bf_lo(hw[q]) + w0 * bf_lo(aw[q]) + w1 * bf_lo(bw[q]); x[j][2 * q + 1] = bf_hi(hw[q]) + w0 * bf_hi(aw[q]) + w1 * bf_hi(bw[q]); }
#pragma unroll
                for (int q = 0; q < 8; ++q) ss += x[j][q] * x[j][q];
            }
            const float rs = rsqrtf(wave_sum(ss) * (1.0f / D) + EPS);
#pragma unroll
            for (int j = 0; j < 4; ++j) { const int col = 8 * lane + 512 * j;
                if constexpr (!FINAL) { u32x4 w; w.x = cvt_pk_bf16(x[j][0], x[j][1]); w.y = cvt_pk_bf16(x[j][2], x[j][3]); w.z = cvt_pk_bf16(x[j][4], x[j][5]); w.w = cvt_pk_bf16(x[j][6], x[j][7]);
                    *(u32x4*)(h16 + (size_t)row * D + col) = w; }
                if constexpr (FINAL) { const f32x4 g0 = *(const f32x4*)(gain + col), g1 = *(const f32x4*)(gain + col + 4);
                    const f32x4 a0 = (f32x4){x[j][0], x[j][1], x[j][2], x[j][3]} * rs * g0, a1 = (f32x4){x[j][4], x[j][5], x[j][6], x[j][7]} * rs * g1;
                    *(f32x4*)(fout + (size_t)row * D + col) = a0; *(f32x4*)(fout + (size_t)row * D + col + 4) = a1; }
            }
            if constexpr (!FINAL) { if (lane == 0) rsout[row] = rs; }
            if (!more) break;
            row = rn;
#pragma unroll
            for (int i = 0; i < 6; ++i) { tc[i] = tn[i]; tn[i] = tnn[i]; }
#pragma unroll
            for (int j = 0; j < 4; ++j) { hv[j] = hvn[j]; y0[j] = y0n[j]; y1[j] = y1n[j]; }
        }
    }
}
constexpr int MOE_PT_OFF = 80, MOE_PARTS = 128;
__device__ __forceinline__ void moe_tables(LAS unsigned char* lds, const unsigned* cnt) {
    LAS int* tbl = (LAS int*)(lds + TBL_OFF);
    __syncthreads();
    const int tq = fresh_tid();
    if (tq < 64) {
        const int e = tq & 31; const int c = (tq < 32) ? (int)__hip_atomic_load(cnt + e * 64, __ATOMIC_RELAXED, __HIP_MEMORY_SCOPE_AGENT) : 0;
        const int t256 = (c + 255) >> 8, t16 = (c + 15) >> 4, np = (t16 + 23) / 24;
        int s1 = t256, s2 = np;
#pragma unroll
        for (int d = 1; d < 32; d <<= 1) { const int a = __shfl_up(s1, d), b = __shfl_up(s2, d); if (tq >= d) { s1 += a; s2 += b; } }
        if (tq < 32) { tbl[e] = s1 - t256; tbl[33 + e] = c; tbl[MOE_PT_OFF + e] = s2 - np;
            if (e == 31) { tbl[32] = s1; tbl[MOE_PT_OFF + 32] = s2; }
            const int tpp = np ? (t16 + np - 1) / np : 0;
            for (int p = 0; p < np; ++p) { const int t0 = p * tpp, nt = (t16 - t0) < tpp ? (t16 - t0) : tpp; tbl[MOE_PARTS + (s2 - np) + p] = e | (t0 << 5) | (nt << 15); } }
    }
    __syncthreads();
}
struct Moe1Sched {
    static constexpr bool GATHER = true;
    const LAS int* tbl; const int* list; const char* xn; const char* wg; const char* wu; char* hid; int G, c;
    __device__ __forceinline__ bool next(int i, pg8::Unit& u) const {
        const int MT = __builtin_amdgcn_readfirstlane(tbl[32]); const int U = MT * 8; const long L = (long)i * G + c; if (L >= U) return false;
        int wgid = (int)L; { const int q = U / 8, r = U % 8, xcd = wgid % 8, off = wgid / 8; wgid = (xcd < r ? xcd * (q + 1) : r * (q + 1) + (xcd - r) * q) + off; }
        const int mtg = wgid >> 3, nt = wgid & 7; int e = 0;
        for (int k = 1; k < 32; ++k) e += (__builtin_amdgcn_readfirstlane(tbl[k]) <= mtg) ? 1 : 0;
        e = __builtin_amdgcn_readfirstlane(e);
        const int ml = mtg - __builtin_amdgcn_readfirstlane(tbl[e]);
        u.a = xn; u.b0 = wg + (size_t)e * WEXP_ONE + (size_t)nt * (128 * D * 2); u.b1 = wu + (size_t)e * WEXP_ONE + (size_t)nt * (128 * D * 2);
        u.out = hid; u.ldc = DEXP; u.pm = mtg; u.pn = nt; u.e = e | (ml << 8); return true;
    }
    __device__ __forceinline__ int arow(const pg8::Unit& u, int r) const {
        const int e = u.e & 255, ml = u.e >> 8; const int cntv = __builtin_amdgcn_readfirstlane(tbl[33 + e]); int idx = ml * 256 + r; idx = idx < cntv ? idx : 0;
        return list[(size_t)e * LISTCAP + idx];
    }
};
struct Moe2Sched {
    static constexpr bool GATHER = false;
    const LAS int* tbl; const char* hid; const char* wd; char* yb; int G, c;
    __device__ __forceinline__ bool next(int i, pg8::Unit& u) const {
        const int MT = __builtin_amdgcn_readfirstlane(tbl[32]); const int U = MT * 8; const long L = (long)i * G + c; if (L >= U) return false;
        int wgid = (int)L; { const int q = U / 8, r = U % 8, xcd = wgid % 8, off = wgid / 8; wgid = (xcd < r ? xcd * (q + 1) : r * (q + 1) + (xcd - r) * q) + off; }
        const int mtg = wgid >> 3, pn = wgid & 7; int e = 0;
        for (int k = 1; k < 32; ++k) e += (__builtin_amdgcn_readfirstlane(tbl[k]) <= mtg) ? 1 : 0;
        e = __builtin_amdgcn_readfirstlane(e);
        u.a = hid + (size_t)mtg * (256 * DEXP * 2); u.b0 = wd + (size_t)e * WEXP_ONE + (size_t)pn * (256 * DEXP * 2); u.b1 = u.b0 + (size_t)128 * DEXP * 2;
        u.out = yb; u.ldc = D; u.pm = mtg; u.pn = pn; u.e = e; return true;
    }
    __device__ __forceinline__ int arow(const pg8::Unit&, int r) const { return r; }
};
struct KVSched {
    static constexpr bool GATHER = false;
    const char* memn; const char* wk; const char* wv; char* kx; char* vx; int G, c;
    __device__ __forceinline__ bool next(int i, pg8::Unit& u) const {
        const int j = ((c + G - (G >> 1)) % G) + i * G; if (j >= 32) return false;
        const int l = j >> 4, kv = (j >> 3) & 1, idx = j & 7;
        u.a = memn + (size_t)l * (NMEM * D * 2);
        const char* wb = (kv ? wv : wk) + (size_t)l * ((size_t)D * D * 2) + (size_t)idx * (256 * D * 2);
        u.b0 = wb; u.b1 = wb + (size_t)128 * D * 2; u.out = (kv ? vx : kx) + (size_t)l * (NMEM * D * 2); u.ldc = D; u.pm = 0; u.pn = idx; u.e = 0; return true;
    }
    __device__ __forceinline__ int arow(const pg8::Unit&, int r) const { return r; }
};

__device__ __forceinline__ void mlstm_prep(LAS unsigned char* lds, int h, const float* gates, float* bcum, float* gi, float* marr, float* aprev, float* blg) {
    const int tid = fresh_tid(), lane = tid & 63, wave = tid >> 6;
    LAS float* bl = (LAS float*)lds; LAS float* dm = bl + 64;
    for (int c = wave; c < NCH; c += NWAVES) {
        const int t = c * CH + 2 * lane;
        const float i0 = gates[(size_t)t * 8 + h], i1 = gates[(size_t)(t + 1) * 8 + h], f0 = gates[(size_t)t * 8 + 4 + h], f1 = gates[(size_t)(t + 1) * 8 + 4 + h];
        const float l0 = logsigf(f0), l1 = logsigf(f1);
        float p = l0 + l1;
#pragma unroll
        for (int o = 1; o < 64; o <<= 1) { const float n = __shfl_up(p, o); if (lane >= o) p += n; }
        const float bc1 = p, bc0 = p - l1, blast = __shfl(p, 63);
        bcum[(size_t)t * 4 + h] = bc0; bcum[(size_t)(t + 1) * 4 + h] = bc1;
        gi[(size_t)t * 4 + h] = i0 - bc0; gi[(size_t)(t + 1) * 4 + h] = i1 - bc1;
        const float d = wave_max(fmaxf(blast - bc0 + i0, blast - bc1 + i1));
        if (lane == 0) { bl[c] = blast; dm[c] = d; }
    }
    __syncthreads();
    if (tid == 0) {
        float m = 0.f;
        for (int c = 0; c < NCH; ++c) { marr[h * 65 + c] = m; const float b = bl[c], mn = fmaxf(b + m, dm[c]); aprev[h * 64 + c] = expf(b + m - mn); blg[h * 64 + c] = b; m = mn; }
        marr[h * 65 + NCH] = m;
    }
    __syncthreads();
}

__device__ __forceinline__ void mlstm_B(LAS unsigned char* lds, int c, int h, const bf16_t* Z, const float* gi, const float* marr, const float* blg, float* KC, float* KN) {
    constexpr int RS = (DH + 16) * 2;
    const int tid = fresh_tid(), lane = tid & 63, wave = __builtin_amdgcn_readfirstlane(tid >> 6), fr = lane & 15, fq = lane >> 4;
    LAS unsigned char* Vt = lds; LAS unsigned char* Kt = lds + CH * RS; LAS float* asc = (LAS float*)(lds + 2 * CH * RS);
    const int t0 = c * CH;
    __syncthreads();
    if (tid < CH) asc[tid] = expf(blg[h * 64 + c] + gi[(size_t)(t0 + tid) * 4 + h] - marr[h * 65 + c + 1]);
    __syncthreads();
    stage_tile<CH, DH, 16>(Vt, Z + (size_t)t0 * EVN + 3072 + h * DH, EVN, tid);
    {
        u32x4 v[8];
#pragma unroll
        for (int i = 0; i < 8; ++i) { const int idx = tid + i * NTHR, r = idx >> 5, cc = idx & 31; v[i] = *(const u32x4*)(Z + (size_t)(t0 + r) * EVN + 2048 + h * DH + cc * 8); }
#pragma unroll
        for (int i = 0; i < 8; ++i) { const int idx = tid + i * NTHR, r = idx >> 5, cc = idx & 31; const float s = asc[r]; u32x4 o;
            o.x = cvt_pk_bf16(bf_lo(v[i].x) * s, bf_hi(v[i].x) * s); o.y = cvt_pk_bf16(bf_lo(v[i].y) * s, bf_hi(v[i].y) * s);
            o.z = cvt_pk_bf16(bf_lo(v[i].z) * s, bf_hi(v[i].z) * s); o.w = cvt_pk_bf16(bf_lo(v[i].w) * s, bf_hi(v[i].w) * s);
            *(LAS u32x4*)(Kt + r * RS + cc * 16) = o; }
    }
    __syncthreads();
    const int wr2 = wave >> 2, wc2 = wave & 3;
    f32x4 acc[8][4];
#pragma unroll
    for (int mi = 0; mi < 8; ++mi)
#pragma unroll
        for (int nj = 0; nj < 4; ++nj) acc[mi][nj] = (f32x4){0.f, 0.f, 0.f, 0.f};
#pragma unroll
    for (int ks = 0; ks < 4; ++ks) {
        bf16x8 bk[4];
#pragma unroll
        for (int nj = 0; nj < 4; ++nj) bk[nj] = tr_frag(Kt, RS, 32 * ks, 64 * wc2 + 16 * nj, lane);
#pragma unroll
        for (int mi = 0; mi < 8; ++mi) { const bf16x8 av = tr_frag(Vt, RS, 32 * ks, 128 * wr2 + 16 * mi, lane);
#pragma unroll
            for (int nj = 0; nj < 4; ++nj) acc[mi][nj] = MFMA16(bk[nj], av, acc[mi][nj]); }
    }
#define ACC8(m) "+v"(acc[m][0]), "+v"(acc[m][1]), "+v"(acc[m][2]), "+v"(acc[m][3]), "+v"(acc[m + 1][0]), "+v"(acc[m + 1][1]), "+v"(acc[m + 1][2]), "+v"(acc[m + 1][3])
    asm volatile("s_nop 0" : ACC8(0), ACC8(2)); asm volatile("s_nop 0" : ACC8(4), ACC8(6));
    asm volatile("s_nop 7\n\ts_nop 7\n\ts_nop 7" : ACC8(0), ACC8(2)); asm volatile("s_nop 0" : ACC8(4), ACC8(6));
#undef ACC8
    bf16_t* kc = (bf16_t*)KC + (size_t)(c * NH + h) * DH * DH;
#pragma unroll
    for (int mi = 0; mi < 8; ++mi)
#pragma unroll
        for (int nj = 0; nj < 4; ++nj) { u32x2 w; w.x = cvt_pk_bf16(acc[mi][nj][0], acc[mi][nj][1]); w.y = cvt_pk_bf16(acc[mi][nj][2], acc[mi][nj][3]);
            *(u32x2*)(kc + (size_t)(128 * wr2 + 16 * mi + fr) * DH + 64 * wc2 + 16 * nj + 4 * fq) = w; }
    if (tid < DH) { float s = 0.f; for (int r = 0; r < CH; ++r) s += bf2f(*(const LAS unsigned short*)(Kt + r * RS + tid * 2)); KN[(size_t)(c * NH + h) * DH + tid] = s; }
}

__device__ __forceinline__ void mlstm_scan(const float* KC, const float* KN, const float* aprev, bf16_t* CST, float* NST, int G) {
    const int gid = fresh_bx() * NTHR + fresh_tid(), NT = G * NTHR;
    for (int p = gid; p < NH * DH * DH / 2; p += NT) {
        const int h = p / (DH * DH / 2); const size_t e2 = (size_t)(p % (DH * DH / 2)) * 2;
        float s0 = 0.f, s1 = 0.f;
#pragma unroll 1
        for (int c0 = 0; c0 < NCH; c0 += 32) {
            unsigned k[32]; float ap[32];
#pragma unroll
            for (int j = 0; j < 32; ++j) { k[j] = *(const unsigned*)((const bf16_t*)KC + (size_t)((c0 + j) * NH + h) * DH * DH + e2); ap[j] = aprev[h * 64 + c0 + j]; }
#pragma unroll
            for (int j = 0; j < 32; ++j) { const size_t o = (size_t)((c0 + j) * NH + h) * DH * DH + e2;
                *(unsigned*)(CST + o) = cvt_pk_bf16(s0, s1);
                s0 = ap[j] * s0 + bf_lo(k[j]); s1 = ap[j] * s1 + bf_hi(k[j]); }
        }
    }
    for (int p = gid; p < NH * DH; p += NT) {
        const int h = p / DH, dk = p % DH; float s = 0.f;
#pragma unroll 1
        for (int c0 = 0; c0 < NCH; c0 += 32) {
            float kn[32], ap[32];
#pragma unroll
            for (int j = 0; j < 32; ++j) { kn[j] = KN[(size_t)((c0 + j) * NH + h) * DH + dk]; ap[j] = aprev[h * 64 + c0 + j]; }
#pragma unroll
            for (int j = 0; j < 32; ++j) { NST[(size_t)((c0 + j) * NH + h) * DH + dk] = s; s = ap[j] * s + kn[j]; }
        }
    }
}

__device__ __forceinline__ void mlstm_D(LAS unsigned char* lds, int c, int h, const bf16_t* Z, const float* gi, const float* bcum, const float* marr, const bf16_t* CST, const float* NST,
                                        const float* hgain, bf16_t* YCAT) {
    constexpr int XOFF = 0, XBYTES = 69632, POFF = XBYTES, PRS = (CH + 8) * 2, SOFF = POFF + 8 * 16 * PRS;
    const int tid = fresh_tid(), lane = tid & 63, wave = __builtin_amdgcn_readfirstlane(tid >> 6), fr = lane & 15, fq = lane >> 4;
    LAS unsigned char* X = lds + XOFF; LAS unsigned char* Pw = lds + POFF + wave * 16 * PRS;
    LAS float* gS = (LAS float*)(lds + SOFF); LAS float* Mrow = gS + CH; LAS float* nst = Mrow + CH;
    const int t0 = c * CH; const float mc = marr[h * 65 + c];
    __syncthreads();
    if (tid < CH) gS[tid] = gi[(size_t)(t0 + tid) * 4 + h];
    else if (tid < CH + DH) nst[tid - CH] = NST[(size_t)(c * NH + h) * DH + (tid - CH)];
    __syncthreads();
    if (tid < CH) { float m = mc; for (int s = 0; s <= tid; ++s) m = fmaxf(m, gS[s]); Mrow[tid] = m; }
    stage_tile<CH, DH, 8>(X, Z + (size_t)t0 * EVN + 2048 + h * DH, EVN, tid);
    const int tl = 16 * wave + fr; const size_t trow = (size_t)(t0 + tl);
    bf16x8 aq[8];
#pragma unroll
    for (int ks = 0; ks < 8; ++ks) aq[ks] = *(const bf16x8*)(Z + trow * EVN + 1024 + h * DH + 32 * ks + 8 * fq);
    __syncthreads();
    f32x4 S[8];
#pragma unroll
    for (int j = 0; j < 8; ++j) S[j] = (f32x4){0.f, 0.f, 0.f, 0.f};
#pragma unroll
    for (int ks = 0; ks < 8; ++ks)
        {
#pragma unroll
          for (int j = 0; j < 8; ++j) if (j <= wave) S[j] = MFMA16(row_frag(X, (DH + 8) * 2, 16 * j, 32 * ks, lane), aq[ks], S[j]);
          asm volatile("" ::: "memory"); }
    float nq = 0.f;
#pragma unroll
    for (int ks = 0; ks < 8; ++ks)
#pragma unroll
        for (int e = 0; e < 8; ++e) nq += bf2f((unsigned short)aq[ks][e]) * nst[32 * ks + 8 * fq + e];
    nq += __shfl_xor(nq, 16); nq += __shfl_xor(nq, 32);
    const float Mt = Mrow[tl]; const float SC = 0.0625f; const float wi = expf(mc - Mt) * SC;
    float rsum = 0.f;
#pragma unroll
    for (int j = 0; j < 8; ++j) { float pv[4];
#pragma unroll
        for (int i = 0; i < 4; ++i) { const int s = 16 * j + 4 * fq + i; const float p = (s <= tl) ? S[j][i] * SC * expf(gS[s] - Mt) : 0.f; pv[i] = p; rsum += p; }
        u32x2 w; w.x = cvt_pk_bf16(pv[0], pv[1]); w.y = cvt_pk_bf16(pv[2], pv[3]);
        *(LAS u32x2*)(Pw + fr * PRS + (16 * j + 4 * fq) * 2) = w; }
    rsum += __shfl_xor(rsum, 16); rsum += __shfl_xor(rsum, 32);
    const float den = wi * nq + rsum;
    f32x4 acc[16];
#pragma unroll
    for (int j = 0; j < 16; ++j) acc[j] = (f32x4){0.f, 0.f, 0.f, 0.f};
    const bf16_t* cst = CST + (size_t)(c * NH + h) * DH * DH;
#pragma unroll
    for (int half = 0; half < 2; ++half) {
        __syncthreads();
        stage_tile<DH, 128, 8>(X, cst + half * 128, DH, tid);
        __syncthreads();
#pragma unroll
        for (int ks = 0; ks < 4; ++ks)
            { const bf16x8 aqh = *(const bf16x8*)(Z + trow * EVN + 1024 + h * DH + 32 * (half * 4 + ks) + 8 * fq);
#pragma unroll
              for (int j = 0; j < 16; ++j) acc[j] = MFMA16(row_frag(X, (128 + 8) * 2, 16 * j, 32 * ks, lane), aqh, acc[j]);
              asm volatile("" ::: "memory"); }
    }
#pragma unroll
    for (int j = 0; j < 16; ++j) acc[j] = acc[j] * wi;
    __syncthreads();
    stage_tile<CH, DH, 16>(X, Z + (size_t)t0 * EVN + 3072 + h * DH, EVN, tid);
    __syncthreads();
#pragma unroll 1
    for (int ks = 0; ks < 4; ++ks) { const bf16x8 ap = *(const LAS bf16x8*)(Pw + fr * PRS + (32 * ks + 8 * fq) * 2);
#pragma unroll
        for (int j = 0; j < 16; ++j) acc[j] = MFMA16(tr_frag(X, (DH + 16) * 2, 32 * ks, 16 * j, lane), ap, acc[j]); }
    const float mt = bcum[trow * 4 + h] + Mt; const float inv = 1.0f / fmaxf(fabsf(den), expf(-mt));
    float ss = 0.f;
#pragma unroll
    for (int j = 0; j < 16; ++j) { acc[j] = acc[j] * inv; ss += (acc[j][0] * acc[j][0] + acc[j][1] * acc[j][1]) + (acc[j][2] * acc[j][2] + acc[j][3] * acc[j][3]); }
    ss += __shfl_xor(ss, 16); ss += __shfl_xor(ss, 32);
    const float rs = rsqrtf(ss * (1.0f / DH) + EPS);
#pragma unroll
    for (int j = 0; j < 16; j += 2) { u32x2 ab[2];
#pragma unroll
        for (int n = 0; n < 2; ++n) { const int col = h * DH + 16 * (j + n) + 4 * fq;
            const f32x4 gn = *(const f32x4*)(hgain + col); const u32x2 ov = *(const u32x2*)(Z + trow * EVN + 4096 + col);
            const float o0 = bf_lo(ov.x), o1 = bf_hi(ov.x), o2 = bf_lo(ov.y), o3 = bf_hi(ov.y);
            const float y0 = acc[j + n][0] * rs * gn[0] / (1.0f + expf(-o0)), y1 = acc[j + n][1] * rs * gn[1] / (1.0f + expf(-o1));
            const float y2 = acc[j + n][2] * rs * gn[2] / (1.0f + expf(-o2)), y3 = acc[j + n][3] * rs * gn[3] / (1.0f + expf(-o3));
            ab[n].x = cvt_pk_bf16(y0, y1); ab[n].y = cvt_pk_bf16(y2, y3); }
        const bool odd = fq & 1; const u32x2 give = odd ? ab[0] : ab[1];
        u32x2 got; got.x = (unsigned)__shfl_xor((int)give.x, 16); got.y = (unsigned)__shfl_xor((int)give.y, 16);
        u32x4 w; if (odd) { w.x = got.x; w.y = got.y; w.z = ab[1].x; w.w = ab[1].y; } else { w.x = ab[0].x; w.y = ab[0].y; w.z = got.x; w.w = got.y; }
        *(u32x4*)(YCAT + trow * D + 1024 + h * DH + 16 * (j + (odd ? 1 : 0)) + 4 * (fq & 2)) = w; if ((j & 3) == 2) asm volatile("" ::: "memory"); }
}

__device__ __forceinline__ void pool_diffs(const bf16_t* Z, bf16_t* DP, int G) {
    const int gid = fresh_bx() * NTHR + fresh_tid(), NT = G * NTHR;
    for (int it = gid; it < T * 128; it += NT) {
        const int t = it >> 7, col = (it & 127) * 8, w = 2 << (col >> 8), cnt = (t + 1 < w) ? t + 1 : w;
        float s[8];
#pragma unroll
        for (int e = 0; e < 8; ++e) s[e] = 0.f;
        u32x4 v = (u32x4){0u, 0u, 0u, 0u};
        for (int k = cnt - 1; k >= 0; --k) { v = *(const u32x4*)(Z + (size_t)(t - k) * EVN + col);
            s[0] += bf_lo(v.x); s[1] += bf_hi(v.x); s[2] += bf_lo(v.y); s[3] += bf_hi(v.y); s[4] += bf_lo(v.z); s[5] += bf_hi(v.z); s[6] += bf_lo(v.w); s[7] += bf_hi(v.w); }
        const float ic = 1.0f / (float)cnt; u32x4 o;
        o.x = cvt_pk_bf16(s[0] * ic - bf_lo(v.x), s[1] * ic - bf_hi(v.x)); o.y = cvt_pk_bf16(s[2] * ic - bf_lo(v.y), s[3] * ic - bf_hi(v.y));
        o.z = cvt_pk_bf16(s[4] * ic - bf_lo(v.z), s[5] * ic - bf_hi(v.z)); o.w = cvt_pk_bf16(s[6] * ic - bf_lo(v.w), s[7] * ic - bf_hi(v.w));
        *(u32x4*)(DP + (size_t)t * 1024 + col) = o;
    }
}
__device__ __forceinline__ void conv_gate(const bf16_t* ZB, const bf16_t* ZC, const float* cw, bf16_t* Y, int G) {
    const int gid = fresh_bx() * NTHR + fresh_tid(), NT = G * NTHR;
    for (int it = gid; it < T * 256; it += NT) {
        const int t = it >> 8, col = (it & 255) * 8; const size_t o = (size_t)t * D + col;
        const u32x4 z0 = *(const u32x4*)(ZC + o), gb = *(const u32x4*)(ZB + o);
        const u32x4 z1 = (t >= 1) ? *(const u32x4*)(ZC + o - D) : (u32x4){0u, 0u, 0u, 0u}, z2 = (t >= 2) ? *(const u32x4*)(ZC + o - 2 * D) : (u32x4){0u, 0u, 0u, 0u};
        const f32x4 wa0 = *(const f32x4*)(cw + col), wa1 = *(const f32x4*)(cw + col + 4), wb0 = *(const f32x4*)(cw + D + col), wb1 = *(const f32x4*)(cw + D + col + 4),
                    wc0 = *(const f32x4*)(cw + 2 * D + col), wc1 = *(const f32x4*)(cw + 2 * D + col + 4);
        float r[8];
        r[0] = bf_lo(gb.x) * (wa0[0] * bf_lo(z2.x) + wb0[0] * bf_lo(z1.x) + wc0[0] * bf_lo(z0.x)); r[1] = bf_hi(gb.x) * (wa0[1] * bf_hi(z2.x) + wb0[1] * bf_hi(z1.x) + wc0[1] * bf_hi(z0.x));
        r[2] = bf_lo(gb.y) * (wa0[2] * bf_lo(z2.y) + wb0[2] * bf_lo(z1.y) + wc0[2] * bf_lo(z0.y)); r[3] = bf_hi(gb.y) * (wa0[3] * bf_hi(z2.y) + wb0[3] * bf_hi(z1.y) + wc0[3] * bf_hi(z0.y));
        r[4] = bf_lo(gb.z) * (wa1[0] * bf_lo(z2.z) + wb1[0] * bf_lo(z1.z) + wc1[0] * bf_lo(z0.z)); r[5] = bf_hi(gb.z) * (wa1[1] * bf_hi(z2.z) + wb1[1] * bf_hi(z1.z) + wc1[1] * bf_hi(z0.z));
        r[6] = bf_lo(gb.w) * (wa1[2] * bf_lo(z2.w) + wb1[2] * bf_lo(z1.w) + wc1[2] * bf_lo(z0.w)); r[7] = bf_hi(gb.w) * (wa1[3] * bf_hi(z2.w) + wb1[3] * bf_hi(z1.w) + wc1[3] * bf_hi(z0.w));
        u32x4 w; w.x = cvt_pk_bf16(r[0], r[1]); w.y = cvt_pk_bf16(r[2], r[3]); w.z = cvt_pk_bf16(r[4], r[5]); w.w = cvt_pk_bf16(r[6], r[7]);
        *(u32x4*)(Y + o) = w;
    }
}

__device__ __forceinline__ void xattn_unit(LAS unsigned char* lds, int hd, int qt, const bf16_t* QX, const bf16_t* KX, const bf16_t* VX, bf16_t* O) {
    constexpr int XBYTES = 73728, PRS = (NMEM + 8) * 2;
    const int tid = fresh_tid(), lane = tid & 63, wave = __builtin_amdgcn_readfirstlane(tid >> 6), fr = lane & 15, fq = lane >> 4;
    LAS unsigned char* X = lds; LAS unsigned char* Pw = lds + XBYTES + wave * 16 * PRS;
    const size_t trow = (size_t)qt * 128 + 16 * wave + fr;
    f32x4 S[16];
#pragma unroll
    for (int j = 0; j < 16; ++j) S[j] = (f32x4){0.f, 0.f, 0.f, 0.f};
    u32x4 pf[8];
    stage_load<NMEM, 128>(pf, KX + hd * XD, D, tid);
#pragma unroll 1
    for (int kc = 0; kc < 4; ++kc) {
        __syncthreads();
        stage_store<NMEM, 128, 8>(X, pf, tid);
        bf16x8 aq[4];
#pragma unroll
        for (int ks = 0; ks < 4; ++ks) aq[ks] = *(const bf16x8*)(QX + trow * D + hd * XD + kc * 128 + 32 * ks + 8 * fq);
        if (kc < 3) stage_load<NMEM, 128>(pf, KX + hd * XD + (kc + 1) * 128, D, tid);
        __syncthreads();
#pragma unroll
        for (int ks = 0; ks < 4; ++ks)
#pragma unroll
            for (int j = 0; j < 16; ++j) S[j] = MFMA16(row_frag(X, (128 + 8) * 2, 16 * j, 32 * ks, lane), aq[ks], S[j]);
    }
    float mx = -INFINITY;
#pragma unroll
    for (int j = 0; j < 16; ++j) mx = fmaxf(mx, fmaxf(fmaxf(S[j][0], S[j][1]), fmaxf(S[j][2], S[j][3])));
    mx = fmaxf(mx, __shfl_xor(mx, 16)); mx = fmaxf(mx, __shfl_xor(mx, 32));
    const float SC = 0.044194173824159216f;
    float sum = 0.f;
#pragma unroll
    for (int j = 0; j < 16; ++j) { float pv[4];
#pragma unroll
        for (int i = 0; i < 4; ++i) { pv[i] = __expf((S[j][i] - mx) * SC); sum += pv[i]; }
        u32x2 w; w.x = cvt_pk_bf16(pv[0], pv[1]); w.y = cvt_pk_bf16(pv[2], pv[3]);
        *(LAS u32x2*)(Pw + fr * PRS + (16 * j + 4 * fq) * 2) = w; }
    sum += __shfl_xor(sum, 16); sum += __shfl_xor(sum, 32);
    const float inv = 1.0f / sum;
    asm volatile("s_waitcnt lgkmcnt(0)" ::: "memory");
    stage_load<NMEM, 128>(pf, VX + hd * XD, D, tid);
    bf16x8 ap[8];
#pragma unroll
    for (int ks = 0; ks < 8; ++ks) ap[ks] = *(const LAS bf16x8*)(Pw + fr * PRS + (32 * ks + 8 * fq) * 2);
#pragma unroll 1
    for (int vc = 0; vc < 4; ++vc) {
        __syncthreads();
        stage_store<NMEM, 128, 16>(X, pf, tid);
        if (vc < 3) stage_load<NMEM, 128>(pf, VX + hd * XD + (vc + 1) * 128, D, tid);
        __syncthreads();
        f32x4 oa[8];
#pragma unroll
        for (int j = 0; j < 8; ++j) oa[j] = (f32x4){0.f, 0.f, 0.f, 0.f};
#pragma unroll
        for (int ks = 0; ks < 8; ++ks)
#pragma unroll
            for (int j = 0; j < 8; ++j) oa[j] = MFMA16(tr_frag(X, (128 + 16) * 2, 32 * ks, 16 * j, lane), ap[ks], oa[j]);
#pragma unroll
        for (int j = 0; j < 8; j += 2) { u32x2 a, b; a.x = cvt_pk_bf16(oa[j][0] * inv, oa[j][1] * inv); a.y = cvt_pk_bf16(oa[j][2] * inv, oa[j][3] * inv);
            b.x = cvt_pk_bf16(oa[j + 1][0] * inv, oa[j + 1][1] * inv); b.y = cvt_pk_bf16(oa[j + 1][2] * inv, oa[j + 1][3] * inv);
            const bool odd = fq & 1; const u32x2 give = odd ? a : b;
            u32x2 got; got.x = (unsigned)__shfl_xor((int)give.x, 16); got.y = (unsigned)__shfl_xor((int)give.y, 16);
            u32x4 w; if (odd) { w.x = got.x; w.y = got.y; w.z = b.x; w.w = b.y; } else { w.x = a.x; w.y = a.y; w.z = got.x; w.w = got.y; }
            *(u32x4*)(O + trow * D + hd * XD + vc * 128 + 16 * (j + (odd ? 1 : 0)) + 4 * (fq & 2)) = w; }
    }
}

__device__ __forceinline__ float vec_elem_f32(u32x4 v, int j) { const unsigned u = v[j]; return __builtin_bit_cast(float, u); }
__device__ __forceinline__ void glds4(const char* base, unsigned voff, unsigned lds_dst) {
    unsigned keep;
    asm volatile("s_mov_b32 %0, m0\n\ts_mov_b32 m0, %3\n\ts_nop 0\n\tglobal_load_lds_dword %1, %2\n\ts_mov_b32 m0, %0" : "=&s"(keep) : "v"(voff), "s"(base), "s"(lds_dst) : "memory");
}
struct MoeDesc { int valid, e, sl, t0, nt, cnt, slot0; const char* Ab; bf16_t* out; const float* W0; const float* W1; };
template <int MODE, int NMT, int ABL>
__device__ __forceinline__ void moe_unit(LAS unsigned char* lds, const char* Abase, u32x4 wrsrc, unsigned wsoff, int bvoff, const unsigned (&voff)[6], unsigned asb, bf16_t* out, int w, int fr, int fq, int bwoff, int bsw,
                                         const LAS unsigned char* pa0, const LAS unsigned char* pa1, const LAS unsigned char* pb0, const LAS unsigned char* pb1,
                                         int t0, int cnt, int slot0, int sl,
                                         bool pre, u32x4 (&bst)[2][4], u32x4 wrsrc_n, unsigned wsoff_n, const char* Abase_n, const LAS int* stash, unsigned kco0, unsigned kco1, const LAS float* gtab, const LAS float* rstash) {
    constexpr int K = (MODE == 2) ? DEXP : D, KS = K / 64, LDA = K, NW = (MODE == 1) ? DEXP : D, LDO = (MODE == 1) ? DEXP : D;
    constexpr int BS_OFF = 0, AS_OFF = 32768, AW = 6144;
        f32x4 acc[NMT][8];
#pragma unroll
        for (int mi = 0; mi < NMT; ++mi)
#pragma unroll
            for (int j = 0; j < 8; ++j) acc[mi][j] = (f32x4){0.f, 0.f, 0.f, 0.f};
        constexpr unsigned BSTEP = 64u * NW * 4u;
#define MOE_LOADB(set, rs, so) do { if constexpr (ABL == 2) break; const unsigned _so = (so); _Pragma("unroll") for (int kk = 0; kk < 4; ++kk) \
            asm volatile("buffer_load_dwordx4 %0, %1, %2, %3 offen" : "=v"(bst[set][kk]) : "v"(bvoff), "s"(rs), "s"(_so + (unsigned)kk * (NW * 4u)) : "memory"); } while (0)
#define MOE_WAITB(set, n) asm volatile("s_waitcnt vmcnt(%4)" : "+v"(bst[set][0]), "+v"(bst[set][1]), "+v"(bst[set][2]), "+v"(bst[set][3]) : "n"(n) : "memory")
#define MOE_DMAA(buf, step) do { if constexpr (ABL == 2) break; _Pragma("unroll") for (int q = 0; q < 2 * NMT; ++q) glds16(Abase + (size_t)(step) * 128, voff[q], asb + (unsigned)(buf) * (8 * AW) + (unsigned)q * 1024u); } while (0)
#define MOE_WRITEB(set, buf, step) do { LAS unsigned char* _b = lds + BS_OFF + (buf) * 16384; \
        if constexpr (MODE == 1) { const f32x4 _g = *(const LAS f32x4*)(gtab + (step) * 64);     \
            _Pragma("unroll") for (int j = 0; j < 4; ++j) { u32x2 o; \
                o.x = cvt_pk_bf16(vec_elem_f32(bst[set][0], j) * _g[0], vec_elem_f32(bst[set][1], j) * _g[1]); o.y = cvt_pk_bf16(vec_elem_f32(bst[set][2], j) * _g[2], vec_elem_f32(bst[set][3], j) * _g[3]); \
                *(LAS u32x2*)(_b + bwoff + j * 128 + (((bsw) ^ (((j) >> 1) & 1)) * 16)) = o; } \
        } else { \
        _Pragma("unroll") for (int j = 0; j < 4; ++j) { u32x2 o; \
            o.x = cvt_pk_bf16(vec_elem_f32(bst[set][0], j), vec_elem_f32(bst[set][1], j)); o.y = cvt_pk_bf16(vec_elem_f32(bst[set][2], j), vec_elem_f32(bst[set][3], j)); \
            *(LAS u32x2*)(_b + bwoff + j * 128 + (((bsw) ^ (((j) >> 1) & 1)) * 16)) = o; } } } while (0)
#define MOE_COMPUTE(buf) do { if constexpr (ABL == 1) break; \
        _Pragma("unroll") for (int ks = 0; ks < 2; ++ks) { bf16x8 af[NMT]; const LAS unsigned char* _pa = (ks ? pa1 : pa0) + (buf) * (8 * AW); const LAS unsigned char* _pb = (ks ? pb1 : pb0) + (buf) * 16384; \
            _Pragma("unroll") for (int mi = 0; mi < NMT; ++mi) af[mi] = *(const LAS bf16x8*)(_pa + mi * 2048); \
            _Pragma("unroll") for (int j = 0; j < 8; ++j) { const bf16x8 bf = *(const LAS bf16x8*)(_pb + j * 2048); \
                _Pragma("unroll") for (int mi = 0; mi < NMT; ++mi) acc[mi][j] = MFMA16(bf, af[mi], acc[mi][j]); } } } while (0)
        if (!pre) {
            __syncthreads();
            MOE_LOADB(0, wrsrc, wsoff); MOE_LOADB(1, wrsrc, wsoff + BSTEP); MOE_DMAA(0, 0);
            asm volatile("s_waitcnt vmcnt(0)" : "+v"(bst[0][0]), "+v"(bst[0][1]), "+v"(bst[0][2]), "+v"(bst[0][3]), "+v"(bst[1][0]), "+v"(bst[1][1]), "+v"(bst[1][2]), "+v"(bst[1][3]) :: "memory");
            MOE_WRITEB(0, 0, 0);
            asm volatile("s_waitcnt lgkmcnt(0)" ::: "memory"); __builtin_amdgcn_s_barrier(); asm volatile("" ::: "memory");
        }
#pragma unroll 1
        for (int t = 0; t < KS; t += 2) {
            const bool nb = (t + 2 >= KS);
            { const u32x4 rs = nb ? wrsrc_n : wrsrc; const unsigned so = nb ? wsoff_n : wsoff + (unsigned)(t + 2) * BSTEP;
              MOE_DMAA(1, t + 1); MOE_LOADB(0, rs, so);
              asm volatile("s_waitcnt vmcnt(%0)" :: "n"(8 + 2 * NMT) : "memory");
              MOE_COMPUTE(0);
              MOE_WAITB(1, 4 + 2 * NMT);
              MOE_WRITEB(1, 1, t + 1);
              asm volatile("s_waitcnt lgkmcnt(0)" ::: "memory"); __builtin_amdgcn_s_barrier(); asm volatile("" ::: "memory"); }
            { const u32x4 rs = nb ? wrsrc_n : wrsrc; const unsigned so = nb ? wsoff_n + BSTEP : wsoff + (unsigned)(t + 3) * BSTEP;
              if (nb) {
                  unsigned vn[6];
#pragma unroll
                  for (int q = 0; q < 6; ++q) vn[q] = (unsigned)stash[q * 64] * (unsigned)(LDA * 2) + ((q & 1) ? kco1 : kco0);
#pragma unroll
                  for (int q = 0; q < 6; ++q) if constexpr (ABL != 2) glds16(Abase_n, vn[q], asb + (unsigned)q * 1024u);
              } else MOE_DMAA(0, t + 2);
              MOE_LOADB(1, rs, so);
              asm volatile("s_waitcnt vmcnt(%0)" :: "n"(8 + 2 * NMT) : "memory");
              MOE_COMPUTE(1);
              MOE_WAITB(0, 4 + 2 * NMT);
              MOE_WRITEB(0, 0, (nb ? 0 : t + 2));
              asm volatile("s_waitcnt lgkmcnt(0)" ::: "memory"); __builtin_amdgcn_s_barrier(); asm volatile("" ::: "memory"); }
        }
        MOE_WAITB(1, 0);
#pragma unroll
        for (int mi = 0; mi < NMT; ++mi) {
            const int prow = (t0 + mi * 8 + w) * 16 + fr;
            if (prow < cnt) {
                bf16_t* op = out + (size_t)(slot0 + prow) * LDO;
                if constexpr (MODE == 1) { const float rs = rstash[mi * 64];
#pragma unroll
                    for (int pp = 0; pp < 2; ++pp) { float r[8];
#pragma unroll
                        for (int n = 0; n < 2; ++n)
#pragma unroll
                            for (int i = 0; i < 4; ++i) { const float g = acc[mi][2 * pp + n][i] * rs, up = acc[mi][4 + 2 * pp + n][i] * rs; r[4 * n + i] = (g * __builtin_amdgcn_rcpf(1.0f + __expf(-g))) * up; }
                        u32x4 o; o.x = cvt_pk_bf16(r[0], r[1]); o.y = cvt_pk_bf16(r[2], r[3]); o.z = cvt_pk_bf16(r[4], r[5]); o.w = cvt_pk_bf16(r[6], r[7]);
                        *(u32x4*)(op + sl * 64 + 32 * pp + 8 * fq) = o; }
                } else {
#pragma unroll
                    for (int pp = 0; pp < 4; ++pp) { u32x4 o; o.x = cvt_pk_bf16(acc[mi][2 * pp][0], acc[mi][2 * pp][1]); o.y = cvt_pk_bf16(acc[mi][2 * pp][2], acc[mi][2 * pp][3]);
                        o.z = cvt_pk_bf16(acc[mi][2 * pp + 1][0], acc[mi][2 * pp + 1][1]); o.w = cvt_pk_bf16(acc[mi][2 * pp + 1][2], acc[mi][2 * pp + 1][3]);
                        *(u32x4*)(op + sl * 128 + 32 * pp + 8 * fq) = o; }
                }
            }
        }
#undef MOE_LOADB
#undef MOE_WAITB
#undef MOE_DMAA
#undef MOE_WRITEB
#undef MOE_COMPUTE
}
template <int MODE, int ABL = 0>
__device__ __forceinline__ void moe_phase(LAS unsigned char* lds, const int* list, const char* Abase, const float* W0, const float* W1, bf16_t* out, int G, int c, const float* gain = nullptr, const float* rsl = nullptr) {
    constexpr int K = (MODE == 2) ? DEXP : D, KS = K / 64, LDA = K, NW = (MODE == 1) ? DEXP : D  , LDO = (MODE == 1) ? DEXP : D;
    constexpr int BS_OFF = 0, AS_OFF = 32768, AW = 6144;
    const int tid = fresh_tid(), lane = tid & 63, w = __builtin_amdgcn_readfirstlane(tid >> 6), fr = lane & 15, fq = lane >> 4;
    const LAS int* tbl = (const LAS int*)(lds + TBL_OFF);
    const unsigned ldsb = (unsigned)__builtin_amdgcn_readfirstlane((int)(unsigned)(__UINTPTR_TYPE__)lds);
    const unsigned asb = ldsb + AS_OFF + (unsigned)w * AW;
    const int NU = (MODE == 3) ? 64 : __builtin_amdgcn_readfirstlane(tbl[MOE_PT_OFF + 32]) * 16;
    const int bL = lane & 15, bn = 32 * (2 * (w & 1) + (bL >> 3)) + 16 * (bL & 1) + 4 * ((bL & 7) >> 1), bk0 = 16 * (w >> 1), bk4 = lane >> 4;
    const int bkc = 2 * (w >> 1) + (bk4 >> 1);
    const int bwoff = bn * 128 + 8 * (bk4 & 1), bsw = bkc ^ ((bn >> 1) & 7);
    const int sw0 = (fq ^ ((fr >> 1) & 7)) * 16, sw1 = sw0 ^ 64;
    const LAS unsigned char* pa0 = lds + AS_OFF + w * AW + fr * 128 + sw0; const LAS unsigned char* pa1 = lds + AS_OFF + w * AW + fr * 128 + sw1;
    const LAS unsigned char* pb0 = lds + BS_OFF + fr * 128 + sw0; const LAS unsigned char* pb1 = lds + BS_OFF + fr * 128 + sw1;
    auto desc = [&](int ui) -> MoeDesc {
        MoeDesc d; d.valid = 0; d.e = 0; d.sl = 0; d.t0 = 0; d.nt = 0; d.cnt = 1; d.slot0 = 0; d.Ab = Abase; d.out = out; d.W0 = W0; d.W1 = W1;
        if constexpr (MODE == 3) {
            const int j = ((c + G - (G >> 1)) % G) + ui * G;
            if (j < NU) { const int l = j >> 5, kv = (j >> 4) & 1; d.sl = j & 15; d.cnt = NMEM; d.nt = NMEM / 16;
                d.Ab = Abase + (size_t)l * NMEM * D * 2; d.out = out + (size_t)(kv * 2 + l) * NMEM * D; d.W0 = (kv ? W1 : W0) + (size_t)l * D * D; d.valid = 1; }
        } else {
            const long L = (long)ui * G + c;
            if (L < NU) {
                int wg = (int)L; { const int q = NU / 8, r = NU % 8, xcd = wg % 8, off = wg / 8; wg = (xcd < r ? xcd * (q + 1) : r * (q + 1) + (xcd - r) * q) + off; }
                d.sl = wg & 15;
                const int pk = __builtin_amdgcn_readfirstlane(tbl[MOE_PARTS + (wg >> 4)]); const int e = pk & 31;
                d.e = e; d.t0 = (pk >> 5) & 1023; d.nt = pk >> 15;
                d.cnt = __builtin_amdgcn_readfirstlane(tbl[33 + e]);
                d.slot0 = __builtin_amdgcn_readfirstlane(tbl[e]) * 256;
                d.valid = 1;
            }
        }
        return d;
    };
    constexpr int STASH_OFF = AS_OFF + 2 * 8 * AW;
    LAS int* stash = (LAS int*)(lds + STASH_OFF + w * 1536) + lane;
    const unsigned stash_b = ldsb + STASH_OFF + (unsigned)w * 1536u;
    const unsigned kco0 = (unsigned)(((lane & 7) ^ (lane >> 4)) * 16), kco1 = (unsigned)(((lane & 7) ^ (4 + (lane >> 4))) * 16);
    auto fill = [&](const MoeDesc& d) {
#pragma unroll
        for (int q = 0; q < 6; ++q) { int idx = (d.t0 + (q >> 1) * 8 + w) * 16 + (q & 1) * 8 + (lane >> 3); idx = idx < d.cnt ? idx : 0;
            if constexpr (MODE == 1) glds4((const char*)list, (unsigned)(d.e * LISTCAP + idx) * 4u, stash_b + (unsigned)q * 256u);
            else stash[q * 64] = d.slot0 + idx; }
    };
    constexpr int GT_OFF = STASH_OFF + 8 * 1536, RS_OFF = GT_OFF + 8192;
    LAS float* gt = (LAS float*)(lds + GT_OFF);
    const LAS float* gtab = gt + bk0 + 4 * bk4;
    const LAS float* rstash = (const LAS float*)(lds + RS_OFF + w * 768) + lane;
    const unsigned rs_b = ldsb + RS_OFF + (unsigned)w * 768u;
    if constexpr (MODE == 1) { *(LAS f32x4*)(gt + 4 * tid) = *(const f32x4*)(gain + 4 * tid); }
    auto fill_rs = [&](const MoeDesc& d) {
        if constexpr (MODE == 1) {
#pragma unroll
            for (int mi = 0; mi < 3; ++mi) { int idx = (d.t0 + mi * 8 + w) * 16 + (lane & 15); idx = idx < d.cnt ? idx : 0;
                glds4((const char*)rsl, (unsigned)(d.e * LISTCAP + idx) * 4u, rs_b + (unsigned)mi * 256u); }
        }
    };
    MoeDesc cur = desc(0);
    if (cur.valid) {
    fill(cur);
    bool pre = false; u32x4 bst[2][4];
#pragma unroll 1
    for (int ui = 0;; ++ui) {
        const MoeDesc nxt = desc(ui + 1);
        if (MODE == 1 && !pre) asm volatile("s_waitcnt vmcnt(0)" ::: "memory");
        unsigned voff[6];
#pragma unroll
        for (int q = 0; q < 6; ++q) voff[q] = (unsigned)stash[q * 64] * (unsigned)(LDA * 2) + ((q & 1) ? kco1 : kco0);
        asm volatile("s_waitcnt lgkmcnt(0)" ::: "memory");
        if (nxt.valid) fill(nxt);
        fill_rs(cur);
        const int nt = cur.nt, nmt = (nt > 16 + w) ? 3 : (nt > 8 + w) ? 2 : (nt > w) ? 1 : 0;
        const MoeDesc& dn = nxt.valid ? nxt : cur;
        const float* wmat = ((MODE == 1 && (w & 1)) ? cur.W1 : cur.W0) + (size_t)cur.e * K * NW;
        const float* wmat_n = ((MODE == 1 && (w & 1)) ? dn.W1 : dn.W0) + (size_t)dn.e * K * NW;
        const unsigned long long wa = (unsigned long long)wmat, wan = (unsigned long long)wmat_n;
        const u32x4 wrsrc = {(unsigned)__builtin_amdgcn_readfirstlane((int)(unsigned)wa), (unsigned)__builtin_amdgcn_readfirstlane((int)(unsigned)(wa >> 32)) & 0xffffu, (unsigned)(K * NW * 4), 0x00020000u};
        const u32x4 wrsrc_n = {(unsigned)__builtin_amdgcn_readfirstlane((int)(unsigned)wan), (unsigned)__builtin_amdgcn_readfirstlane((int)(unsigned)(wan >> 32)) & 0xffffu, (unsigned)(K * NW * 4), 0x00020000u};
        const unsigned wsoff = (unsigned)__builtin_amdgcn_readfirstlane((bk0 * NW + ((MODE == 1) ? cur.sl * 64 : cur.sl * 128 + 64 * (w & 1))) * 4);
        const unsigned wsoff_n = (unsigned)__builtin_amdgcn_readfirstlane((bk0 * NW + ((MODE == 1) ? dn.sl * 64 : dn.sl * 128 + 64 * (w & 1))) * 4);
        const int bvoff = (4 * bk4 * NW + 4 * (lane & 15)) * 4;
#define MOE_CALL(N) moe_unit<MODE, N, ABL>(lds, cur.Ab, wrsrc, wsoff, bvoff, voff, asb, cur.out, w, fr, fq, bwoff, bsw, pa0, pa1, pb0, pb1, cur.t0, cur.cnt, cur.slot0, cur.sl, pre, bst, wrsrc_n, wsoff_n, dn.Ab, stash, kco0, kco1, gtab, rstash)
        if constexpr (MODE == 3) MOE_CALL(2);
        else if (nmt == 3) MOE_CALL(3);
        else if (nmt == 2) MOE_CALL(2);
        else MOE_CALL(1);
#undef MOE_CALL
        if (!nxt.valid) break;
        cur = nxt; pre = true;
    }
    asm volatile("s_waitcnt vmcnt(0)" ::: "memory");
    }
}

#ifndef MK_PER_PHASE
#define MK_PER_PHASE 0
#endif
#ifndef NEWMOE
#define NEWMOE 3
#endif
#ifndef PHMASK
#define PHMASK 0x3fff
#endif
#define PH(n) (((PHMASK) >> (n)) & 1)
#ifndef REPMASK
#define REPMASK 0
#endif
#define NREP(n) ((((REPMASK) >> (n)) & 1) ? 2 : 1)
#ifndef SUBMASK
#define SUBMASK 0xff
#endif
#define SUB(n) (((SUBMASK) >> (n)) & 1)
constexpr int NPH = 27;
struct Args { const float* in[27]; float* out; unsigned char* ws; int ph_lo, ph_hi, fused, pad; };

__global__ void __launch_bounds__(NTHR, 2) mk_fwd(Args args) {
    extern __shared__ __attribute__((aligned(16))) unsigned char lds_raw[];
    LAS unsigned char* lds0 = (LAS unsigned char*)lds_raw;
    const int tid = threadIdx.x, lane = tid & 63, wave = __builtin_amdgcn_readfirstlane(tid >> 6);
    unsigned* const ctl = (unsigned*)(args.ws + WS_CTL);
    for (int u = tid; u < (LDS_BYTES - MISC_OFF) / 4; u += NTHR) ((LAS unsigned*)(lds0 + MISC_OFF))[u] = 0u;
    __syncthreads();
    XcdBarrier bar; bar.bar = ctl + CW_BAR; bar.x = 0; bar.st = nullptr;
    if (args.fused) bar = xcd_barrier_post(ctl + CW_BAR, (volatile LAS unsigned*)(lds0 + MISC_OFF));
    const int lo = args.ph_lo;
#define IN(k) (args.fused || lo == (k))
#ifdef SEAM2X
#define SEAM() do { if (args.fused) { XcdBarrier b2 = bar; asm volatile("" : "+s"(b2.bar), "+s"(b2.x)); xcd_barrier(b2); xcd_barrier(b2); xcd_barrier(b2); } } while (0)
#else
#define SEAM() do { if (args.fused) { XcdBarrier b2 = bar; asm volatile("" : "+s"(b2.bar), "+s"(b2.x)); xcd_barrier(b2); } } while (0)
#endif

#define CAS __attribute__((address_space(4)))
#define KARG() ({ const CAS char* _k = (const CAS char*)__builtin_amdgcn_kernarg_segment_ptr(); asm volatile("" : "+s"(_k)); _k; })
#define INP(k) (*(const float* const CAS*)(ka + 8 * (k)))
#define hbuf (*(float* const CAS*)(ka + 216))
#define DEF_W LAS unsigned char* lds = lds0; asm volatile("" : "+s"(lds)); const LAS int* tbl = (const LAS int*)(lds + TBL_OFF); const int bx = fresh_bx(), G = fresh_s((int)gridDim.x); const CAS char* ka = KARG(); unsigned char* ws = *(unsigned char* const CAS*)(ka + 224);
#define W_EVIN ((bf16_t*)(ws + WS_WEVIN))
#define W_EVOUT ((bf16_t*)(ws + WS_WEVOUT))
#define W_ODIN ((bf16_t*)(ws + WS_WODIN))
#define W_ODOUT ((bf16_t*)(ws + WS_WODOUT))
#define W_XQ ((bf16_t*)(ws + WS_WXQ))
#define W_XK ((bf16_t*)(ws + WS_WXK))
#define W_XV ((bf16_t*)(ws + WS_WXV))
#define W_XO ((bf16_t*)(ws + WS_WXO))
#define W_POOL ((bf16_t*)(ws + WS_WPOOL))
#define MEMN ((bf16_t*)(ws + WS_MEMN))
#define KX ((bf16_t*)(ws + WS_KX))
#define VX ((bf16_t*)(ws + WS_VX))
#define GATES ((float*)(ws + WS_SMALL + SM_GATES))
#define BCUM ((float*)(ws + WS_SMALL + SM_BCUM))
#define GI ((float*)(ws + WS_SMALL + SM_GI))
#define MARR ((float*)(ws + WS_SMALL + SM_MARR))
#define APREV ((float*)(ws + WS_SMALL + SM_APREV))
#define BLG ((float*)(ws + WS_SMALL + SM_BL))
#define KN ((float*)(ws + WS_SMALL + SM_KN))
#define NST ((float*)(ws + WS_SMALL + SM_NST))
#define HN ((bf16_t*)(ws + WS_HN))
#define Z ((bf16_t*)(ws + WS_Z))
#define YCAT ((bf16_t*)(ws + WS_YCAT))
#define DPOOL ((bf16_t*)(ws + WS_DPOOL))
#define KC ((float*)(ws + WS_KC))
#define CST ((bf16_t*)(ws + WS_CST))
#define QX ((bf16_t*)(ws + WS_QX))
#define OATT ((bf16_t*)(ws + WS_OATT))
#define HID ((bf16_t*)(ws + WS_HID))
#define H16 ((bf16_t*)(ws + WS_H16))
#define WRT ((bf16_t*)(ws + WS_WEXP))
#define YB ((bf16_t*)(ws + WS_YB))
#define LIST ((int*)(ws + WS_LIST + (size_t)layer * MiB))
#define RSTD1 ((float*)(ws + WS_WEXP + (size_t)10 * MiB))
#define RSL ((float*)(ws + WS_WEXP + (size_t)(8 + layer) * MiB))
#define TOKINFO ((int*)(ws + WS_TOKINFO + (size_t)layer * 256 * 1024))
#define WG ((const bf16_t*)(ws + WS_WEXP + (size_t)layer * WEXP_LAYER))
#define WU (WG + WEXP_MAT / 2)
#define WD (WG + WEXP_MAT)
#define x_in INP(0)
#define mem_in INP(1)
#define mix_norm INP(2)
#define xattn_norm INP(3)
#define mem_norm INP(4)
#define ffn_norm INP(5)
#define final_norm INP(6)
#define ev_w_in INP(7)
#define ev_b_gates INP(8)
#define ev_pool_w INP(9)
#define ev_pool_scale INP(10)
#define ev_head_norm INP(11)
#define ev_w_out INP(12)
#define od_w_in INP(13)
#define od_conv_w INP(14)
#define od_w_out INP(15)
#define xa_wq INP(16)
#define xa_wk INP(17)
#define xa_wv INP(18)
#define xa_wo INP(19)
#define rt_group_w INP(20)
#define rt_group_b INP(21)
#define rt_expert_w INP(22)
#define rt_expert_b INP(23)
#define ex_w_gate INP(24)
#define ex_w_up INP(25)
#define ex_w_down INP(26)

    constexpr int I_EVIN = (D / 64) * (EVN / 64), I_SQ = (D / 64) * (D / 64), I_ODIN = (D / 64) * (ODN / 64), I_POOL = 4 * 4 * 4;
    constexpr int NP_ITEMS = I_EVIN + I_POOL, NITEMS = NP_ITEMS + I_ODIN + 6 * I_SQ;
#define TRANSPOSE_ITEMS(first, stride, lo, hi) \
        for (int it = (lo) + (first); it < (hi); it += (stride)) { \
            int r = it; const float* src; int ldw, K, N; bf16_t* dst; const float* gain = nullptr; \
            if (r < I_EVIN) { src = ev_w_in; ldw = EVW; K = D; N = EVN; dst = W_EVIN; } \
            else if ((r -= I_EVIN) < I_POOL) { const int m = r / 16; r -= m * 16; src = ev_pool_w + (size_t)m * 65536; ldw = 256; K = 256; N = 256; dst = W_POOL + (size_t)m * 65536; } \
            else if ((r -= I_POOL) < I_SQ) { src = ev_w_out; ldw = D; K = D; N = D; dst = W_EVOUT; } \
            else if ((r -= I_SQ) < I_SQ) { src = xa_wq; ldw = D; K = D; N = D; dst = W_XQ; gain = xattn_norm; } \
            else if ((r -= I_SQ) < I_SQ) { src = xa_wo; ldw = D; K = D; N = D; dst = W_XO; } \
            else if ((r -= I_SQ) < I_ODIN) { src = od_w_in; ldw = ODN; K = D; N = ODN; dst = W_ODIN; gain = mix_norm + D; } \
            else if ((r -= I_ODIN) < I_SQ) { src = od_w_out; ldw = D; K = D; N = D; dst = W_ODOUT; } \
            else if ((r -= I_SQ) < I_SQ) { src = xa_wq + (size_t)D * D; ldw = D; K = D; N = D; dst = W_XQ + (size_t)D * D; gain = xattn_norm + D; } \
            else { r -= I_SQ; src = xa_wo + (size_t)D * D; ldw = D; K = D; N = D; dst = W_XO + (size_t)D * D; } \
            const int nbn = N / 64; \
            transpose_item64(src, ldw, K, dst, r / nbn, r % nbn, scr, lane, gain); }

    if (PH(13) && IN(0)) { DEF_W
        LAS float* scr = (LAS float*)(lds + wave * 16640);
        const int gw = bx * NWAVES + wave, NGW = G * NWAVES;
        for (int rep = 0; rep < NREP(13); ++rep) { TRANSPOSE_ITEMS(gw, NGW, 0, NP_ITEMS) }
        for (int r = gw; r < 2 * NMEM; r += NGW) { const int l = r >> 8, row = r & 255; const float* s = mem_in + (size_t)row * D; const float* g = mem_norm + (size_t)l * D;
            f32x4 v[8]; float ss = 0.f;
#pragma unroll
            for (int j = 0; j < 8; ++j) { v[j] = *(const f32x4*)(s + 4 * lane + 256 * j); ss += (v[j][0] * v[j][0] + v[j][1] * v[j][1]) + (v[j][2] * v[j][2] + v[j][3] * v[j][3]); }
            const float rs = rsqrtf(wave_sum(ss) * (1.0f / D) + EPS);
#pragma unroll
            for (int j = 0; j < 8; ++j) { const f32x4 gg = *(const f32x4*)(g + 4 * lane + 256 * j); const f32x4 y = v[j] * rs * gg; u32x2 w; w.x = cvt_pk_bf16(y[0], y[1]); w.y = cvt_pk_bf16(y[2], y[3]);
                *(u32x2*)(MEMN + (size_t)l * NMEM * D + (size_t)row * D + 4 * lane + 256 * j) = w; } }
        for (int idx = bx * NTHR + tid; idx < 2 * 48 * D; idx += G * NTHR) { const int l = idx / (48 * D), n = (idx / D) % 48, k = idx % D;
            float wv = 0.f;
            if (n < 32) wv = rt_expert_w[((size_t)l * D + k) * NEXP + n]; else if (n < 36) wv = rt_group_w[((size_t)l * D + k) * 4 + (n - 32)];
            wv *= ffn_norm[(size_t)l * D + k];
            const unsigned hi = cvt_pk_bf16(wv, 0.f) & 0xffffu; const float rem = wv - bf2f((unsigned short)hi); const unsigned lo = cvt_pk_bf16(rem, 0.f) & 0xffffu;
            WRT[((size_t)l * 2 + 0) * 48 * D + (size_t)n * D + k] = (bf16_t)hi; WRT[((size_t)l * 2 + 1) * 48 * D + (size_t)n * D + k] = (bf16_t)lo; }
        __syncthreads();
        RowArgs ra{}; ra.hin = x_in; ra.gain = mix_norm; ra.hn = HN; ra.wgate = ev_w_in; ra.bgate = ev_b_gates; ra.gates = GATES;
        row_phase<RM_GATES, false>(lds, ra, G);
        SEAM();
    }

    { constexpr int layer = 0;
        const int pb = 1 + 13 * layer;
#define cnt_p ((unsigned*)(ws + WS_CTL) + CW_CNT + layer * 32 * 64)
        if (PH(0) && IN(pb + 0)) { DEF_W
            for (int rep = 0; rep < NREP(0); ++rep) {
            if (layer == 0) {
                if (SUB(4)) for (int h = bx; h < NH; h += G) mlstm_prep(lds, h, GATES, BCUM, GI, MARR, APREV, BLG);
                if (SUB(0)) { pg8::DenseSched S{(const char*)HN, (size_t)256 * D * 2, 0, (const char*)W_EVIN, (const char*)W_EVIN + (size_t)128 * D * 2, (size_t)256 * D * 2, (char*)Z, EVN, T / 256, EVN / 256, G, bx};
                  pg8::EpiBf16 E{}; pg8::gemm_phase<pg8::EpiBf16, pg8::DenseSched, true>(lds, D, D, D, S, E); }
                if (SUB(1)) moe_phase<3>(lds, nullptr, (const char*)MEMN, xa_wk, xa_wv, KX, G, bx);
                if (SUB(1) && bx >= (G >> 1)) {
                    __syncthreads();
                    const int tid_ = fresh_tid(), lane = tid_ & 63, wave = __builtin_amdgcn_readfirstlane(tid_ >> 6);
                    LAS float* scr = (LAS float*)(lds + wave * 16640);
                    const int b = bx - (G >> 1), nbu = G - (G >> 1), nkv = nbu < 64 ? nbu : 64, WA = nkv * NWAVES, WB = (nbu - nkv) * NWAVES;
                    const int NL = NITEMS - NP_ITEMS, NA = (int)((long)NL * WA / (WA + 5 * WB));
                    if (b < nkv) { TRANSPOSE_ITEMS(b * NWAVES + wave, WA, NP_ITEMS, NP_ITEMS + NA) }
                    else { TRANSPOSE_ITEMS((b - nkv) * NWAVES + wave, WB, NP_ITEMS + NA, NITEMS) }
                }
            } else {
                if (SUB(2)) { pg8::DenseSched S{(const char*)H16, (size_t)256 * D * 2, 0, (const char*)W_ODIN, (const char*)W_ODIN + (size_t)128 * D * 2, (size_t)256 * D * 2, (char*)Z, D, T / 256, D / 256, G, bx};
                  pg8::EpiBf16Rs E{RSTD1}; pg8::gemm_phase<pg8::EpiBf16Rs, pg8::DenseSched, true>(lds, D, D, D, S, E); }
                if (SUB(3)) { pg8::DenseSched S{(const char*)H16, (size_t)256 * D * 2, 0, (const char*)W_ODIN + (size_t)2048 * D * 2, (const char*)W_ODIN + (size_t)4096 * D * 2, (size_t)128 * D * 2, (char*)(Z + (size_t)T * D), D, T / 256, D / 128, G, bx};
                  pg8::EpiPairRs E{RSTD1}; pg8::gemm_phase<pg8::EpiPairRs, pg8::DenseSched, true>(lds, D, D, D, S, E); }
            }
            }
            SEAM();
        }
        if (PH(1) && IN(pb + 1)) { DEF_W
            for (int rep = 0; rep < NREP(1); ++rep) {
            if (layer == 0) {
                for (int u = bx; u < NCH * NH; u += G) mlstm_B(lds, u >> 2, u & 3, Z, GI, MARR, BLG, KC, KN);
                pool_diffs(Z, DPOOL, G);
            } else conv_gate(Z, Z + (size_t)T * D, od_conv_w, YCAT, G);
            }
            SEAM();
        }
        if (PH(2) && layer == 0 && IN(pb + 2)) { DEF_W
            for (int rep = 0; rep < NREP(2); ++rep) {
            if (SUB(5)) mlstm_scan(KC, KN, APREV, CST, NST, G);
            if (SUB(6)) { pg8::DenseSched S{(const char*)DPOOL, (size_t)256 * 1024 * 2, (size_t)256 * 2, (const char*)W_POOL, (const char*)W_POOL + (size_t)128 * 256 * 2, (size_t)256 * 256 * 2, (char*)YCAT, D, T / 256, 4, G, bx};
              pg8::EpiBf16Scale E{ev_pool_scale}; pg8::gemm_phase<pg8::EpiBf16Scale, pg8::DenseSched, true>(lds, 256, 1024, 256, S, E); }
            }
            SEAM();
        }
        if (PH(3) && layer == 0 && IN(pb + 3)) { DEF_W
            for (int rep = 0; rep < NREP(3); ++rep) {
            for (int u = bx; u < NCH * NH; u += G) mlstm_D(lds, u >> 2, u & 3, Z, GI, BCUM, MARR, CST, NST, ev_head_norm, YCAT);
            }
            SEAM();
        }
        if (PH(4) && IN(pb + 4)) { DEF_W
            pg8::DenseSched S{(const char*)YCAT, (size_t)256 * D * 2, 0, (const char*)(layer == 0 ? W_EVOUT : W_ODOUT), (const char*)(layer == 0 ? W_EVOUT : W_ODOUT) + (size_t)128 * D * 2, (size_t)256 * D * 2, (char*)H16, D, T / 256, D / 256, G, bx};
            float* ssq = (float*)(ws + WS_SMALL + SM_SSQP) + (size_t)layer * T * 32;
            if (layer == 0) { pg8::EpiResSsq<false> E{(const void*)x_in, ssq}; pg8::gemm_phase<pg8::EpiResSsq<false>, pg8::DenseSched, true>(lds, D, D, D, S, E); }
            else { pg8::EpiResSsq<true> E{(const void*)H16, ssq}; pg8::gemm_phase<pg8::EpiResSsq<true>, pg8::DenseSched, true>(lds, D, D, D, S, E); }
            SEAM();
        }
        if (PH(6) && IN(pb + 6)) { DEF_W
            for (int rep = 0; rep < NREP(6); ++rep) {
            const bf16_t* W = W_XQ + (size_t)layer * D * D;
            pg8::DenseSched S{(const char*)H16, (size_t)256 * D * 2, 0, (const char*)W, (const char*)W + (size_t)128 * D * 2, (size_t)256 * D * 2, (char*)QX, D, T / 256, D / 256, G, bx};
            pg8::EpiBf16RowScale E{(const float*)(ws + WS_SMALL + SM_SSQP) + (size_t)layer * T * 32, 1.0f / D, EPS}; pg8::gemm_phase<pg8::EpiBf16RowScale, pg8::DenseSched, true>(lds, D, D, D, S, E);
            }
            SEAM();
        }
        if (PH(7) && IN(pb + 7)) { DEF_W
            for (int rep = 0; rep < NREP(7); ++rep) {
            for (int u = bx; u < XH * (T / 128); u += G) xattn_unit(lds, u & 3, u >> 2, QX, KX + (size_t)layer * NMEM * D, VX + (size_t)layer * NMEM * D, OATT);
            }
            SEAM();
        }
        if (PH(8) && IN(pb + 8)) { DEF_W
            const bf16_t* W = W_XO + (size_t)layer * D * D;
            pg8::DenseSched S{(const char*)OATT, (size_t)256 * D * 2, 0, (const char*)W, (const char*)W + (size_t)128 * D * 2, (size_t)256 * D * 2, (char*)H16, D, T / 256, D / 256, G, bx};
            pg8::EpiResSsq<true> E{(const void*)H16, nullptr}; pg8::gemm_phase<pg8::EpiResSsq<true>, pg8::DenseSched, true>(lds, D, D, D, S, E);
            SEAM();
        }
        if (PH(9) && IN(pb + 9)) { DEF_W
            RowArgs ra{}; ra.hin16 = H16; ra.gain = ffn_norm + (size_t)layer * D; ra.hn = HN;
            ra.rgw = rt_group_w + (size_t)layer * D * 4; ra.rgb = rt_group_b + layer * 4; ra.rew = rt_expert_w + (size_t)layer * D * NEXP; ra.reb = rt_expert_b + layer * NEXP;
            ra.cnt = cnt_p; ra.list = LIST; ra.tokinfo = TOKINFO; ra.wr = WRT + (size_t)layer * 2 * 48 * D; ra.rsl = RSL;
            row_phase<RM_ROUTE, false, true, false>(lds, ra, G);
            SEAM();
        }
        if (PH(10) && IN(pb + 10)) { DEF_W
            moe_tables(lds, cnt_p);
#if (NEWMOE & 1)
            moe_phase<1>(lds, LIST, (const char*)H16, ex_w_gate + (size_t)layer * NEXP * D * DEXP, ex_w_up + (size_t)layer * NEXP * D * DEXP, HID, G, bx, ffn_norm + (size_t)layer * D, RSL);
#ifdef MOE_ABLV
            if (NREP(10) > 1) moe_phase<1, MOE_ABLV>(lds, LIST, (const char*)H16, ex_w_gate + (size_t)layer * NEXP * D * DEXP, ex_w_up + (size_t)layer * NEXP * D * DEXP, YB, G, bx, ffn_norm + (size_t)layer * D, RSL);
#else
            if (NREP(10) > 1) moe_phase<1>(lds, LIST, (const char*)H16, ex_w_gate + (size_t)layer * NEXP * D * DEXP, ex_w_up + (size_t)layer * NEXP * D * DEXP, YB, G, bx, ffn_norm + (size_t)layer * D, RSL);
#endif
#else
            Moe1Sched S{tbl, LIST, (const char*)HN, (const char*)WG, (const char*)WU, (char*)HID, G, bx};
            pg8::EpiPair<true> E{}; for (int rep = 0; rep < NREP(10); ++rep) pg8::gemm_phase<pg8::EpiPair<true>, Moe1Sched, true>(lds, D, D, D, S, E);
#endif
            SEAM();
        }
        if (PH(11) && IN(pb + 11)) { DEF_W
            if (!args.fused) moe_tables(lds, cnt_p);
#if (NEWMOE & 2)
            moe_phase<2>(lds, nullptr, (const char*)HID, ex_w_down + (size_t)layer * NEXP * D * DEXP, nullptr, YB, G, bx);
#ifdef MOE_ABLV
            if (NREP(11) > 1) moe_phase<2, MOE_ABLV>(lds, nullptr, (const char*)HID, ex_w_down + (size_t)layer * NEXP * D * DEXP, nullptr, Z, G, bx);
#else
            if (NREP(11) > 1) moe_phase<2>(lds, nullptr, (const char*)HID, ex_w_down + (size_t)layer * NEXP * D * DEXP, nullptr, Z, G, bx);
#endif
#else
            Moe2Sched S{tbl, (const char*)HID, (const char*)WD, (char*)YB, G, bx};
            pg8::EpiBf16 E{}; for (int rep = 0; rep < NREP(11); ++rep) pg8::gemm_phase<pg8::EpiBf16, Moe2Sched, true>(lds, DEXP, DEXP, DEXP, S, E);
#endif
            SEAM();
        }
        if (PH(12) && IN(pb + 12)) { DEF_W
            if (!args.fused) moe_tables(lds, cnt_p);
            if (layer == 0) { combine_phase<false>(lds, H16, YB, TOKINFO, nullptr, RSTD1, nullptr, G); SEAM(); }
            else combine_phase<true>(lds, H16, YB, TOKINFO, final_norm, nullptr, hbuf, G);
        }
    }
    { constexpr int layer = 1;
        const int pb = 1 + 13 * layer;
#define cnt_p ((unsigned*)(ws + WS_CTL) + CW_CNT + layer * 32 * 64)
        if (PH(0) && IN(pb + 0)) { DEF_W
            for (int rep = 0; rep < NREP(0); ++rep) {
            if (layer == 0) {
                if (SUB(4)) for (int h = bx; h < NH; h += G) mlstm_prep(lds, h, GATES, BCUM, GI, MARR, APREV, BLG);
                if (SUB(0)) { pg8::DenseSched S{(const char*)HN, (size_t)256 * D * 2, 0, (const char*)W_EVIN, (const char*)W_EVIN + (size_t)128 * D * 2, (size_t)256 * D * 2, (char*)Z, EVN, T / 256, EVN / 256, G, bx};
                  pg8::EpiBf16 E{}; pg8::gemm_phase<pg8::EpiBf16, pg8::DenseSched, true>(lds, D, D, D, S, E); }
                if (SUB(1)) moe_phase<3>(lds, nullptr, (const char*)MEMN, xa_wk, xa_wv, KX, G, bx);
                if (SUB(1) && bx >= (G >> 1)) {
                    __syncthreads();
                    const int tid_ = fresh_tid(), lane = tid_ & 63, wave = __builtin_amdgcn_readfirstlane(tid_ >> 6);
                    LAS float* scr = (LAS float*)(lds + wave * 16640);
                    const int b = bx - (G >> 1), nbu = G - (G >> 1), nkv = nbu < 64 ? nbu : 64, WA = nkv * NWAVES, WB = (nbu - nkv) * NWAVES;
                    const int NL = NITEMS - NP_ITEMS, NA = (int)((long)NL * WA / (WA + 5 * WB));
                    if (b < nkv) { TRANSPOSE_ITEMS(b * NWAVES + wave, WA, NP_ITEMS, NP_ITEMS + NA) }
                    else { TRANSPOSE_ITEMS((b - nkv) * NWAVES + wave, WB, NP_ITEMS + NA, NITEMS) }
                }
            } else {
                if (SUB(2)) { pg8::DenseSched S{(const char*)H16, (size_t)256 * D * 2, 0, (const char*)W_ODIN, (const char*)W_ODIN + (size_t)128 * D * 2, (size_t)256 * D * 2, (char*)Z, D, T / 256, D / 256, G, bx};
                  pg8::EpiBf16Rs E{RSTD1}; pg8::gemm_phase<pg8::EpiBf16Rs, pg8::DenseSched, true>(lds, D, D, D, S, E); }
                if (SUB(3)) { pg8::DenseSched S{(const char*)H16, (size_t)256 * D * 2, 0, (const char*)W_ODIN + (size_t)2048 * D * 2, (const char*)W_ODIN + (size_t)4096 * D * 2, (size_t)128 * D * 2, (char*)(Z + (size_t)T * D), D, T / 256, D / 128, G, bx};
                  pg8::EpiPairRs E{RSTD1}; pg8::gemm_phase<pg8::EpiPairRs, pg8::DenseSched, true>(lds, D, D, D, S, E); }
            }
            }
            SEAM();
        }
        if (PH(1) && IN(pb + 1)) { DEF_W
            for (int rep = 0; rep < NREP(1); ++rep) {
            if (layer == 0) {
                for (int u = bx; u < NCH * NH; u += G) mlstm_B(lds, u >> 2, u & 3, Z, GI, MARR, BLG, KC, KN);
                pool_diffs(Z, DPOOL, G);
            } else conv_gate(Z, Z + (size_t)T * D, od_conv_w, YCAT, G);
            }
            SEAM();
        }
        if (PH(2) && layer == 0 && IN(pb + 2)) { DEF_W
            for (int rep = 0; rep < NREP(2); ++rep) {
            if (SUB(5)) mlstm_scan(KC, KN, APREV, CST, NST, G);
            if (SUB(6)) { pg8::DenseSched S{(const char*)DPOOL, (size_t)256 * 1024 * 2, (size_t)256 * 2, (const char*)W_POOL, (const char*)W_POOL + (size_t)128 * 256 * 2, (size_t)256 * 256 * 2, (char*)YCAT, D, T / 256, 4, G, bx};
              pg8::EpiBf16Scale E{ev_pool_scale}; pg8::gemm_phase<pg8::EpiBf16Scale, pg8::DenseSched, true>(lds, 256, 1024, 256, S, E); }
            }
            SEAM();
        }
        if (PH(3) && layer == 0 && IN(pb + 3)) { DEF_W
            for (int rep = 0; rep < NREP(3); ++rep) {
            for (int u = bx; u < NCH * NH; u += G) mlstm_D(lds, u >> 2, u & 3, Z, GI, BCUM, MARR, CST, NST, ev_head_norm, YCAT);
            }
            SEAM();
        }
        if (PH(4) && IN(pb + 4)) { DEF_W
            pg8::DenseSched S{(const char*)YCAT, (size_t)256 * D * 2, 0, (const char*)(layer == 0 ? W_EVOUT : W_ODOUT), (const char*)(layer == 0 ? W_EVOUT : W_ODOUT) + (size_t)128 * D * 2, (size_t)256 * D * 2, (char*)H16, D, T / 256, D / 256, G, bx};
            float* ssq = (float*)(ws + WS_SMALL + SM_SSQP) + (size_t)layer * T * 32;
            if (layer == 0) { pg8::EpiResSsq<false> E{(const void*)x_in, ssq}; pg8::gemm_phase<pg8::EpiResSsq<false>, pg8::DenseSched, true>(lds, D, D, D, S, E); }
            else { pg8::EpiResSsq<true> E{(const void*)H16, ssq}; pg8::gemm_phase<pg8::EpiResSsq<true>, pg8::DenseSched, true>(lds, D, D, D, S, E); }
            SEAM();
        }
        if (PH(6) && IN(pb + 6)) { DEF_W
            for (int rep = 0; rep < NREP(6); ++rep) {
            const bf16_t* W = W_XQ + (size_t)layer * D * D;
            pg8::DenseSched S{(const char*)H16, (size_t)256 * D * 2, 0, (const char*)W, (const char*)W + (size_t)128 * D * 2, (size_t)256 * D * 2, (char*)QX, D, T / 256, D / 256, G, bx};
            pg8::EpiBf16RowScale E{(const float*)(ws + WS_SMALL + SM_SSQP) + (size_t)layer * T * 32, 1.0f / D, EPS}; pg8::gemm_phase<pg8::EpiBf16RowScale, pg8::DenseSched, true>(lds, D, D, D, S, E);
            }
            SEAM();
        }
        if (PH(7) && IN(pb + 7)) { DEF_W
            for (int rep = 0; rep < NREP(7); ++rep) {
            for (int u = bx; u < XH * (T / 128); u += G) xattn_unit(lds, u & 3, u >> 2, QX, KX + (size_t)layer * NMEM * D, VX + (size_t)layer * NMEM * D, OATT);
            }
            SEAM();
        }
        if (PH(8) && IN(pb + 8)) { DEF_W
            const bf16_t* W = W_XO + (size_t)layer * D * D;
            pg8::DenseSched S{(const char*)OATT, (size_t)256 * D * 2, 0, (const char*)W, (const char*)W + (size_t)128 * D * 2, (size_t)256 * D * 2, (char*)H16, D, T / 256, D / 256, G, bx};
            pg8::EpiResSsq<true> E{(const void*)H16, nullptr}; pg8::gemm_phase<pg8::EpiResSsq<true>, pg8::DenseSched, true>(lds, D, D, D, S, E);
            SEAM();
        }
        if (PH(9) && IN(pb + 9)) { DEF_W
            RowArgs ra{}; ra.hin16 = H16; ra.gain = ffn_norm + (size_t)layer * D; ra.hn = HN;
            ra.rgw = rt_group_w + (size_t)layer * D * 4; ra.rgb = rt_group_b + layer * 4; ra.rew = rt_expert_w + (size_t)layer * D * NEXP; ra.reb = rt_expert_b + layer * NEXP;
            ra.cnt = cnt_p; ra.list = LIST; ra.tokinfo = TOKINFO; ra.wr = WRT + (size_t)layer * 2 * 48 * D; ra.rsl = RSL;
            row_phase<RM_ROUTE, false, true, false>(lds, ra, G);
            SEAM();
        }
        if (PH(10) && IN(pb + 10)) { DEF_W
            moe_tables(lds, cnt_p);
#if (NEWMOE & 1)
            moe_phase<1>(lds, LIST, (const char*)H16, ex_w_gate + (size_t)layer * NEXP * D * DEXP, ex_w_up + (size_t)layer * NEXP * D * DEXP, HID, G, bx, ffn_norm + (size_t)layer * D, RSL);
#ifdef MOE_ABLV
            if (NREP(10) > 1) moe_phase<1, MOE_ABLV>(lds, LIST, (const char*)H16, ex_w_gate + (size_t)layer * NEXP * D * DEXP, ex_w_up + (size_t)layer * NEXP * D * DEXP, YB, G, bx, ffn_norm + (size_t)layer * D, RSL);
#else
            if (NREP(10) > 1) moe_phase<1>(lds, LIST, (const char*)H16, ex_w_gate + (size_t)layer * NEXP * D * DEXP, ex_w_up + (size_t)layer * NEXP * D * DEXP, YB, G, bx, ffn_norm + (size_t)layer * D, RSL);
#endif
#else
            Moe1Sched S{tbl, LIST, (const char*)HN, (const char*)WG, (const char*)WU, (char*)HID, G, bx};
            pg8::EpiPair<true> E{}; for (int rep = 0; rep < NREP(10); ++rep) pg8::gemm_phase<pg8::EpiPair<true>, Moe1Sched, true>(lds, D, D, D, S, E);
#endif
            SEAM();
        }
        if (PH(11) && IN(pb + 11)) { DEF_W
            if (!args.fused) moe_tables(lds, cnt_p);
#if (NEWMOE & 2)
            moe_phase<2>(lds, nullptr, (const char*)HID, ex_w_down + (size_t)layer * NEXP * D * DEXP, nullptr, YB, G, bx);
#ifdef MOE_ABLV
            if (NREP(11) > 1) moe_phase<2, MOE_ABLV>(lds, nullptr, (const char*)HID, ex_w_down + (size_t)layer * NEXP * D * DEXP, nullptr, Z, G, bx);
#else
            if (NREP(11) > 1) moe_phase<2>(lds, nullptr, (const char*)HID, ex_w_down + (size_t)layer * NEXP * D * DEXP, nullptr, Z, G, bx);
#endif
#else
            Moe2Sched S{tbl, (const char*)HID, (const char*)WD, (char*)YB, G, bx};
            pg8::EpiBf16 E{}; for (int rep = 0; rep < NREP(11); ++rep) pg8::gemm_phase<pg8::EpiBf16, Moe2Sched, true>(lds, DEXP, DEXP, DEXP, S, E);
#endif
            SEAM();
        }
        if (PH(12) && IN(pb + 12)) { DEF_W
            if (!args.fused) moe_tables(lds, cnt_p);
            if (layer == 0) { combine_phase<false>(lds, H16, YB, TOKINFO, nullptr, RSTD1, nullptr, G); SEAM(); }
            else combine_phase<true>(lds, H16, YB, TOKINFO, final_norm, nullptr, hbuf, G);
        }
    }
#undef IN
#undef SEAM
#undef KARG
#undef hbuf
#undef INP
#undef DEF_W
#undef W_EVIN
#undef W_EVOUT
#undef W_ODIN
#undef W_ODOUT
#undef W_XQ
#undef W_XK
#undef W_XV
#undef W_XO
#undef W_POOL
#undef MEMN
#undef KX
#undef VX
#undef GATES
#undef BCUM
#undef GI
#undef MARR
#undef APREV
#undef BLG
#undef KN
#undef NST
#undef HN
#undef Z
#undef YCAT
#undef DPOOL
#undef KC
#undef CST
#undef QX
#undef OATT
#undef HID
#undef H16
#undef WRT
#undef YB
#undef LIST
#undef RSL
#undef RSTD1
#undef TOKINFO
#undef WG
#undef WU
#undef WD
#undef cnt_p
#undef x_in
#undef mem_in
#undef mix_norm
#undef xattn_norm
#undef mem_norm
#undef ffn_norm
#undef final_norm
#undef ev_w_in
#undef ev_b_gates
#undef ev_pool_w
#undef ev_pool_scale
#undef ev_head_norm
#undef ev_w_out
#undef od_w_in
#undef od_conv_w
#undef od_w_out
#undef xa_wq
#undef xa_wk
#undef xa_wv
#undef xa_wo
#undef rt_group_w
#undef rt_group_b
#undef rt_expert_w
#undef rt_expert_b
#undef ex_w_gate
#undef ex_w_up
#undef ex_w_down
}

extern "C" void kernel_launch(void* const* d_in, const int* in_sizes, int n_in, void* d_out, int out_size, void* d_ws, size_t ws_size, hipStream_t stream) {
    static int grid = 0;
    if (grid == 0) {
        if (n_in != 27 || in_sizes[0] != T * D || out_size != T * D || ws_size < WS_END) { fprintf(stderr, "kernel_launch: unexpected shapes (n_in %d, in0 %d, out %d, ws %zu < %zu); nothing launched\n", n_in, n_in > 0 ? in_sizes[0] : -1, out_size, ws_size, (size_t)WS_END); grid = -1; return; }
        int dev = 0, cus = 0, per_cu = 0;
        if (hipGetDevice(&dev) != hipSuccess || hipDeviceGetAttribute(&cus, hipDeviceAttributeMultiprocessorCount, dev) != hipSuccess) { fprintf(stderr, "kernel_launch: device query failed\n"); grid = -1; return; }
        if (hipFuncSetAttribute((const void*)mk_fwd, hipFuncAttributeMaxDynamicSharedMemorySize, LDS_BYTES) != hipSuccess) { fprintf(stderr, "kernel_launch: hipFuncSetAttribute(%d B LDS) failed\n", LDS_BYTES); grid = -1; return; }
        if (hipOccupancyMaxActiveBlocksPerMultiprocessor(&per_cu, (const void*)mk_fwd, NTHR, LDS_BYTES) != hipSuccess || per_cu < 1) fprintf(stderr, "kernel_launch: note: occupancy query reports %d workgroups per CU\n", per_cu);
        (void)hipGetLastError();
        grid = cus;
    }
    if (grid < 0) return;
    if (hipMemsetAsync((char*)d_ws + WS_CTL, 0, CTL_ZERO_BYTES, stream) != hipSuccess) { fprintf(stderr, "kernel_launch: memset failed\n"); return; }
    Args a{};
    for (int i = 0; i < 27; ++i) a.in[i] = (const float*)d_in[i];
    a.out = (float*)d_out; a.ws = (unsigned char*)d_ws;
#if MK_PER_PHASE
    for (int p = 0; p < NPH; ++p) {
        if (p == 16 || p == 17) continue;
        a.ph_lo = p; a.ph_hi = p + 1; a.fused = 0;
        hipLaunchKernelGGL(mk_fwd, dim3(grid), dim3(NTHR), LDS_BYTES, stream, a);
    }
#else
    a.ph_lo = 0; a.ph_hi = NPH; a.fused = 1;
    hipLaunchKernelGGL(mk_fwd, dim3(grid), dim3(NTHR), LDS_BYTES, stream, a);
#endif
    const hipError_t le = hipPeekAtLastError();
    if (le != hipSuccess) fprintf(stderr, "kernel_launch: launch failed: %s (grid %d)\n", hipGetErrorName(le), grid);
}
```

```cpp
#include <hip/hip_runtime.h>
#include <cstdio>
#include <cstdint>

#define LAS __attribute__((address_space(3)))
typedef unsigned short bf16_t;
typedef short bf16x8 __attribute__((ext_vector_type(8)));
typedef short s16x4 __attribute__((ext_vector_type(4)));
typedef short v4i16_t __attribute__((ext_vector_type(4)));
typedef float f32x4 __attribute__((ext_vector_type(4)));
typedef float f32x2 __attribute__((ext_vector_type(2)));
typedef unsigned u32x4 __attribute__((ext_vector_type(4)));
typedef unsigned u32x2 __attribute__((ext_vector_type(2)));

__device__ __forceinline__ unsigned cvt_pk_bf16(float lo, float hi) { unsigned r; asm volatile("v_cvt_pk_bf16_f32 %0, %1, %2" : "=v"(r) : "v"(lo), "v"(hi)); return r; }
__device__ __forceinline__ float bf_lo(unsigned u) { return __builtin_bit_cast(float, u << 16); }
__device__ __forceinline__ float bf_hi(unsigned u) { return __builtin_bit_cast(float, u & 0xffff0000u); }
__device__ __forceinline__ float bf2f(unsigned short b) { return __builtin_bit_cast(float, ((unsigned)b) << 16); }

__device__ __forceinline__ int fresh_tid() { int t = threadIdx.x; asm volatile("" : "+v"(t)); return t; }
__device__ __forceinline__ int fresh_bx() { int t = blockIdx.x; asm volatile("" : "+s"(t)); return t; }
__device__ __forceinline__ int fresh_s(int t) { asm volatile("" : "+s"(t)); return t; }
__device__ __forceinline__ void glds16(const char* base, unsigned voff, unsigned lds_dst) {
    unsigned keep;
    asm volatile("s_mov_b32 %0, m0\n\ts_mov_b32 m0, %3\n\ts_nop 0\n\tglobal_load_lds_dwordx4 %1, %2\n\ts_mov_b32 m0, %0" : "=&s"(keep) : "v"(voff), "s"(base), "s"(lds_dst) : "memory");
}
namespace pg8 {
constexpr int BM = 256, BK = 64, HALF = 128, HTB = HALF * BK * 2  , STAGE_BYTES = 8 * HTB, NXCD = 8, WGM = 8;
__host__ __device__ __forceinline__ int lds_byte(int r, int c) { const int st = (r >> 4) * 2 + (c >> 5), rr = r & 15, cc = c & 31, ob = rr * 64 + cc * 2; return st * 1024 + (ob ^ (((ob >> 9) & 1) << 5)); }
__host__ __device__ __forceinline__ void stage_rc(int b, int& R, int& C) { const int st = b / 1024, sb = b % 1024, swz = sb ^ (((sb >> 9) & 1) << 5); R = (st >> 1) * 16 + swz / 64; C = (st & 1) * 32 + (swz % 64) / 2; }
__host__ __device__ __forceinline__ int perm32(int rho) { const int n = rho >> 4, i = rho & 15; return 8 * (i >> 2) + 4 * n + (i & 3); }

struct Unit { const char* a; const char* b0; const char* b1; char* out; int ldc, pm, pn, e; };

__device__ __forceinline__ bool tile_of(int i, int G, int c, int nM, int nN, int& pm, int& pn) {
    const int nwg = nM * nN; const long L = (long)i * G + c; if (L >= nwg) return false;
    int wgid = (int)L; { const int q = nwg / NXCD, r = nwg % NXCD, xcd = wgid % NXCD, off = wgid / NXCD; wgid = (xcd < r ? xcd * (q + 1) : r * (q + 1) + (xcd - r) * q) + off; }
    const int nig = WGM * nN, gid = wgid / nig, fm = gid * WGM, gsz = (nM - fm) < WGM ? (nM - fm) : WGM;
    pm = fm + ((wgid % nig) % gsz); pn = (wgid % nig) / gsz; return true;
}
struct DenseSched {
    static constexpr bool GATHER = false;
    const char* A; size_t a_mstep, a_nstep; const char* B0; const char* B1; size_t b_nstep; char* out; int ldc, nM, nN, G, c;
    __device__ __forceinline__ bool next(int i, Unit& u) const {
        int pm, pn; if (!tile_of(i, G, c, nM, nN, pm, pn)) return false;
        u.a = A + (size_t)pm * a_mstep + (size_t)pn * a_nstep; u.b0 = B0 + (size_t)pn * b_nstep; u.b1 = B1 + (size_t)pn * b_nstep; u.out = out; u.ldc = ldc; u.pm = pm; u.pn = pn; u.e = 0; return true;
    }
    __device__ __forceinline__ int arow(const Unit&, int r) const { return r; }
};

struct EpiBf16 {
    static constexpr bool PERM = true;
    __device__ __forceinline__ void operator()(const f32x4 (&acc)[2][2][4][2], const Unit& u, int wr, int wc, int fr, int fq) const {
        bf16_t* base = (bf16_t*)u.out; const int row0 = u.pm * BM + wr * 64 + fr, col0 = u.pn * BM + wc * 32 + 8 * fq;
#pragma unroll
        for (int ai = 0; ai < 2; ++ai)
#pragma unroll
            for (int m = 0; m < 4; ++m) { bf16_t* rowp = base + (size_t)(row0 + ai * HALF + m * 16) * u.ldc + col0;
#pragma unroll
                for (int bj = 0; bj < 2; ++bj) { const f32x4 v0 = acc[ai][bj][m][0], v1 = acc[ai][bj][m][1];
                    u32x4 w; w.x = cvt_pk_bf16(v0[0], v0[1]); w.y = cvt_pk_bf16(v0[2], v0[3]); w.z = cvt_pk_bf16(v1[0], v1[1]); w.w = cvt_pk_bf16(v1[2], v1[3]);
                    *(u32x4*)(rowp + bj * HALF) = w; } }
    }
};
struct EpiBf16Scale {
    static constexpr bool PERM = true;
    const float* scale;
    __device__ __forceinline__ void operator()(const f32x4 (&acc)[2][2][4][2], const Unit& u, int wr, int wc, int fr, int fq) const {
        bf16_t* base = (bf16_t*)u.out; const int row0 = u.pm * BM + wr * 64 + fr, col0 = u.pn * BM + wc * 32 + 8 * fq;
        f32x4 sv[2][2];
#pragma unroll
        for (int bj = 0; bj < 2; ++bj)
#pragma unroll
            for (int n = 0; n < 2; ++n) sv[bj][n] = *(const f32x4*)(scale + col0 + bj * HALF + 4 * n);
#pragma unroll
        for (int ai = 0; ai < 2; ++ai)
#pragma unroll
            for (int m = 0; m < 4; ++m) { bf16_t* rowp = base + (size_t)(row0 + ai * HALF + m * 16) * u.ldc + col0;
#pragma unroll
                for (int bj = 0; bj < 2; ++bj) { const f32x4 v0 = acc[ai][bj][m][0] * sv[bj][0], v1 = acc[ai][bj][m][1] * sv[bj][1];
                    u32x4 w; w.x = cvt_pk_bf16(v0[0], v0[1]); w.y = cvt_pk_bf16(v0[2], v0[3]); w.z = cvt_pk_bf16(v1[0], v1[1]); w.w = cvt_pk_bf16(v1[2], v1[3]);
                    *(u32x4*)(rowp + bj * HALF) = w; } }
    }
};
template <bool SILU> struct EpiPair {
    static constexpr bool PERM = true;
    __device__ __forceinline__ void operator()(const f32x4 (&acc)[2][2][4][2], const Unit& u, int wr, int wc, int fr, int fq) const {
        bf16_t* base = (bf16_t*)u.out; const int row0 = u.pm * BM + wr * 64 + fr, col0 = u.pn * HALF + wc * 32 + 8 * fq;
#pragma unroll
        for (int ai = 0; ai < 2; ++ai)
#pragma unroll
            for (int m = 0; m < 4; ++m) { bf16_t* rowp = base + (size_t)(row0 + ai * HALF + m * 16) * u.ldc + col0;
                float r[8];
#pragma unroll
                for (int n = 0; n < 2; ++n)
#pragma unroll
                    for (int j = 0; j < 4; ++j) { const float g = acc[ai][0][m][n][j], up = acc[ai][1][m][n][j];
                        r[n * 4 + j] = SILU ? (g * __builtin_amdgcn_rcpf(1.0f + __expf(-g))) * up : g * up; }
                u32x4 w; w.x = cvt_pk_bf16(r[0], r[1]); w.y = cvt_pk_bf16(r[2], r[3]); w.z = cvt_pk_bf16(r[4], r[5]); w.w = cvt_pk_bf16(r[6], r[7]);
                *(u32x4*)rowp = w; }
    }
};
struct EpiRes {
    static constexpr bool PERM = false;
    const float* res;
    __device__ __forceinline__ void operator()(const f32x4 (&acc)[2][2][4][2], const Unit& u, int wr, int wc, int fr, int fq) const {
        float* base = (float*)u.out; const int row0 = u.pm * BM + wr * 64 + fr, col0 = u.pn * BM + wc * 32 + 4 * fq;
#pragma unroll
        for (int ai = 0; ai < 2; ++ai)
#pragma unroll
            for (int m = 0; m < 4; ++m) { const size_t ro = (size_t)(row0 + ai * HALF + m * 16) * u.ldc + col0;
                f32x4 rv[2][2];
#pragma unroll
                for (int bj = 0; bj < 2; ++bj)
#pragma unroll
                    for (int n = 0; n < 2; ++n) rv[bj][n] = *(const f32x4*)(res + ro + bj * HALF + n * 16);
#pragma unroll
                for (int bj = 0; bj < 2; ++bj)
#pragma unroll
                    for (int n = 0; n < 2; ++n) *(f32x4*)(base + ro + bj * HALF + n * 16) = acc[ai][bj][m][n] + rv[bj][n]; }
    }
};

template <bool RES16> struct EpiResSsq {
    static constexpr bool PERM = true;
    const void* res; float* ssq;
    __device__ __forceinline__ void operator()(const f32x4 (&acc)[2][2][4][2], const Unit& u, int wr, int wc, int fr, int fq) const {
        bf16_t* base = (bf16_t*)u.out; const int row0 = u.pm * BM + wr * 64 + fr, col0 = u.pn * BM + wc * 32 + 8 * fq;
        if constexpr (RES16) {
            u32x4 t[2][4][2];
#pragma unroll
            for (int ai = 0; ai < 2; ++ai)
#pragma unroll
                for (int m = 0; m < 4; ++m)
#pragma unroll
                    for (int bj = 0; bj < 2; ++bj) t[ai][m][bj] = *(const u32x4*)((const bf16_t*)res + (size_t)(row0 + ai * HALF + m * 16) * u.ldc + col0 + bj * HALF);
#pragma unroll
            for (int ai = 0; ai < 2; ++ai)
#pragma unroll
                for (int m = 0; m < 4; ++m) { const int row = row0 + ai * HALF + m * 16; const size_t ro = (size_t)row * u.ldc + col0;
                    float s = 0.f;
#pragma unroll
                    for (int bj = 0; bj < 2; ++bj) { const u32x4 tt = t[ai][m][bj];
                        const f32x4 v0 = acc[ai][bj][m][0] + (f32x4){bf_lo(tt.x), bf_hi(tt.x), bf_lo(tt.y), bf_hi(tt.y)}, v1 = acc[ai][bj][m][1] + (f32x4){bf_lo(tt.z), bf_hi(tt.z), bf_lo(tt.w), bf_hi(tt.w)};
                        u32x4 w; w.x = cvt_pk_bf16(v0[0], v0[1]); w.y = cvt_pk_bf16(v0[2], v0[3]); w.z = cvt_pk_bf16(v1[0], v1[1]); w.w = cvt_pk_bf16(v1[2], v1[3]);
                        *(u32x4*)(base + ro + bj * HALF) = w;
                        s += ((v0[0] * v0[0] + v0[1] * v0[1]) + (v0[2] * v0[2] + v0[3] * v0[3])) + ((v1[0] * v1[0] + v1[1] * v1[1]) + (v1[2] * v1[2] + v1[3] * v1[3])); }
                    if (ssq) { s += __shfl_xor(s, 16); s += __shfl_xor(s, 32);
                        if (fq == 0) ssq[(size_t)row * 32 + u.pn * 4 + wc] = s; } }
        } else {
#pragma unroll
        for (int ai = 0; ai < 2; ++ai)
#pragma unroll
            for (int m = 0; m < 4; ++m) { const int row = row0 + ai * HALF + m * 16; const size_t ro = (size_t)row * u.ldc + col0;
                f32x4 rv[2][2];
#pragma unroll
                for (int bj = 0; bj < 2; ++bj) { rv[bj][0] = *(const f32x4*)((const float*)res + ro + bj * HALF); rv[bj][1] = *(const f32x4*)((const float*)res + ro + bj * HALF + 4); }
                float s = 0.f;
#pragma unroll
                for (int bj = 0; bj < 2; ++bj) { const f32x4 v0 = acc[ai][bj][m][0] + rv[bj][0], v1 = acc[ai][bj][m][1] + rv[bj][1];
                    u32x4 w; w.x = cvt_pk_bf16(v0[0], v0[1]); w.y = cvt_pk_bf16(v0[2], v0[3]); w.z = cvt_pk_bf16(v1[0], v1[1]); w.w = cvt_pk_bf16(v1[2], v1[3]);
                    *(u32x4*)(base + ro + bj * HALF) = w;
                    s += ((v0[0] * v0[0] + v0[1] * v0[1]) + (v0[2] * v0[2] + v0[3] * v0[3])) + ((v1[0] * v1[0] + v1[1] * v1[1]) + (v1[2] * v1[2] + v1[3] * v1[3])); }
                if (ssq) { s += __shfl_xor(s, 16); s += __shfl_xor(s, 32);
                    if (fq == 0) ssq[(size_t)row * 32 + u.pn * 4 + wc] = s; } }
        }
    }
};
struct EpiBf16RowScale {
    static constexpr bool PERM = true;
    const float* ssq; float inv_n, eps;
    __device__ __forceinline__ void operator()(const f32x4 (&acc)[2][2][4][2], const Unit& u, int wr, int wc, int fr, int fq) const {
        bf16_t* base = (bf16_t*)u.out; const int row0 = u.pm * BM + wr * 64 + fr, col0 = u.pn * BM + wc * 32 + 8 * fq;
#pragma unroll
        for (int ai = 0; ai < 2; ++ai)
#pragma unroll
            for (int m = 0; m < 4; ++m) { const int row = row0 + ai * HALF + m * 16; bf16_t* rowp = base + (size_t)row * u.ldc + col0;
                const f32x4 pa = *(const f32x4*)(ssq + (size_t)row * 32 + 8 * fq), pb = *(const f32x4*)(ssq + (size_t)row * 32 + 8 * fq + 4);
                float ps = ((pa[0] + pa[1]) + (pa[2] + pa[3])) + ((pb[0] + pb[1]) + (pb[2] + pb[3]));
                ps += __shfl_xor(ps, 16); ps += __shfl_xor(ps, 32);
                const float rs = rsqrtf(ps * inv_n + eps);
#pragma unroll
                for (int bj = 0; bj < 2; ++bj) { const f32x4 v0 = acc[ai][bj][m][0] * rs, v1 = acc[ai][bj][m][1] * rs;
                    u32x4 w; w.x = cvt_pk_bf16(v0[0], v0[1]); w.y = cvt_pk_bf16(v0[2], v0[3]); w.z = cvt_pk_bf16(v1[0], v1[1]); w.w = cvt_pk_bf16(v1[2], v1[3]);
                    *(u32x4*)(rowp + bj * HALF) = w; } }
    }
};

struct EpiBf16Rs {
    static constexpr bool PERM = true;
    const float* rs;
    __device__ __forceinline__ void operator()(const f32x4 (&acc)[2][2][4][2], const Unit& u, int wr, int wc, int fr, int fq) const {
        bf16_t* base = (bf16_t*)u.out; const int row0 = u.pm * BM + wr * 64 + fr, col0 = u.pn * BM + wc * 32 + 8 * fq;
#pragma unroll
        for (int ai = 0; ai < 2; ++ai)
#pragma unroll
            for (int m = 0; m < 4; ++m) { const int row = row0 + ai * HALF + m * 16; bf16_t* rowp = base + (size_t)row * u.ldc + col0; const float r = rs[row];
#pragma unroll
                for (int bj = 0; bj < 2; ++bj) { const f32x4 v0 = acc[ai][bj][m][0] * r, v1 = acc[ai][bj][m][1] * r;
                    u32x4 w; w.x = cvt_pk_bf16(v0[0], v0[1]); w.y = cvt_pk_bf16(v0[2], v0[3]); w.z = cvt_pk_bf16(v1[0], v1[1]); w.w = cvt_pk_bf16(v1[2], v1[3]);
                    *(u32x4*)(rowp + bj * HALF) = w; } }
    }
};
struct EpiPairRs {
    static constexpr bool PERM = true;
    const float* rs;
    __device__ __forceinline__ void operator()(const f32x4 (&acc)[2][2][4][2], const Unit& u, int wr, int wc, int fr, int fq) const {
        bf16_t* base = (bf16_t*)u.out; const int row0 = u.pm * BM + wr * 64 + fr, col0 = u.pn * HALF + wc * 32 + 8 * fq;
#pragma unroll
        for (int ai = 0; ai < 2; ++ai)
#pragma unroll
            for (int m = 0; m < 4; ++m) { const int row = row0 + ai * HALF + m * 16; bf16_t* rowp = base + (size_t)row * u.ldc + col0; const float q = rs[row], q2 = q * q;
                float r[8];
#pragma unroll
                for (int n = 0; n < 2; ++n)
#pragma unroll
                    for (int j = 0; j < 4; ++j) r[n * 4 + j] = acc[ai][0][m][n][j] * acc[ai][1][m][n][j] * q2;
                u32x4 w; w.x = cvt_pk_bf16(r[0], r[1]); w.y = cvt_pk_bf16(r[2], r[3]); w.z = cvt_pk_bf16(r[4], r[5]); w.w = cvt_pk_bf16(r[6], r[7]);
                *(u32x4*)rowp = w; }
    }
};

template <class Epi, class Sched, bool ALIGN_EPI>
__device__ __forceinline__ void gemm_phase(LAS unsigned char* lds, const int K, const int lda, const int ldb, const Sched& S, const Epi& E) {
    const int tid = fresh_tid(), wid = __builtin_amdgcn_readfirstlane(tid >> 6), lane = tid & 63, wr = wid >> 2, wc = wid & 3, fr = lane & 15, fq = lane >> 4;
    const int nt = K / BK;
    int sR[2], sC[2]; unsigned voffB[2], vA[2][2], nvA[2][2];
#pragma unroll
    for (int i = 0; i < 2; ++i) { stage_rc(tid * 16 + i * 8192, sR[i], sC[i]); const int Rb = Epi::PERM ? ((sR[i] & ~31) + perm32(sR[i] & 31)) : sR[i];
        voffB[i] = (unsigned)(Rb * ldb + sC[i]) * 2u; }
    const size_t kstep = (size_t)(BK * 2);
    const unsigned ldsb = (unsigned)__builtin_amdgcn_readfirstlane((int)(unsigned)(__UINTPTR_TYPE__)lds) + (unsigned)wid * 1024u;
    const size_t hstepA = (size_t)HALF * lda * 2;
    const int aoff = lds_byte(wr * 64 + fr, fq * 8), boff = lds_byte(wc * 32 + fr, fq * 8);
#define PG8_SA(b, h) (((b) * 2 + (h)) * HTB)
#define PG8_SB(b, h) ((4 + (b) * 2 + (h)) * HTB)
#define PG8_STAGE(bufoff, gbase, voff) do { _Pragma("unroll") for (int _i = 0; _i < 2; ++_i) \
        glds16((const char*)(gbase), (voff)[_i], ldsb + (unsigned)(bufoff) + (unsigned)(_i * 8192)); } while (0)
#define PG8_STAGE_A(bufoff, gbase, h, VA) do { if constexpr (Sched::GATHER) { PG8_STAGE(bufoff, gbase, (VA)[h]); } else { PG8_STAGE(bufoff, (gbase) + (h) * hstepA, (VA)[0]); } } while (0)
#define PG8_LDA(dst, b, h) do { _Pragma("unroll") for (int m = 0; m < 4; ++m) _Pragma("unroll") for (int k = 0; k < 2; ++k) dst[m][k] = *(const LAS bf16x8*)(lds + PG8_SA(b, h) + aoff + m * 2048 + k * 1024); } while (0)
#define PG8_LDB(dst, b, h) do { _Pragma("unroll") for (int n = 0; n < 2; ++n) _Pragma("unroll") for (int k = 0; k < 2; ++k) dst[n][k] = *(const LAS bf16x8*)(lds + PG8_SB(b, h) + boff + n * 2048 + k * 1024); } while (0)
#define PG8_MMA(ai, bj, At, Bt) do { __builtin_amdgcn_s_setprio(1); _Pragma("unroll") for (int m = 0; m < 4; ++m) _Pragma("unroll") for (int n = 0; n < 2; ++n) _Pragma("unroll") for (int k = 0; k < 2; ++k) \
        acc[ai][bj][m][n] = __builtin_amdgcn_mfma_f32_16x16x32_bf16(Bt[n][k], At[m][k], acc[ai][bj][m][n], 0, 0, 0); __builtin_amdgcn_s_setprio(0); } while (0)
#define PG8_WAIT_V(n) asm volatile("s_waitcnt vmcnt(" #n ")" ::: "memory")
#define PG8_WAIT_L(n) asm volatile("s_waitcnt lgkmcnt(" #n ")" ::: "memory")
#define PG8_BAR __builtin_amdgcn_s_barrier()
#define PG8_SCHED __builtin_amdgcn_sched_barrier(0)
    Unit cur, nxt; int ui = 0;
    if (!S.next(0, cur)) return;
#pragma unroll
    for (int h = 0; h < 2; ++h)
#pragma unroll
        for (int i = 0; i < 2; ++i) vA[h][i] = Sched::GATHER ? (unsigned)(S.arow(cur, h * HALF + sR[i]) * lda + sC[i]) * 2u : (unsigned)(sR[i] * lda + sC[i]) * 2u;
    f32x4 acc[2][2][4][2];
#pragma unroll
    for (int a = 0; a < 2; ++a)
#pragma unroll
        for (int b = 0; b < 2; ++b)
#pragma unroll
            for (int m = 0; m < 4; ++m)
#pragma unroll
                for (int n = 0; n < 2; ++n) acc[a][b][m][n] = (f32x4){0.f, 0.f, 0.f, 0.f};
    bf16x8 At[4][2], B0[2][2], B1[2][2];
    PG8_STAGE(PG8_SB(0, 0), cur.b0, voffB); PG8_STAGE(PG8_SB(0, 1), cur.b1, voffB); PG8_STAGE_A(PG8_SA(0, 0), cur.a, 0, vA); PG8_STAGE_A(PG8_SA(0, 1), cur.a, 1, vA);
    if (wr == 1) PG8_BAR;
    PG8_WAIT_V(2); PG8_BAR;
    PG8_STAGE(PG8_SB(1, 0), cur.b0 + kstep, voffB); PG8_STAGE_A(PG8_SA(1, 0), cur.a + kstep, 0, vA); PG8_STAGE(PG8_SB(1, 1), cur.b1 + kstep, voffB);
    PG8_WAIT_V(6); PG8_BAR;
    for (;;) {
        const bool has_next = S.next(ui + 1, nxt);
        const char* nA = has_next ? nxt.a : cur.a; const char* nB0 = has_next ? nxt.b0 : cur.b0; const char* nB1 = has_next ? nxt.b1 : cur.b1;
        if constexpr (Sched::GATHER) {
#pragma unroll
            for (int h = 0; h < 2; ++h)
#pragma unroll
                for (int i = 0; i < 2; ++i) nvA[h][i] = has_next ? (unsigned)(S.arow(nxt, h * HALF + sR[i]) * lda + sC[i]) * 2u : vA[h][i];
        }
        for (int t = 0; t < nt; t += 2) {
            const bool last = (t == nt - 2);
            const char* a1 = cur.a + (size_t)(t + 1) * kstep;
            const char* a2 = last ? nA : cur.a + (size_t)(t + 2) * kstep;
            const char* b20 = last ? nB0 : cur.b0 + (size_t)(t + 2) * kstep; const char* b21 = last ? nB1 : cur.b1 + (size_t)(t + 2) * kstep;
            const char* a3 = a2 + kstep; const char* b30 = b20 + kstep; const char* b31 = b21 + kstep;
            unsigned wA[2][2];
#pragma unroll
            for (int h = 0; h < 2; ++h)
#pragma unroll
                for (int i = 0; i < 2; ++i) wA[h][i] = (Sched::GATHER && last) ? nvA[h][i] : vA[h][i];
            PG8_LDB(B0, 0, 0); PG8_LDB(B1, 0, 1); PG8_SCHED; PG8_LDA(At, 0, 0); PG8_STAGE_A(PG8_SA(1, 1), a1, 1, vA);
            PG8_WAIT_V(8); PG8_WAIT_L(0); PG8_BAR; PG8_MMA(0, 0, At, B0); PG8_MMA(0, 1, At, B1); PG8_BAR; PG8_SCHED;
            PG8_LDA(At, 0, 1); PG8_STAGE(PG8_SB(0, 0), b20, voffB); PG8_STAGE(PG8_SB(0, 1), b21, voffB); PG8_STAGE_A(PG8_SA(0, 0), a2, 0, wA);
            PG8_WAIT_V(8); PG8_WAIT_L(0); PG8_BAR; PG8_MMA(1, 0, At, B0); PG8_MMA(1, 1, At, B1); PG8_BAR; PG8_SCHED;
            PG8_LDB(B0, 1, 0); PG8_LDB(B1, 1, 1); PG8_SCHED; PG8_LDA(At, 1, 0); PG8_STAGE_A(PG8_SA(0, 1), a2, 1, wA);
            PG8_WAIT_V(8); PG8_WAIT_L(0); PG8_BAR; PG8_MMA(0, 0, At, B0); PG8_MMA(0, 1, At, B1); PG8_BAR; PG8_SCHED;
            PG8_LDA(At, 1, 1); PG8_STAGE(PG8_SB(1, 0), b30, voffB); PG8_STAGE(PG8_SB(1, 1), b31, voffB); PG8_STAGE_A(PG8_SA(1, 0), a3, 0, wA);
            PG8_WAIT_V(8); PG8_WAIT_L(0); PG8_BAR; PG8_MMA(1, 0, At, B0); PG8_MMA(1, 1, At, B1); PG8_BAR; PG8_SCHED;
        }
        if constexpr (ALIGN_EPI) { if (wr == 0) PG8_BAR; }
        E(acc, cur, wr, wc, fr, fq);
        if (!has_next) break;
#pragma unroll
        for (int a = 0; a < 2; ++a)
#pragma unroll
            for (int b = 0; b < 2; ++b)
#pragma unroll
                for (int m = 0; m < 4; ++m)
#pragma unroll
                    for (int n = 0; n < 2; ++n) acc[a][b][m][n] = (f32x4){0.f, 0.f, 0.f, 0.f};
        cur = nxt; ++ui;
        if constexpr (Sched::GATHER) {
#pragma unroll
            for (int h = 0; h < 2; ++h)
#pragma unroll
                for (int i = 0; i < 2; ++i) vA[h][i] = nvA[h][i];
        }
        if constexpr (ALIGN_EPI) { if (wr == 1) PG8_BAR; }
    }
    PG8_WAIT_V(0);
    if constexpr (!ALIGN_EPI) { if (wr == 0) PG8_BAR; }
    PG8_BAR;
#undef PG8_SA
#undef PG8_SB
#undef PG8_STAGE
#undef PG8_STAGE_A
#undef PG8_LDA
#undef PG8_LDB
#undef PG8_MMA
#undef PG8_WAIT_V
#undef PG8_WAIT_L
#undef PG8_BAR
#undef PG8_SCHED
}
}
#define XB_TMO      128
#define XB_XCNT(j)  (256  + 64 * (j))
#define XB_XSUB(j)  (1280 + 64 * (j))
#define XB_XGEN(j)  (2304 + 64 * (j))
#define XB_TOP      3328
#define XB_TOPGEN   3392
#define XCD_BAR_WORDS 3456
#define XB_SPIN_CAP (1u << 21)

__device__ __forceinline__ unsigned xb_ld(unsigned* p)              { return __hip_atomic_load(p, __ATOMIC_RELAXED, __HIP_MEMORY_SCOPE_AGENT); }
__device__ __forceinline__ unsigned xb_add(unsigned* p, unsigned v) { return __hip_atomic_fetch_add(p, v, __ATOMIC_RELAXED, __HIP_MEMORY_SCOPE_AGENT); }
__device__ __forceinline__ unsigned xb_xcc_id() { return (unsigned)__builtin_amdgcn_s_getreg((3 << 11) | 20) & 0xFu; }
#define XB_SPIN(cond, bar) do { unsigned _sp = 0; while (cond) { __builtin_amdgcn_s_sleep(1); \
    if ((++_sp & 255u) == 0u) { if (xb_ld(&(bar)[XB_TMO])) break; if (_sp > XB_SPIN_CAP) { atomicAdd(&(bar)[XB_TMO], 1u); break; } } } } while (0)

struct XcdBarrier {
    unsigned* bar; unsigned x;
    volatile LAS unsigned* st;
};

__device__ __forceinline__ XcdBarrier xcd_barrier_post(unsigned* bar, volatile LAS unsigned* st) {
    XcdBarrier b; b.bar = bar; b.x = xb_xcc_id(); b.st = st;
    if (threadIdx.x == 0) (void)xb_add(&bar[XB_XCNT(b.x)], 1u);
    return b;
}
__device__ __forceinline__ void xcd_barrier_complete(unsigned* bar, unsigned x, unsigned& nloc, unsigned& nx) {
    const unsigned G = gridDim.x * gridDim.y * gridDim.z;
    unsigned sum, cnt, mine, sp = 0u;
    for (;;) {
        sum = 0u; cnt = 0u; mine = 0u;
#pragma unroll
        for (unsigned j = 0; j < 16; ++j) { const unsigned c = xb_ld(&bar[XB_XCNT(j)]); sum += c; cnt += (c > 0u) ? 1u : 0u; mine = (j == x) ? c : mine; }
        if (sum == G) break;
        __builtin_amdgcn_s_sleep(1);
        if ((++sp & 255u) == 0u) { if (xb_ld(&bar[XB_TMO])) break; if (sp > XB_SPIN_CAP) { atomicAdd(&bar[XB_TMO], 1u); break; } }
    }
    nloc = mine > 0u ? mine : 1u; nx = cnt > 0u ? cnt : 1u;
}

__device__ __forceinline__ void xcd_barrier(const XcdBarrier& b) {
    asm volatile("s_waitcnt vmcnt(0)" ::: "memory");
    __syncthreads();
    if (threadIdx.x == 0) {
        unsigned* bar = b.bar;
        __builtin_amdgcn_s_waitcnt(0);
        unsigned nloc = b.st[0], nx = b.st[1];
        if (nloc == 0u) { xcd_barrier_complete(bar, b.x, nloc, nx); b.st[0] = nloc; b.st[1] = nx; }
        const unsigned old = xb_add(&bar[XB_XSUB(b.x)], 1u);
        const unsigned gen = old / nloc;
        if (old + 1u == (gen + 1u) * nloc) {
            __builtin_amdgcn_fence(__ATOMIC_RELEASE, "agent");
            asm volatile("s_waitcnt vmcnt(0)" ::: "memory");
            const unsigned og = xb_add(&bar[XB_TOP], 1u);
            const unsigned tg = og / nx;
            if (og + 1u == (tg + 1u) * nx) xb_add(&bar[XB_TOPGEN], 1u);
            else XB_SPIN(xb_ld(&bar[XB_TOPGEN]) == tg, bar);
            __builtin_amdgcn_fence(__ATOMIC_ACQUIRE, "agent");
            xb_add(&bar[XB_XGEN(b.x)], 1u);
            asm volatile("s_waitcnt vmcnt(0)" ::: "memory");
        } else {
            XB_SPIN(xb_ld(&bar[XB_XGEN(b.x)]) == gen, bar);
            __builtin_amdgcn_fence(__ATOMIC_ACQUIRE, "agent");
            asm volatile("s_waitcnt vmcnt(0)" ::: "memory");
        }
    }
    __syncthreads();
}

constexpr int T = 8192, D = 2048, NMEM = 256;
constexpr int EVW = 5128, EVN = 5120, ODN = 6144;
constexpr int NH = 4, DH = 256, CH = 128, NCH = 64;
constexpr int XH = 4, XD = 512;
constexpr int NEXP = 32, DEXP = 1024, LISTCAP = 8192;
constexpr float EPS = 1e-6f;
constexpr int NWAVES = 8, NTHR = 512;

constexpr size_t MiB = 1u << 20;
constexpr size_t WS_CTL = 0, CTL_ZERO_BYTES = 192 * 1024, CTL_SSQ = 64 * 1024;
constexpr size_t WS_WEVIN = 1 * MiB, WS_WEVOUT = 21 * MiB, WS_WODIN = 29 * MiB, WS_WODOUT = 53 * MiB;
constexpr size_t WS_WXQ = 61 * MiB, WS_WXK = 77 * MiB, WS_WXV = 93 * MiB, WS_WXO = 109 * MiB, WS_WPOOL = 125 * MiB;
constexpr size_t WS_MEMN = 126 * MiB, WS_KX = 128 * MiB, WS_VX = 130 * MiB, WS_SMALL = 132 * MiB;
constexpr size_t WS_WEXP = 136 * MiB, WEXP_LAYER = 384 * MiB, WEXP_MAT = 128 * MiB, WEXP_ONE = (size_t)DEXP * D * 2;
constexpr size_t WS_HN = 904 * MiB, WS_Z = 936 * MiB, WS_YCAT = 1032 * MiB, WS_DPOOL = 1064 * MiB, WS_KC = 1080 * MiB, WS_CST = 1144 * MiB;
constexpr size_t WS_QX = 1192 * MiB, WS_OATT = 1224 * MiB, WS_HID = 1256 * MiB, WS_YB = 1304 * MiB, WS_LIST = 1400 * MiB, WS_TOKINFO = 1402 * MiB, WS_H16 = 1404 * MiB, WS_END = 1436 * MiB;
constexpr size_t SM_GATES = 0, SM_BCUM = 256 * 1024, SM_GI = 384 * 1024, SM_MARR = 512 * 1024, SM_APREV = 516 * 1024, SM_BL = 520 * 1024, SM_KN = 1 * MiB, SM_NST = 1 * MiB + 256 * 1024, SM_SSQP = 2 * MiB;
constexpr int CW_BAR = 4096;
constexpr int CW_CNT = 8192;
constexpr int LDS_BYTES = 159744, MISC_OFF = 159232, TBL_OFF = 157696;

__device__ __forceinline__ float wave_sum(float v) {
#pragma unroll
    for (int o = 1; o < 64; o <<= 1) v += __shfl_xor(v, o);
    return v;
}
__device__ __forceinline__ float wave_max(float v) {
#pragma unroll
    for (int o = 1; o < 64; o <<= 1) v = fmaxf(v, __shfl_xor(v, o));
    return v;
}
template <int N, int BIT> struct WRed {
    static __device__ __forceinline__ void run(float* v, int lane) {
        const bool up = (lane & BIT) != 0;
#pragma unroll
        for (int i = 0; i < N / 2; ++i) { const float keep = up ? v[i + N / 2] : v[i]; const float send = up ? v[i] : v[i + N / 2]; v[i] = keep + __shfl_xor(send, BIT); }
        WRed<N / 2, BIT / 2>::run(v, lane);
    }
};
template <int BIT> struct WRed<1, BIT> { static __device__ __forceinline__ void run(float*, int) {} };
template <int N> struct Log2 { static constexpr int v = 1 + Log2<N / 2>::v; };
template <> struct Log2<1> { static constexpr int v = 0; };
template <int N> __device__ __forceinline__ float wave_reduce_pow2(float (&v)[N], int lane) {
    WRed<N, 32>::run(v, lane);
    float r = v[0];
#pragma unroll
    for (int s = Log2<N>::v; s < 6; ++s) r += __shfl_xor(r, 32 >> s);
    return r;
}
__device__ __forceinline__ float logsigf(float x) { return fminf(x, 0.f) - log1pf(expf(-fabsf(x))); }

__device__ __forceinline__ void transpose_item64(const float* W, int ldw, int K, bf16_t* WT, int kb, int nb, LAS float* scr, int lane, const float* gain) {
    const int k0 = kb * 64, n0 = nb * 64;
    const float* src = W + (size_t)(k0 + (lane >> 4)) * ldw + n0 + 4 * (lane & 15);
    f32x4 v[16];
#pragma unroll
    for (int i = 0; i < 16; ++i) v[i] = *(const f32x4*)(src + (size_t)(4 * i) * ldw);
    if (gain) {
#pragma unroll
        for (int i = 0; i < 16; ++i) v[i] = v[i] * gain[k0 + 4 * i + (lane >> 4)]; }
#pragma unroll
    for (int i = 0; i < 16; ++i) { LAS float* d = scr + (4 * i + (lane >> 4)) * 65 + 4 * (lane & 15); d[0] = v[i][0]; d[1] = v[i][1]; d[2] = v[i][2]; d[3] = v[i][3]; }
    asm volatile("s_waitcnt lgkmcnt(0)" ::: "memory");
    const int kc = lane & 7;
#pragma unroll
    for (int j = 0; j < 8; ++j) { const int n = (lane >> 3) + 8 * j; const LAS float* s = scr + (8 * kc) * 65 + n;
        u32x4 o; o.x = cvt_pk_bf16(s[0], s[65]); o.y = cvt_pk_bf16(s[130], s[195]); o.z = cvt_pk_bf16(s[260], s[325]); o.w = cvt_pk_bf16(s[390], s[455]);
        *(u32x4*)(WT + (size_t)(n0 + n) * K + k0 + 8 * kc) = o; }
    asm volatile("s_waitcnt lgkmcnt(0)" ::: "memory");
}

template <int ROWS, int COLS, int PAD> __device__ __forceinline__ void stage_tile(LAS unsigned char* dst, const bf16_t* src, size_t ld, int tid) {
    constexpr int CPR = COLS / 8, TOTAL = ROWS * CPR, RS = (COLS + PAD) * 2, NI = TOTAL / NTHR;
    static_assert(TOTAL % NTHR == 0, "stage_tile");
    u32x4 v[NI];
#pragma unroll
    for (int i = 0; i < NI; ++i) { const int idx = tid + i * NTHR, r = idx / CPR, c = idx % CPR; v[i] = *(const u32x4*)(src + (size_t)r * ld + c * 8); }
#pragma unroll
    for (int i = 0; i < NI; ++i) { const int idx = tid + i * NTHR, r = idx / CPR, c = idx % CPR; *(LAS u32x4*)(dst + r * RS + c * 16) = v[i]; }
}
template <int ROWS, int COLS> __device__ __forceinline__ void stage_load(u32x4 (&v)[ROWS * (COLS / 8) / NTHR], const bf16_t* src, size_t ld, int tid) {
    constexpr int CPR = COLS / 8, NI = ROWS * CPR / NTHR;
#pragma unroll
    for (int i = 0; i < NI; ++i) { const int idx = tid + i * NTHR, r = idx / CPR, c = idx % CPR; v[i] = *(const u32x4*)(src + (size_t)r * ld + c * 8); }
}
template <int ROWS, int COLS, int PAD> __device__ __forceinline__ void stage_store(LAS unsigned char* dst, const u32x4 (&v)[ROWS * (COLS / 8) / NTHR], int tid) {
    constexpr int CPR = COLS / 8, NI = ROWS * CPR / NTHR, RS = (COLS + PAD) * 2;
#pragma unroll
    for (int i = 0; i < NI; ++i) { const int idx = tid + i * NTHR, r = idx / CPR, c = idx % CPR; *(LAS u32x4*)(dst + r * RS + c * 16) = v[i]; }
}
__device__ __forceinline__ bf16x8 row_frag(const LAS unsigned char* tile, int RS, int n0, int k0, int lane) {
    return *(const LAS bf16x8*)(tile + (n0 + (lane & 15)) * RS + (k0 + 8 * (lane >> 4)) * 2);
}
__device__ __forceinline__ s16x4 tr4(const LAS unsigned char* p) { return __builtin_bit_cast(s16x4, __builtin_amdgcn_ds_read_tr16_b64_v4i16((LAS v4i16_t*)p)); }
__device__ __forceinline__ bf16x8 tr_frag(const LAS unsigned char* tile, int RS, int k0, int n0, int lane) {
    const int g = lane >> 4, i = lane & 15, q = i >> 2, pp = i & 3;
    const LAS unsigned char* a = tile + (k0 + 8 * g + q) * RS + (n0 + 4 * pp) * 2;
    const s16x4 lo = tr4(a), hi = tr4(a + 4 * RS);
    return (bf16x8){lo[0], lo[1], lo[2], lo[3], hi[0], hi[1], hi[2], hi[3]};
}
#define MFMA16(b, a, c) __builtin_amdgcn_mfma_f32_16x16x32_bf16((b), (a), (c), 0, 0, 0)

enum { RM_PLAIN = 0, RM_GATES = 1, RM_ROUTE = 2, RM_COMBINE = 3 };
struct RowArgs {
    const float* hin; float* hout; const bf16_t* hin16; bf16_t* hout16; const float* gain; bf16_t* hn; float* fout;
    const float* wgate; const float* bgate; float* gates;
    const float* rgw; const float* rgb; const float* rew; const float* reb; unsigned* cnt; int* list; int* tokinfo;
    const bf16_t* yb; const int* tokinfo_in;
    float* rsl;
    const bf16_t* wr;
};
template <int MODE, bool OUTF32, bool HIN16 = false, bool HOUT16 = false>
__device__ __forceinline__ void row_phase(LAS unsigned char* lds, const RowArgs& a, int G) {
    constexpr int NRED = 40, RG = (MODE == RM_ROUTE) ? 4 : 32;
    const int tid = fresh_tid(), lane = tid & 63, wave = __builtin_amdgcn_readfirstlane(tid >> 6);
    LAS float* red = (LAS float*)lds;
    LAS float* rstd_l = (LAS float*)(lds + 40960);
    LAS float* fin = (LAS float*)(lds + 41088);
    LAS int* cntl = (LAS int*)(lds + 46208);
    LAS int* basel = (LAS int*)(lds + 46336);
    const LAS int* tbl = (const LAS int*)(lds + TBL_OFF);
    const f32x4 g4 = *(const f32x4*)(a.gain + 4 * tid);
    for (int rb = fresh_bx(); rb < T / 32; rb += G) {
        const int row0 = rb * 32;
    float wg8[4][8]; float we[4][32]; float wgr[4][4];
    if constexpr (MODE == RM_GATES) {
#pragma unroll
        for (int i = 0; i < 4; ++i) { const f32x4 lo = *(const f32x4*)(a.wgate + (size_t)(4 * tid + i) * EVW + EVN), hi = *(const f32x4*)(a.wgate + (size_t)(4 * tid + i) * EVW + EVN + 4);
#pragma unroll
            for (int o = 0; o < 4; ++o) { wg8[i][o] = lo[o] * g4[i]; wg8[i][4 + o] = hi[o] * g4[i]; } }
    }
    if constexpr (MODE == RM_ROUTE && !HIN16) {
#pragma unroll
        for (int i = 0; i < 4; ++i) {
#pragma unroll
            for (int o4 = 0; o4 < 8; ++o4) { const f32x4 w = *(const f32x4*)(a.rew + (size_t)(4 * tid + i) * NEXP + 4 * o4);
#pragma unroll
                for (int o = 0; o < 4; ++o) we[i][4 * o4 + o] = w[o] * g4[i]; }
            const f32x4 w = *(const f32x4*)(a.rgw + (size_t)(4 * tid + i) * 4);
#pragma unroll
            for (int o = 0; o < 4; ++o) wgr[i][o] = w[o] * g4[i];
        }
    }
        if (MODE == RM_ROUTE && tid < 32) cntl[tid] = 0;
        f32x4 xs[RG];
        if constexpr (MODE == RM_ROUTE && HIN16) {
            const int fr = lane & 15, fq = lane >> 4;
            f32x4 acc[2][3]; float sq[2] = {0.f, 0.f};
#pragma unroll
            for (int mt = 0; mt < 2; ++mt)
#pragma unroll
                for (int nt = 0; nt < 3; ++nt) acc[mt][nt] = (f32x4){0.f, 0.f, 0.f, 0.f};
#pragma unroll 2
            for (int ks = 0; ks < 8; ++ks) { const int k0 = 256 * wave + 32 * ks + 8 * fq;
                bf16x8 af[2], bh[3], bl[3];
#pragma unroll
                for (int mt = 0; mt < 2; ++mt) af[mt] = *(const bf16x8*)(a.hin16 + (size_t)(row0 + 16 * mt + fr) * D + k0);
#pragma unroll
                for (int nt = 0; nt < 3; ++nt) { bh[nt] = *(const bf16x8*)(a.wr + (size_t)(16 * nt + fr) * D + k0); bl[nt] = *(const bf16x8*)(a.wr + (size_t)(48 + 16 * nt + fr) * D + k0); }
#pragma unroll
                for (int mt = 0; mt < 2; ++mt) {
#pragma unroll
                    for (int e = 0; e < 8; ++e) { const float v = bf2f((unsigned short)af[mt][e]); sq[mt] += v * v; }
#pragma unroll
                    for (int nt = 0; nt < 3; ++nt) { acc[mt][nt] = MFMA16(bh[nt], af[mt], acc[mt][nt]); acc[mt][nt] = MFMA16(bl[nt], af[mt], acc[mt][nt]); } }
            }
#pragma unroll
            for (int mt = 0; mt < 2; ++mt) { const int r = 16 * mt + fr;
#pragma unroll
                for (int nt = 0; nt < 3; ++nt)
#pragma unroll
                    for (int i = 0; i < 4; ++i) { const int o = 16 * nt + 4 * fq + i; if (o < 36) red[(r * 8 + wave) * NRED + o] = acc[mt][nt][i]; }
                float s = sq[mt]; s += __shfl_xor(s, 16); s += __shfl_xor(s, 32);
                if (fq == 0) red[(r * 8 + wave) * NRED + 36] = s; }
        } else {
        u32x2 xnext[(MODE == RM_ROUTE && HIN16) ? RG : 1];
        if constexpr (MODE == RM_ROUTE && HIN16) {
#pragma unroll
            for (int i = 0; i < RG; ++i) xnext[i] = *(const u32x2*)(a.hin16 + (size_t)(row0 + i) * D + 4 * tid);
        }
        for (int grp = 0; grp < 32 / RG; ++grp) {
            if constexpr (MODE == RM_ROUTE && HIN16) {
#pragma unroll
                for (int i = 0; i < RG; ++i) xs[i] = (f32x4){bf_lo(xnext[i].x), bf_hi(xnext[i].x), bf_lo(xnext[i].y), bf_hi(xnext[i].y)};
                const int gn = (grp + 1 < 32 / RG) ? grp + 1 : grp;
#pragma unroll
                for (int i = 0; i < RG; ++i) xnext[i] = *(const u32x2*)(a.hin16 + (size_t)(row0 + gn * RG + i) * D + 4 * tid);
            } else {
#pragma unroll
            for (int i = 0; i < RG; ++i) {
                if constexpr (HIN16) { const u32x2 t = *(const u32x2*)(a.hin16 + (size_t)(row0 + grp * RG + i) * D + 4 * tid); xs[i] = (f32x4){bf_lo(t.x), bf_hi(t.x), bf_lo(t.y), bf_hi(t.y)}; }
                else xs[i] = *(const f32x4*)(a.hin + (size_t)(row0 + grp * RG + i) * D + 4 * tid); }
            }
            if constexpr (MODE == RM_COMBINE) {
#pragma unroll
                for (int i = 0; i < RG; ++i) { const int row = row0 + grp * RG + i; const int* ti = a.tokinfo_in + (size_t)row * 8;
                    const int e0 = ti[0], p0 = ti[1], e1 = ti[3], p1 = ti[4]; const float w0 = __builtin_bit_cast(float, ti[2]), w1 = __builtin_bit_cast(float, ti[5]);
                    const size_t s0 = (size_t)tbl[e0] * 256 + p0, s1 = (size_t)tbl[e1] * 256 + p1;
                    const u32x2 y0 = *(const u32x2*)(a.yb + s0 * D + 4 * tid), y1 = *(const u32x2*)(a.yb + s1 * D + 4 * tid);
                    f32x4 x = xs[i];
                    x[0] += w0 * bf_lo(y0.x) + w1 * bf_lo(y1.x); x[1] += w0 * bf_hi(y0.x) + w1 * bf_hi(y1.x);
                    x[2] += w0 * bf_lo(y0.y) + w1 * bf_lo(y1.y); x[3] += w0 * bf_hi(y0.y) + w1 * bf_hi(y1.y);
                    xs[i] = x;
                    if constexpr (HOUT16) { u32x2 w; w.x = cvt_pk_bf16(x[0], x[1]); w.y = cvt_pk_bf16(x[2], x[3]); *(u32x2*)(a.hout16 + (size_t)row * D + 4 * tid) = w; }
                    else *(f32x4*)(a.hout + (size_t)row * D + 4 * tid) = x; }
            }
#pragma unroll
            for (int i = 0; i < RG; ++i) {
                const f32x4 x = xs[i]; const int r = grp * RG + i;
                float ssq[1]; ssq[0] = (x[0] * x[0] + x[1] * x[1]) + (x[2] * x[2] + x[3] * x[3]);
                if constexpr (MODE == RM_GATES) {
                    float v[8];
#pragma unroll
                    for (int o = 0; o < 8; ++o) v[o] = (x[0] * wg8[0][o] + x[1] * wg8[1][o]) + (x[2] * wg8[2][o] + x[3] * wg8[3][o]);
                    const float rv = wave_reduce_pow2<8>(v, lane);
                    if ((lane & 7) == 0) red[(r * 8 + wave) * NRED + (lane >> 3)] = rv;
                }
                if constexpr (MODE == RM_ROUTE) {
                    float v[32];
#pragma unroll
                    for (int o = 0; o < 32; ++o) v[o] = (x[0] * we[0][o] + x[1] * we[1][o]) + (x[2] * we[2][o] + x[3] * we[3][o]);
                    const float rv = wave_reduce_pow2<32>(v, lane);
                    if ((lane & 1) == 0) red[(r * 8 + wave) * NRED + (lane >> 1)] = rv;
                    float u[4];
#pragma unroll
                    for (int o = 0; o < 4; ++o) u[o] = (x[0] * wgr[0][o] + x[1] * wgr[1][o]) + (x[2] * wgr[2][o] + x[3] * wgr[3][o]);
                    const float ru = wave_reduce_pow2<4>(u, lane);
                    if ((lane & 15) == 0) red[(r * 8 + wave) * NRED + 32 + (lane >> 4)] = ru;
                }
                const float rs = wave_reduce_pow2<1>(ssq, lane);
                if (lane == 0) red[(r * 8 + wave) * NRED + 36] = rs;
            }
        }
        }
        __syncthreads();
        int fe0 = 0, fe1 = 0, lp0 = 0, lp1 = 0; float fw0 = 0.f, fw1 = 0.f, frs = 0.f;
        if (tid < 32) {
            const int r = tid, row = row0 + r;
            float s = 0.f;
#pragma unroll
            for (int w = 0; w < 8; ++w) s += red[(r * 8 + w) * NRED + 36];
            const float rstd = rsqrtf(s * (1.0f / D) + EPS);
            rstd_l[r] = rstd; frs = rstd;
            if constexpr (MODE == RM_GATES) {
#pragma unroll
                for (int o = 0; o < 8; ++o) { float d = 0.f;
#pragma unroll
                    for (int w = 0; w < 8; ++w) d += red[(r * 8 + w) * NRED + o];
                    a.gates[(size_t)row * 8 + o] = d * rstd + a.bgate[o]; }
            }
            if constexpr (MODE == RM_ROUTE) {
#pragma unroll
                for (int o = 0; o < 36; ++o) { float d = 0.f;
#pragma unroll
                    for (int w = 0; w < 8; ++w) d += red[(r * 8 + w) * NRED + o];
                    fin[r * NRED + o] = d * rstd + (o < 32 ? a.reb[o] : a.rgb[o - 32]); }
                const float l0 = fin[r * NRED + 32], l1 = fin[r * NRED + 33], l2 = fin[r * NRED + 34], l3 = fin[r * NRED + 35];
                int gsel = 0; float mx = l0;
                if (l1 > mx) { mx = l1; gsel = 1; }
                if (l2 > mx) { mx = l2; gsel = 2; }
                if (l3 > mx) { mx = l3; gsel = 3; }
                const float gp = 1.0f / (expf(l0 - mx) + expf(l1 - mx) + expf(l2 - mx) + expf(l3 - mx));
                float v1 = -INFINITY, v2 = -INFINITY; int i1 = 0, i2 = 0;
                for (int j = 0; j < 8; ++j) { const float v = fin[r * NRED + gsel * 8 + j]; if (v > v1) { v1 = v; i1 = j; } }
                for (int j = 0; j < 8; ++j) { const float v = fin[r * NRED + gsel * 8 + j]; if (j != i1 && v > v2) { v2 = v; i2 = j; } }
                const float e21 = expf(v2 - v1), inv = 1.0f / (1.0f + e21);
                fw0 = gp * inv; fw1 = gp * e21 * inv; fe0 = gsel * 8 + i1; fe1 = gsel * 8 + i2;
                lp0 = atomicAdd((int*)&cntl[fe0], 1); lp1 = atomicAdd((int*)&cntl[fe1], 1);
            }
        }
        __syncthreads();
        if constexpr (MODE == RM_ROUTE) {
            if (tid < 32) { const int c = cntl[tid]; basel[tid] = c ? (int)__hip_atomic_fetch_add(a.cnt + tid * 64, (unsigned)c, __ATOMIC_RELAXED, __HIP_MEMORY_SCOPE_AGENT) : 0; }
            __syncthreads();
            if (tid < 32) { const int row = row0 + tid; const int p0 = basel[fe0] + lp0, p1 = basel[fe1] + lp1;
                a.list[(size_t)fe0 * LISTCAP + p0] = row; a.list[(size_t)fe1 * LISTCAP + p1] = row;
                if constexpr (HIN16) { a.rsl[(size_t)fe0 * LISTCAP + p0] = frs; a.rsl[(size_t)fe1 * LISTCAP + p1] = frs; }
                int* ti = a.tokinfo + (size_t)row * 8;
                ti[0] = fe0; ti[1] = p0; ti[2] = __builtin_bit_cast(int, fw0); ti[3] = fe1; ti[4] = p1; ti[5] = __builtin_bit_cast(int, fw1); ti[6] = 0; ti[7] = 0; }
        }
        constexpr bool SRC16 = (MODE == RM_COMBINE) ? HOUT16 : HIN16;
        const float* src2 = (MODE == RM_COMBINE) ? (const float*)a.hout : a.hin; const bf16_t* src216 = (MODE == RM_COMBINE) ? (const bf16_t*)a.hout16 : a.hin16;
        if constexpr (MODE == RM_ROUTE && HIN16) {
        } else if constexpr (RG == 32) {
            if constexpr (OUTF32) {
#pragma unroll
                for (int i = 0; i < 32; ++i) { const int row = row0 + i; const float rs = rstd_l[i]; const f32x4 y = xs[i] * rs * g4; *(f32x4*)(a.fout + (size_t)row * D + 4 * tid) = y; }
            } else {
#pragma unroll
                for (int i = 0; i < 32; i += 2) { u32x2 ab[2];
#pragma unroll
                    for (int n = 0; n < 2; ++n) { const float rs = rstd_l[i + n]; const f32x4 y = xs[i + n] * rs * g4; ab[n].x = cvt_pk_bf16(y[0], y[1]); ab[n].y = cvt_pk_bf16(y[2], y[3]); }
                    const bool odd = tid & 1; const u32x2 give = odd ? ab[0] : ab[1];
                    u32x2 got; got.x = (unsigned)__shfl_xor((int)give.x, 1); got.y = (unsigned)__shfl_xor((int)give.y, 1);
                    u32x4 w; if (odd) { w.x = got.x; w.y = got.y; w.z = ab[1].x; w.w = ab[1].y; } else { w.x = ab[0].x; w.y = ab[0].y; w.z = got.x; w.w = got.y; }
                    *(u32x4*)(a.hn + (size_t)(row0 + i + (odd ? 1 : 0)) * D + 4 * (tid & ~1)) = w; }
            }
        } else {
        for (int grp = 0; grp < 4; ++grp) {
            f32x4 ys[8];
#pragma unroll
            for (int i = 0; i < 8; ++i) {
                if constexpr (SRC16) { const u32x2 t = *(const u32x2*)(src216 + (size_t)(row0 + grp * 8 + i) * D + 4 * tid); ys[i] = (f32x4){bf_lo(t.x), bf_hi(t.x), bf_lo(t.y), bf_hi(t.y)}; }
                else ys[i] = *(const f32x4*)(src2 + (size_t)(row0 + grp * 8 + i) * D + 4 * tid); }
#pragma unroll
            for (int i = 0; i < 8; ++i) { const int row = row0 + grp * 8 + i; const float rs = rstd_l[grp * 8 + i]; const f32x4 y = ys[i] * rs * g4;
                if constexpr (OUTF32) *(f32x4*)(a.fout + (size_t)row * D + 4 * tid) = y;
                else { u32x2 w; w.x = cvt_pk_bf16(y[0], y[1]); w.y = cvt_pk_bf16(y[2], y[3]); *(u32x2*)(a.hn + (size_t)row * D + 4 * tid) = w; } }
        }
        }
        __syncthreads();
    }
}

template <bool FINAL>
__device__ __forceinline__ void combine_phase(LAS unsigned char* lds, bf16_t* h16, const bf16_t* yb, const int* tokinfo, const float* gain, float* rsout, float* fout, int G) {
    const int tid = fresh_tid(), lane = tid & 63, wave = __builtin_amdgcn_readfirstlane(tid >> 6);
    const LAS int* tbl = (const LAS int*)(lds + TBL_OFF);
    const int gw = fresh_bx() * NWAVES + wave, NGW = G * NWAVES;
    auto ldti = [&](int r, int (&t)[6]) { const int* ti = tokinfo + (size_t)r * 8;
#pragma unroll
        for (int i = 0; i < 6; ++i) t[i] = ti[i]; };
    auto issue = [&](int r, const int (&t)[6], u32x4 (&hv)[4], u32x4 (&y0)[4], u32x4 (&y1)[4]) {
        const size_t s0 = (size_t)tbl[t[0]] * 256 + t[1], s1 = (size_t)tbl[t[3]] * 256 + t[4];
#pragma unroll
        for (int j = 0; j < 4; ++j) { const int col = 8 * lane + 512 * j;
            hv[j] = *(const u32x4*)(h16 + (size_t)r * D + col); y0[j] = *(const u32x4*)(yb + s0 * D + col); y1[j] = *(const u32x4*)(yb + s1 * D + col); } };
    int row = gw;
    if (row < T) {
        int tc[6], tn[6] = {0, 0, 0, 0, 0, 0};
        u32x4 hv[4], y0[4], y1[4], hvn[4], y0n[4], y1n[4];
        ldti(row, tc);
        if (row + NGW < T) ldti(row + NGW, tn);
        issue(row, tc, hv, y0, y1);
#pragma unroll 1
        for (;;) {
            const int rn = row + NGW; const bool more = rn < T;
            int tnn[6] = {0, 0, 0, 0, 0, 0};
            if (more && rn + NGW < T) ldti(rn + NGW, tnn);
            if (more) issue(rn, tn, hvn, y0n, y1n);
            const float w0 = __builtin_bit_cast(float, tc[2]), w1 = __builtin_bit_cast(float, tc[5]);
            float x[4][8]; float ss = 0.f;
#pragma unroll
            for (int j = 0; j < 4; ++j) {
                const unsigned hw[4] = {hv[j].x, hv[j].y, hv[j].z, hv[j].w}, aw[4] = {y0[j].x, y0[j].y, y0[j].z, y0[j].w}, bw[4] = {y1[j].x, y1[j].y, y1[j].z, y1[j].w};
#pragma unroll
                for (int q = 0; q < 4; ++q) { x[j][2 * q] = bf_lo(hw[q]) + w0 * bf_lo(aw[q]) + w1 * bf_lo(bw[q]); x[j][2 * q + 1] = bf_hi(hw[q]) + w0 * bf_hi(aw[q]) + w1 * bf_hi(bw[q]); }
#pragma unroll
                for (int q = 0; q < 8; ++q) ss += x[j][q] * x[j][q];
            }
            const float rs = rsqrtf(wave_sum(ss) * (1.0f / D) + EPS);
#pragma unroll
            for (int j = 0; j < 4; ++j) { const int col = 8 * lane + 512 * j;
                if constexpr (!FINAL) { u32x4 w; w.x = cvt_pk_bf16(x[j][0], x[j][1]); w.y = cvt_pk_bf16(x[j][2], x[j][3]); w.z = cvt_pk_bf16(x[j][4], x[j][5]); w.w = cvt_pk_bf16(x[j][6], x[j][7]);
                    *(u32x4*)(h16 + (size_t)row * D + col) = w; }
                if constexpr (FINAL) { const f32x4 g0 = *(const f32x4*)(gain + col), g1 = *(const f32x4*)(gain + col + 4);
                    const f32x4 a0 = (f32x4){x[j][0], x[j][1], x[j][2], x[j][3]} * rs * g0, a1 = (f32x4){x[j][4], x[j][5], x[j][6], x[j][7]} * rs * g1;
                    *(f32x4*)(fout + (size_t)row * D + col) = a0; *(f32x4*)(fout + (size_t)row * D + col + 4) = a1; }
            }
            if constexpr (!FINAL) { if (lane == 0) rsout[row] = rs; }
            if (!more) break;
            row = rn;
#pragma unroll
            for (int i = 0; i < 6; ++i) { tc[i] = tn[i]; tn[i] = tnn[i]; }
#pragma unroll
            for (int j = 0; j < 4; ++j) { hv[j] = hvn[j]; y0[j] = y0n[j]; y1[j] = y1n[j]; }
        }
    }
}
constexpr int MOE_PT_OFF = 80, MOE_PARTS = 128;
__device__ __forceinline__ void moe_tables(LAS unsigned char* lds, const unsigned* cnt) {
    LAS int* tbl = (LAS int*)(lds + TBL_OFF);
    __syncthreads();
    const int tq = fresh_tid();
    if (tq < 64) {
        const int e = tq & 31; const int c = (tq < 32) ? (int)__hip_atomic_load(cnt + e * 64, __ATOMIC_RELAXED, __HIP_MEMORY_SCOPE_AGENT) : 0;
        const int t256 = (c + 255) >> 8, t16 = (c + 15) >> 4, np = (t16 + 23) / 24;
        int s1 = t256, s2 = np;
#pragma unroll
        for (int d = 1; d < 32; d <<= 1) { const int a = __shfl_up(s1, d), b = __shfl_up(s2, d); if (tq >= d) { s1 += a; s2 += b; } }
        if (tq < 32) { tbl[e] = s1 - t256; tbl[33 + e] = c; tbl[MOE_PT_OFF + e] = s2 - np;
            if (e == 31) { tbl[32] = s1; tbl[MOE_PT_OFF + 32] = s2; }
            const int tpp = np ? (t16 + np - 1) / np : 0;
            for (int p = 0; p < np; ++p) { const int t0 = p * tpp, nt = (t16 - t0) < tpp ? (t16 - t0) : tpp; tbl[MOE_PARTS + (s2 - np) + p] = e | (t0 << 5) | (nt << 15); } }
    }
    __syncthreads();
}
struct Moe1Sched {
    static constexpr bool GATHER = true;
    const LAS int* tbl; const int* list; const char* xn; const char* wg; const char* wu; char* hid; int G, c;
    __device__ __forceinline__ bool next(int i, pg8::Unit& u) const {
        const int MT = __builtin_amdgcn_readfirstlane(tbl[32]); const int U = MT * 8; const long L = (long)i * G + c; if (L >= U) return false;
        int wgid = (int)L; { const int q = U / 8, r = U % 8, xcd = wgid % 8, off = wgid / 8; wgid = (xcd < r ? xcd * (q + 1) : r * (q + 1) + (xcd - r) * q) + off; }
        const int mtg = wgid >> 3, nt = wgid & 7; int e = 0;
        for (int k = 1; k < 32; ++k) e += (__builtin_amdgcn_readfirstlane(tbl[k]) <= mtg) ? 1 : 0;
        e = __builtin_amdgcn_readfirstlane(e);
        const int ml = mtg - __builtin_amdgcn_readfirstlane(tbl[e]);
        u.a = xn; u.b0 = wg + (size_t)e * WEXP_ONE + (size_t)nt * (128 * D * 2); u.b1 = wu + (size_t)e * WEXP_ONE + (size_t)nt * (128 * D * 2);
        u.out = hid; u.ldc = DEXP; u.pm = mtg; u.pn = nt; u.e = e | (ml << 8); return true;
    }
    __device__ __forceinline__ int arow(const pg8::Unit& u, int r) const {
        const int e = u.e & 255, ml = u.e >> 8; const int cntv = __builtin_amdgcn_readfirstlane(tbl[33 + e]); int idx = ml * 256 + r; idx = idx < cntv ? idx : 0;
        return list[(size_t)e * LISTCAP + idx];
    }
};
struct Moe2Sched {
    static constexpr bool GATHER = false;
    const LAS int* tbl; const char* hid; const char* wd; char* yb; int G, c;
    __device__ __forceinline__ bool next(int i, pg8::Unit& u) const {
        const int MT = __builtin_amdgcn_readfirstlane(tbl[32]); const int U = MT * 8; const long L = (long)i * G + c; if (L >= U) return false;
        int wgid = (int)L; { const int q = U / 8, r = U % 8, xcd = wgid % 8, off = wgid / 8; wgid = (xcd < r ? xcd * (q + 1) : r * (q + 1) + (xcd - r) * q) + off; }
        const int mtg = wgid >> 3, pn = wgid & 7; int e = 0;
        for (int k = 1; k < 32; ++k) e += (__builtin_amdgcn_readfirstlane(tbl[k]) <= mtg) ? 1 : 0;
        e = __builtin_amdgcn_readfirstlane(e);
        u.a = hid + (size_t)mtg * (256 * DEXP * 2); u.b0 = wd + (size_t)e * WEXP_ONE + (size_t)pn * (256 * DEXP * 2); u.b1 = u.b0 + (size_t)128 * DEXP * 2;
        u.out = yb; u.ldc = D; u.pm = mtg; u.pn = pn; u.e = e; return true;
    }
    __device__ __forceinline__ int arow(const pg8::Unit&, int r) const { return r; }
};
struct KVSched {
    static constexpr bool GATHER = false;
    const char* memn; const char* wk; const char* wv; char* kx; char* vx; int G, c;
    __device__ __forceinline__ bool next(int i, pg8::Unit& u) const {
        const int j = ((c + G - (G >> 1)) % G) + i * G; if (j >= 32) return false;
        const int l = j >> 4, kv = (j >> 3) & 1, idx = j & 7;
        u.a = memn + (size_t)l * (NMEM * D * 2);
        const char* wb = (kv ? wv : wk) + (size_t)l * ((size_t)D * D * 2) + (size_t)idx * (256 * D * 2);
        u.b0 = wb; u.b1 = wb + (size_t)128 * D * 2; u.out = (kv ? vx : kx) + (size_t)l * (NMEM * D * 2); u.ldc = D; u.pm = 0; u.pn = idx; u.e = 0; return true;
    }
    __device__ __forceinline__ int arow(const pg8::Unit&, int r) const { return r; }
};

__device__ __forceinline__ void mlstm_prep(LAS unsigned char* lds, int h, const float* gates, float* bcum, float* gi, float* marr, float* aprev, float* blg) {
    const int tid = fresh_tid(), lane = tid & 63, wave = tid >> 6;
    LAS float* bl = (LAS float*)lds; LAS float* dm = bl + 64;
    for (int c = wave; c < NCH; c += NWAVES) {
        const int t = c * CH + 2 * lane;
        const float i0 = gates[(size_t)t * 8 + h], i1 = gates[(size_t)(t + 1) * 8 + h], f0 = gates[(size_t)t * 8 + 4 + h], f1 = gates[(size_t)(t + 1) * 8 + 4 + h];
        const float l0 = logsigf(f0), l1 = logsigf(f1);
        float p = l0 + l1;
#pragma unroll
        for (int o = 1; o < 64; o <<= 1) { const float n = __shfl_up(p, o); if (lane >= o) p += n; }
        const float bc1 = p, bc0 = p - l1, blast = __shfl(p, 63);
        bcum[(size_t)t * 4 + h] = bc0; bcum[(size_t)(t + 1) * 4 + h] = bc1;
        gi[(size_t)t * 4 + h] = i0 - bc0; gi[(size_t)(t + 1) * 4 + h] = i1 - bc1;
        const float d = wave_max(fmaxf(blast - bc0 + i0, blast - bc1 + i1));
        if (lane == 0) { bl[c] = blast; dm[c] = d; }
    }
    __syncthreads();
    if (tid == 0) {
        float m = 0.f;
        for (int c = 0; c < NCH; ++c) { marr[h * 65 + c] = m; const float b = bl[c], mn = fmaxf(b + m, dm[c]); aprev[h * 64 + c] = expf(b + m - mn); blg[h * 64 + c] = b; m = mn; }
        marr[h * 65 + NCH] = m;
    }
    __syncthreads();
}

__device__ __forceinline__ void mlstm_B(LAS unsigned char* lds, int c, int h, const bf16_t* Z, const float* gi, const float* marr, const float* blg, float* KC, float* KN) {
    constexpr int RS = (DH + 16) * 2;
    const int tid = fresh_tid(), lane = tid & 63, wave = __builtin_amdgcn_readfirstlane(tid >> 6), fr = lane & 15, fq = lane >> 4;
    LAS unsigned char* Vt = lds; LAS unsigned char* Kt = lds + CH * RS; LAS float* asc = (LAS float*)(lds + 2 * CH * RS);
    const int t0 = c * CH;
    __syncthreads();
    if (tid < CH) asc[tid] = expf(blg[h * 64 + c] + gi[(size_t)(t0 + tid) * 4 + h] - marr[h * 65 + c + 1]);
    __syncthreads();
    stage_tile<CH, DH, 16>(Vt, Z + (size_t)t0 * EVN + 3072 + h * DH, EVN, tid);
    {
        u32x4 v[8];
#pragma unroll
        for (int i = 0; i < 8; ++i) { const int idx = tid + i * NTHR, r = idx >> 5, cc = idx & 31; v[i] = *(const u32x4*)(Z + (size_t)(t0 + r) * EVN + 2048 + h * DH + cc * 8); }
#pragma unroll
        for (int i = 0; i < 8; ++i) { const int idx = tid + i * NTHR, r = idx >> 5, cc = idx & 31; const float s = asc[r]; u32x4 o;
            o.x = cvt_pk_bf16(bf_lo(v[i].x) * s, bf_hi(v[i].x) * s); o.y = cvt_pk_bf16(bf_lo(v[i].y) * s, bf_hi(v[i].y) * s);
            o.z = cvt_pk_bf16(bf_lo(v[i].z) * s, bf_hi(v[i].z) * s); o.w = cvt_pk_bf16(bf_lo(v[i].w) * s, bf_hi(v[i].w) * s);
            *(LAS u32x4*)(Kt + r * RS + cc * 16) = o; }
    }
    __syncthreads();
    const int wr2 = wave >> 2, wc2 = wave & 3;
    f32x4 acc[8][4];
#pragma unroll
    for (int mi = 0; mi < 8; ++mi)
#pragma unroll
        for (int nj = 0; nj < 4; ++nj) acc[mi][nj] = (f32x4){0.f, 0.f, 0.f, 0.f};
#pragma unroll
    for (int ks = 0; ks < 4; ++ks) {
        bf16x8 bk[4];
#pragma unroll
        for (int nj = 0; nj < 4; ++nj) bk[nj] = tr_frag(Kt, RS, 32 * ks, 64 * wc2 + 16 * nj, lane);
#pragma unroll
        for (int mi = 0; mi < 8; ++mi) { const bf16x8 av = tr_frag(Vt, RS, 32 * ks, 128 * wr2 + 16 * mi, lane);
#pragma unroll
            for (int nj = 0; nj < 4; ++nj) acc[mi][nj] = MFMA16(bk[nj], av, acc[mi][nj]); }
    }
#define ACC8(m) "+v"(acc[m][0]), "+v"(acc[m][1]), "+v"(acc[m][2]), "+v"(acc[m][3]), "+v"(acc[m + 1][0]), "+v"(acc[m + 1][1]), "+v"(acc[m + 1][2]), "+v"(acc[m + 1][3])
    asm volatile("s_nop 0" : ACC8(0), ACC8(2)); asm volatile("s_nop 0" : ACC8(4), ACC8(6));
    asm volatile("s_nop 7\n\ts_nop 7\n\ts_nop 7" : ACC8(0), ACC8(2)); asm volatile("s_nop 0" : ACC8(4), ACC8(6));
#undef ACC8
    bf16_t* kc = (bf16_t*)KC + (size_t)(c * NH + h) * DH * DH;
#pragma unroll
    for (int mi = 0; mi < 8; ++mi)
#pragma unroll
        for (int nj = 0; nj < 4; ++nj) { u32x2 w; w.x = cvt_pk_bf16(acc[mi][nj][0], acc[mi][nj][1]); w.y = cvt_pk_bf16(acc[mi][nj][2], acc[mi][nj][3]);
            *(u32x2*)(kc + (size_t)(128 * wr2 + 16 * mi + fr) * DH + 64 * wc2 + 16 * nj + 4 * fq) = w; }
    if (tid < DH) { float s = 0.f; for (int r = 0; r < CH; ++r) s += bf2f(*(const LAS unsigned short*)(Kt + r * RS + tid * 2)); KN[(size_t)(c * NH + h) * DH + tid] = s; }
}

__device__ __forceinline__ void mlstm_scan(const float* KC, const float* KN, const float* aprev, bf16_t* CST, float* NST, int G) {
    const int gid = fresh_bx() * NTHR + fresh_tid(), NT = G * NTHR;
    for (int p = gid; p < NH * DH * DH / 2; p += NT) {
        const int h = p / (DH * DH / 2); const size_t e2 = (size_t)(p % (DH * DH / 2)) * 2;
        float s0 = 0.f, s1 = 0.f;
#pragma unroll 1
        for (int c0 = 0; c0 < NCH; c0 += 32) {
            unsigned k[32]; float ap[32];
#pragma unroll
            for (int j = 0; j < 32; ++j) { k[j] = *(const unsigned*)((const bf16_t*)KC + (size_t)((c0 + j) * NH + h) * DH * DH + e2); ap[j] = aprev[h * 64 + c0 + j]; }
#pragma unroll
            for (int j = 0; j < 32; ++j) { const size_t o = (size_t)((c0 + j) * NH + h) * DH * DH + e2;
                *(unsigned*)(CST + o) = cvt_pk_bf16(s0, s1);
                s0 = ap[j] * s0 + bf_lo(k[j]); s1 = ap[j] * s1 + bf_hi(k[j]); }
        }
    }
    for (int p = gid; p < NH * DH; p += NT) {
        const int h = p / DH, dk = p % DH; float s = 0.f;
#pragma unroll 1
        for (int c0 = 0; c0 < NCH; c0 += 32) {
            float kn[32], ap[32];
#pragma unroll
            for (int j = 0; j < 32; ++j) { kn[j] = KN[(size_t)((c0 + j) * NH + h) * DH + dk]; ap[j] = aprev[h * 64 + c0 + j]; }
#pragma unroll
            for (int j = 0; j < 32; ++j) { NST[(size_t)((c0 + j) * NH + h) * DH + dk] = s; s = ap[j] * s + kn[j]; }
        }
    }
}

__device__ __forceinline__ void mlstm_D(LAS unsigned char* lds, int c, int h, const bf16_t* Z, const float* gi, const float* bcum, const float* marr, const bf16_t* CST, const float* NST,
                                        const float* hgain, bf16_t* YCAT) {
    constexpr int XOFF = 0, XBYTES = 69632, POFF = XBYTES, PRS = (CH + 8) * 2, SOFF = POFF + 8 * 16 * PRS;
    const int tid = fresh_tid(), lane = tid & 63, wave = __builtin_amdgcn_readfirstlane(tid >> 6), fr = lane & 15, fq = lane >> 4;
    LAS unsigned char* X = lds + XOFF; LAS unsigned char* Pw = lds + POFF + wave * 16 * PRS;
    LAS float* gS = (LAS float*)(lds + SOFF); LAS float* Mrow = gS + CH; LAS float* nst = Mrow + CH;
    const int t0 = c * CH; const float mc = marr[h * 65 + c];
    __syncthreads();
    if (tid < CH) gS[tid] = gi[(size_t)(t0 + tid) * 4 + h];
    else if (tid < CH + DH) nst[tid - CH] = NST[(size_t)(c * NH + h) * DH + (tid - CH)];
    __syncthreads();
    if (tid < CH) { float m = mc; for (int s = 0; s <= tid; ++s) m = fmaxf(m, gS[s]); Mrow[tid] = m; }
    stage_tile<CH, DH, 8>(X, Z + (size_t)t0 * EVN + 2048 + h * DH, EVN, tid);
    const int tl = 16 * wave + fr; const size_t trow = (size_t)(t0 + tl);
    bf16x8 aq[8];
#pragma unroll
    for (int ks = 0; ks < 8; ++ks) aq[ks] = *(const bf16x8*)(Z + trow * EVN + 1024 + h * DH + 32 * ks + 8 * fq);
    __syncthreads();
    f32x4 S[8];
#pragma unroll
    for (int j = 0; j < 8; ++j) S[j] = (f32x4){0.f, 0.f, 0.f, 0.f};
#pragma unroll
    for (int ks = 0; ks < 8; ++ks)
        {
#pragma unroll
          for (int j = 0; j < 8; ++j) if (j <= wave) S[j] = MFMA16(row_frag(X, (DH + 8) * 2, 16 * j, 32 * ks, lane), aq[ks], S[j]);
          asm volatile("" ::: "memory"); }
    float nq = 0.f;
#pragma unroll
    for (int ks = 0; ks < 8; ++ks)
#pragma unroll
        for (int e = 0; e < 8; ++e) nq += bf2f((unsigned short)aq[ks][e]) * nst[32 * ks + 8 * fq + e];
    nq += __shfl_xor(nq, 16); nq += __shfl_xor(nq, 32);
    const float Mt = Mrow[tl]; const float SC = 0.0625f; const float wi = expf(mc - Mt) * SC;
    float rsum = 0.f;
#pragma unroll
    for (int j = 0; j < 8; ++j) { float pv[4];
#pragma unroll
        for (int i = 0; i < 4; ++i) { const int s = 16 * j + 4 * fq + i; const float p = (s <= tl) ? S[j][i] * SC * expf(gS[s] - Mt) : 0.f; pv[i] = p; rsum += p; }
        u32x2 w; w.x = cvt_pk_bf16(pv[0], pv[1]); w.y = cvt_pk_bf16(pv[2], pv[3]);
        *(LAS u32x2*)(Pw + fr * PRS + (16 * j + 4 * fq) * 2) = w; }
    rsum += __shfl_xor(rsum, 16); rsum += __shfl_xor(rsum, 32);
    const float den = wi * nq + rsum;
    f32x4 acc[16];
#pragma unroll
    for (int j = 0; j < 16; ++j) acc[j] = (f32x4){0.f, 0.f, 0.f, 0.f};
    const bf16_t* cst = CST + (size_t)(c * NH + h) * DH * DH;
#pragma unroll
    for (int half = 0; half < 2; ++half) {
        __syncthreads();
        stage_tile<DH, 128, 8>(X, cst + half * 128, DH, tid);
        __syncthreads();
#pragma unroll
        for (int ks = 0; ks < 4; ++ks)
            { const bf16x8 aqh = *(const bf16x8*)(Z + trow * EVN + 1024 + h * DH + 32 * (half * 4 + ks) + 8 * fq);
#pragma unroll
              for (int j = 0; j < 16; ++j) acc[j] = MFMA16(row_frag(X, (128 + 8) * 2, 16 * j, 32 * ks, lane), aqh, acc[j]);
              asm volatile("" ::: "memory"); }
    }
#pragma unroll
    for (int j = 0; j < 16; ++j) acc[j] = acc[j] * wi;
    __syncthreads();
    stage_tile<CH, DH, 16>(X, Z + (size_t)t0 * EVN + 3072 + h * DH, EVN, tid);
    __syncthreads();
#pragma unroll 1
    for (int ks = 0; ks < 4; ++ks) { const bf16x8 ap = *(const LAS bf16x8*)(Pw + fr * PRS + (32 * ks + 8 * fq) * 2);
#pragma unroll
        for (int j = 0; j < 16; ++j) acc[j] = MFMA16(tr_frag(X, (DH + 16) * 2, 32 * ks, 16 * j, lane), ap, acc[j]); }
    const float mt = bcum[trow * 4 + h] + Mt; const float inv = 1.0f / fmaxf(fabsf(den), expf(-mt));
    float ss = 0.f;
#pragma unroll
    for (int j = 0; j < 16; ++j) { acc[j] = acc[j] * inv; ss += (acc[j][0] * acc[j][0] + acc[j][1] * acc[j][1]) + (acc[j][2] * acc[j][2] + acc[j][3] * acc[j][3]); }
    ss += __shfl_xor(ss, 16); ss += __shfl_xor(ss, 32);
    const float rs = rsqrtf(ss * (1.0f / DH) + EPS);
#pragma unroll
    for (int j = 0; j < 16; j += 2) { u32x2 ab[2];
#pragma unroll
        for (int n = 0; n < 2; ++n) { const int col = h * DH + 16 * (j + n) + 4 * fq;
            const f32x4 gn = *(const f32x4*)(hgain + col); const u32x2 ov = *(const u32x2*)(Z + trow * EVN + 4096 + col);
            const float o0 = bf_lo(ov.x), o1 = bf_hi(ov.x), o2 = bf_lo(ov.y), o3 = bf_hi(ov.y);
            const float y0 = acc[j + n][0] * rs * gn[0] / (1.0f + expf(-o0)), y1 = acc[j + n][1] * rs * gn[1] / (1.0f + expf(-o1));
            const float y2 = acc[j + n][2] * rs * gn[2] / (1.0f + expf(-o2)), y3 = acc[j + n][3] * rs * gn[3] / (1.0f + expf(-o3));
            ab[n].x = cvt_pk_bf16(y0, y1); ab[n].y = cvt_pk_bf16(y2, y3); }
        const bool odd = fq & 1; const u32x2 give = odd ? ab[0] : ab[1];
        u32x2 got; got.x = (unsigned)__shfl_xor((int)give.x, 16); got.y = (unsigned)__shfl_xor((int)give.y, 16);
        u32x4 w; if (odd) { w.x = got.x; w.y = got.y; w.z = ab[1].x; w.w = ab[1].y; } else { w.x = ab[0].x; w.y = ab[0].y; w.z = got.x; w.w = got.y; }
        *(u32x4*)(YCAT + trow * D + 1024 + h * DH + 16 * (j + (odd ? 1 : 0)) + 4 * (fq & 2)) = w; if ((j & 3) == 2) asm volatile("" ::: "memory"); }
}

__device__ __forceinline__ void pool_diffs(const bf16_t* Z, bf16_t* DP, int G) {
    const int gid = fresh_bx() * NTHR + fresh_tid(), NT = G * NTHR;
    for (int it = gid; it < T * 128; it += NT) {
        const int t = it >> 7, col = (it & 127) * 8, w = 2 << (col >> 8), cnt = (t + 1 < w) ? t + 1 : w;
        float s[8];
#pragma unroll
        for (int e = 0; e < 8; ++e) s[e] = 0.f;
        u32x4 v = (u32x4){0u, 0u, 0u, 0u};
        for (int k = cnt - 1; k >= 0; --k) { v = *(const u32x4*)(Z + (size_t)(t - k) * EVN + col);
            s[0] += bf_lo(v.x); s[1] += bf_hi(v.x); s[2] += bf_lo(v.y); s[3] += bf_hi(v.y); s[4] += bf_lo(v.z); s[5] += bf_hi(v.z); s[6] += bf_lo(v.w); s[7] += bf_hi(v.w); }
        const float ic = 1.0f / (float)cnt; u32x4 o;
        o.x = cvt_pk_bf16(s[0] * ic - bf_lo(v.x), s[1] * ic - bf_hi(v.x)); o.y = cvt_pk_bf16(s[2] * ic - bf_lo(v.y), s[3] * ic - bf_hi(v.y));
        o.z = cvt_pk_bf16(s[4] * ic - bf_lo(v.z), s[5] * ic - bf_hi(v.z)); o.w = cvt_pk_bf16(s[6] * ic - bf_lo(v.w), s[7] * ic - bf_hi(v.w));
        *(u32x4*)(DP + (size_t)t * 1024 + col) = o;
    }
}
__device__ __forceinline__ void conv_gate(const bf16_t* ZB, const bf16_t* ZC, const float* cw, bf16_t* Y, int G) {
    const int gid = fresh_bx() * NTHR + fresh_tid(), NT = G * NTHR;
    for (int it = gid; it < T * 256; it += NT) {
        const int t = it >> 8, col = (it & 255) * 8; const size_t o = (size_t)t * D + col;
        const u32x4 z0 = *(const u32x4*)(ZC + o), gb = *(const u32x4*)(ZB + o);
        const u32x4 z1 = (t >= 1) ? *(const u32x4*)(ZC + o - D) : (u32x4){0u, 0u, 0u, 0u}, z2 = (t >= 2) ? *(const u32x4*)(ZC + o - 2 * D) : (u32x4){0u, 0u, 0u, 0u};
        const f32x4 wa0 = *(const f32x4*)(cw + col), wa1 = *(const f32x4*)(cw + col + 4), wb0 = *(const f32x4*)(cw + D + col), wb1 = *(const f32x4*)(cw + D + col + 4),
                    wc0 = *(const f32x4*)(cw + 2 * D + col), wc1 = *(const f32x4*)(cw + 2 * D + col + 4);
        float r[8];
        r[0] = bf_lo(gb.x) * (wa0[0] * bf_lo(z2.x) + wb0[0] * bf_lo(z1.x) + wc0[0] * bf_lo(z0.x)); r[1] = bf_hi(gb.x) * (wa0[1] * bf_hi(z2.x) + wb0[1] * bf_hi(z1.x) + wc0[1] * bf_hi(z0.x));
        r[2] = bf_lo(gb.y) * (wa0[2] * bf_lo(z2.y) + wb0[2] * bf_lo(z1.y) + wc0[2] * bf_lo(z0.y)); r[3] = bf_hi(gb.y) * (wa0[3] * bf_hi(z2.y) + wb0[3] * bf_hi(z1.y) + wc0[3] * bf_hi(z0.y));
        r[4] = bf_lo(gb.z) * (wa1[0] * bf_lo(z2.z) + wb1[0] * bf_lo(z1.z) + wc1[0] * bf_lo(z0.z)); r[5] = bf_hi(gb.z) * (wa1[1] * bf_hi(z2.z) + wb1[1] * bf_hi(z1.z) + wc1[1] * bf_hi(z0.z));
        r[6] = bf_lo(gb.w) * (wa1[2] * bf_lo(z2.w) + wb1[2] * bf_lo(z1.w) + wc1[2] * bf_lo(z0.w)); r[7] = bf_hi(gb.w) * (wa1[3] * bf_hi(z2.w) + wb1[3] * bf_hi(z1.w) + wc1[3] * bf_hi(z0.w));
        u32x4 w; w.x = cvt_pk_bf16(r[0], r[1]); w.y = cvt_pk_bf16(r[2], r[3]); w.z = cvt_pk_bf16(r[4], r[5]); w.w = cvt_pk_bf16(r[6], r[7]);
        *(u32x4*)(Y + o) = w;
    }
}

__device__ __forceinline__ void xattn_unit(LAS unsigned char* lds, int hd, int qt, const bf16_t* QX, const bf16_t* KX, const bf16_t* VX, bf16_t* O) {
    constexpr int XBYTES = 73728, PRS = (NMEM + 8) * 2;
    const int tid = fresh_tid(), lane = tid & 63, wave = __builtin_amdgcn_readfirstlane(tid >> 6), fr = lane & 15, fq = lane >> 4;
    LAS unsigned char* X = lds; LAS unsigned char* Pw = lds + XBYTES + wave * 16 * PRS;
    const size_t trow = (size_t)qt * 128 + 16 * wave + fr;
    f32x4 S[16];
#pragma unroll
    for (int j = 0; j < 16; ++j) S[j] = (f32x4){0.f, 0.f, 0.f, 0.f};
    u32x4 pf[8];
    stage_load<NMEM, 128>(pf, KX + hd * XD, D, tid);
#pragma unroll 1
    for (int kc = 0; kc < 4; ++kc) {
        __syncthreads();
        stage_store<NMEM, 128, 8>(X, pf, tid);
        bf16x8 aq[4];
#pragma unroll
        for (int ks = 0; ks < 4; ++ks) aq[ks] = *(const bf16x8*)(QX + trow * D + hd * XD + kc * 128 + 32 * ks + 8 * fq);
        if (kc < 3) stage_load<NMEM, 128>(pf, KX + hd * XD + (kc + 1) * 128, D, tid);
        __syncthreads();
#pragma unroll
        for (int ks = 0; ks < 4; ++ks)
#pragma unroll
            for (int j = 0; j < 16; ++j) S[j] = MFMA16(row_frag(X, (128 + 8) * 2, 16 * j, 32 * ks, lane), aq[ks], S[j]);
    }
    float mx = -INFINITY;
#pragma unroll
    for (int j = 0; j < 16; ++j) mx = fmaxf(mx, fmaxf(fmaxf(S[j][0], S[j][1]), fmaxf(S[j][2], S[j][3])));
    mx = fmaxf(mx, __shfl_xor(mx, 16)); mx = fmaxf(mx, __shfl_xor(mx, 32));
    const float SC = 0.044194173824159216f;
    float sum = 0.f;
#pragma unroll
    for (int j = 0; j < 16; ++j) { float pv[4];
#pragma unroll
        for (int i = 0; i < 4; ++i) { pv[i] = __expf((S[j][i] - mx) * SC); sum += pv[i]; }
        u32x2 w; w.x = cvt_pk_bf16(pv[0], pv[1]); w.y = cvt_pk_bf16(pv[2], pv[3]);
        *(LAS u32x2*)(Pw + fr * PRS + (16 * j + 4 * fq) * 2) = w; }
    sum += __shfl_xor(sum, 16); sum += __shfl_xor(sum, 32);
    const float inv = 1.0f / sum;
    asm volatile("s_waitcnt lgkmcnt(0)" ::: "memory");
    stage_load<NMEM, 128>(pf, VX + hd * XD, D, tid);
    bf16x8 ap[8];
#pragma unroll
    for (int ks = 0; ks < 8; ++ks) ap[ks] = *(const LAS bf16x8*)(Pw + fr * PRS + (32 * ks + 8 * fq) * 2);
#pragma unroll 1
    for (int vc = 0; vc < 4; ++vc) {
        __syncthreads();
        stage_store<NMEM, 128, 16>(X, pf, tid);
        if (vc < 3) stage_load<NMEM, 128>(pf, VX + hd * XD + (vc + 1) * 128, D, tid);
        __syncthreads();
        f32x4 oa[8];
#pragma unroll
        for (int j = 0; j < 8; ++j) oa[j] = (f32x4){0.f, 0.f, 0.f, 0.f};
#pragma unroll
        for (int ks = 0; ks < 8; ++ks)
#pragma unroll
            for (int j = 0; j < 8; ++j) oa[j] = MFMA16(tr_frag(X, (128 + 16) * 2, 32 * ks, 16 * j, lane), ap[ks], oa[j]);
#pragma unroll
        for (int j = 0; j < 8; j += 2) { u32x2 a, b; a.x = cvt_pk_bf16(oa[j][0] * inv, oa[j][1] * inv); a.y = cvt_pk_bf16(oa[j][2] * inv, oa[j][3] * inv);
            b.x = cvt_pk_bf16(oa[j + 1][0] * inv, oa[j + 1][1] * inv); b.y = cvt_pk_bf16(oa[j + 1][2] * inv, oa[j + 1][3] * inv);
            const bool odd = fq & 1; const u32x2 give = odd ? a : b;
            u32x2 got; got.x = (unsigned)__shfl_xor((int)give.x, 16); got.y = (unsigned)__shfl_xor((int)give.y, 16);
            u32x4 w; if (odd) { w.x = got.x; w.y = got.y; w.z = b.x; w.w = b.y; } else { w.x = a.x; w.y = a.y; w.z = got.x; w.w = got.y; }
            *(u32x4*)(O + trow * D + hd * XD + vc * 128 + 16 * (j + (odd ? 1 : 0)) + 4 * (fq & 2)) = w; }
    }
}

__device__ __forceinline__ float vec_elem_f32(u32x4 v, int j) { const unsigned u = v[j]; return __builtin_bit_cast(float, u); }
__device__ __forceinline__ void glds4(const char* base, unsigned voff, unsigned lds_dst) {
    unsigned keep;
    asm volatile("s_mov_b32 %0, m0\n\ts_mov_b32 m0, %3\n\ts_nop 0\n\tglobal_load_lds_dword %1, %2\n\ts_mov_b32 m0, %0" : "=&s"(keep) : "v"(voff), "s"(base), "s"(lds_dst) : "memory");
}
struct MoeDesc { int valid, e, sl, t0, nt, cnt, slot0; const char* Ab; bf16_t* out; const float* W0; const float* W1; };
template <int MODE, int NMT, int ABL>
__device__ __forceinline__ void moe_unit(LAS unsigned char* lds, const char* Abase, u32x4 wrsrc, unsigned wsoff, int bvoff, const unsigned (&voff)[6], unsigned asb, bf16_t* out, int w, int fr, int fq, int bwoff, int bsw,
                                         const LAS unsigned char* pa0, const LAS unsigned char* pa1, const LAS unsigned char* pb0, const LAS unsigned char* pb1,
                                         int t0, int cnt, int slot0, int sl,
                                         bool pre, u32x4 (&bst)[2][4], u32x4 wrsrc_n, unsigned wsoff_n, const char* Abase_n, const LAS int* stash, unsigned kco0, unsigned kco1, const LAS float* gtab, const LAS float* rstash) {
    constexpr int K = (MODE == 2) ? DEXP : D, KS = K / 64, LDA = K, NW = (MODE == 1) ? DEXP : D, LDO = (MODE == 1) ? DEXP : D;
    constexpr int BS_OFF = 0, AS_OFF = 32768, AW = 6144;
        f32x4 acc[NMT][8];
#pragma unroll
        for (int mi = 0; mi < NMT; ++mi)
#pragma unroll
            for (int j = 0; j < 8; ++j) acc[mi][j] = (f32x4){0.f, 0.f, 0.f, 0.f};
        constexpr unsigned BSTEP = 64u * NW * 4u;
#define MOE_LOADB(set, rs, so) do { if constexpr (ABL == 2) break; const unsigned _so = (so); _Pragma("unroll") for (int kk = 0; kk < 4; ++kk) \
            asm volatile("buffer_load_dwordx4 %0, %1, %2, %3 offen" : "=v"(bst[set][kk]) : "v"(bvoff), "s"(rs), "s"(_so + (unsigned)kk * (NW * 4u)) : "memory"); } while (0)
#define MOE_WAITB(set, n) asm volatile("s_waitcnt vmcnt(%4)" : "+v"(bst[set][0]), "+v"(bst[set][1]), "+v"(bst[set][2]), "+v"(bst[set][3]) : "n"(n) : "memory")
#define MOE_DMAA(buf, step) do { if constexpr (ABL == 2) break; _Pragma("unroll") for (int q = 0; q < 2 * NMT; ++q) glds16(Abase + (size_t)(step) * 128, voff[q], asb + (unsigned)(buf) * (8 * AW) + (unsigned)q * 1024u); } while (0)
#define MOE_WRITEB(set, buf, step) do { LAS unsigned char* _b = lds + BS_OFF + (buf) * 16384; \
        if constexpr (MODE == 1) { const f32x4 _g = *(const LAS f32x4*)(gtab + (step) * 64);     \
            _Pragma("unroll") for (int j = 0; j < 4; ++j) { u32x2 o; \
                o.x = cvt_pk_bf16(vec_elem_f32(bst[set][0], j) * _g[0], vec_elem_f32(bst[set][1], j) * _g[1]); o.y = cvt_pk_bf16(vec_elem_f32(bst[set][2], j) * _g[2], vec_elem_f32(bst[set][3], j) * _g[3]); \
                *(LAS u32x2*)(_b + bwoff + j * 128 + (((bsw) ^ (((j) >> 1) & 1)) * 16)) = o; } \
        } else { \
        _Pragma("unroll") for (int j = 0; j < 4; ++j) { u32x2 o; \
            o.x = cvt_pk_bf16(vec_elem_f32(bst[set][0], j), vec_elem_f32(bst[set][1], j)); o.y = cvt_pk_bf16(vec_elem_f32(bst[set][2], j), vec_elem_f32(bst[set][3], j)); \
            *(LAS u32x2*)(_b + bwoff + j * 128 + (((bsw) ^ (((j) >> 1) & 1)) * 16)) = o; } } } while (0)
#define MOE_COMPUTE(buf) do { if constexpr (ABL == 1) break; \
        _Pragma("unroll") for (int ks = 0; ks < 2; ++ks) { bf16x8 af[NMT]; const LAS unsigned char* _pa = (ks ? pa1 : pa0) + (buf) * (8 * AW); const LAS unsigned char* _pb = (ks ? pb1 : pb0) + (buf) * 16384; \
            _Pragma("unroll") for (int mi = 0; mi < NMT; ++mi) af[mi] = *(const LAS bf16x8*)(_pa + mi * 2048); \
            _Pragma("unroll") for (int j = 0; j < 8; ++j) { const bf16x8 bf = *(const LAS bf16x8*)(_pb + j * 2048); \
                _Pragma("unroll") for (int mi = 0; mi < NMT; ++mi) acc[mi][j] = MFMA16(bf, af[mi], acc[mi][j]); } } } while (0)
        if (!pre) {
            __syncthreads();
            MOE_LOADB(0, wrsrc, wsoff); MOE_LOADB(1, wrsrc, wsoff + BSTEP); MOE_DMAA(0, 0);
            asm volatile("s_waitcnt vmcnt(0)" : "+v"(bst[0][0]), "+v"(bst[0][1]), "+v"(bst[0][2]), "+v"(bst[0][3]), "+v"(bst[1][0]), "+v"(bst[1][1]), "+v"(bst[1][2]), "+v"(bst[1][3]) :: "memory");
            MOE_WRITEB(0, 0, 0);
            asm volatile("s_waitcnt lgkmcnt(0)" ::: "memory"); __builtin_amdgcn_s_barrier(); asm volatile("" ::: "memory");
        }
#pragma unroll 1
        for (int t = 0; t < KS; t += 2) {
            const bool nb = (t + 2 >= KS);
            { const u32x4 rs = nb ? wrsrc_n : wrsrc; const unsigned so = nb ? wsoff_n : wsoff + (unsigned)(t + 2) * BSTEP;
              MOE_DMAA(1, t + 1); MOE_LOADB(0, rs, so);
              asm volatile("s_waitcnt vmcnt(%0)" :: "n"(8 + 2 * NMT) : "memory");
              MOE_COMPUTE(0);
              MOE_WAITB(1, 4 + 2 * NMT);
              MOE_WRITEB(1, 1, t + 1);
              asm volatile("s_waitcnt lgkmcnt(0)" ::: "memory"); __builtin_amdgcn_s_barrier(); asm volatile("" ::: "memory"); }
            { const u32x4 rs = nb ? wrsrc_n : wrsrc; const unsigned so = nb ? wsoff_n + BSTEP : wsoff + (unsigned)(t + 3) * BSTEP;
              if (nb) {
                  unsigned vn[6];
#pragma unroll
                  for (int q = 0; q < 6; ++q) vn[q] = (unsigned)stash[q * 64] * (unsigned)(LDA * 2) + ((q & 1) ? kco1 : kco0);
#pragma unroll
                  for (int q = 0; q < 6; ++q) if constexpr (ABL != 2) glds16(Abase_n, vn[q], asb + (unsigned)q * 1024u);
              } else MOE_DMAA(0, t + 2);
              MOE_LOADB(1, rs, so);
              asm volatile("s_waitcnt vmcnt(%0)" :: "n"(8 + 2 * NMT) : "memory");
              MOE_COMPUTE(1);
              MOE_WAITB(0, 4 + 2 * NMT);
              MOE_WRITEB(0, 0, (nb ? 0 : t + 2));
              asm volatile("s_waitcnt lgkmcnt(0)" ::: "memory"); __builtin_amdgcn_s_barrier(); asm volatile("" ::: "memory"); }
        }
        MOE_WAITB(1, 0);
#pragma unroll
        for (int mi = 0; mi < NMT; ++mi) {
            const int prow = (t0 + mi * 8 + w) * 16 + fr;
            if (prow < cnt) {
                bf16_t* op = out + (size_t)(slot0 + prow) * LDO;
                if constexpr (MODE == 1) { const float rs = rstash[mi * 64];
#pragma unroll
                    for (int pp = 0; pp < 2; ++pp) { float r[8];
#pragma unroll
                        for (int n = 0; n < 2; ++n)
#pragma unroll
                            for (int i = 0; i < 4; ++i) { const float g = acc[mi][2 * pp + n][i] * rs, up = acc[mi][4 + 2 * pp + n][i] * rs; r[4 * n + i] = (g * __builtin_amdgcn_rcpf(1.0f + __expf(-g))) * up; }
                        u32x4 o; o.x = cvt_pk_bf16(r[0], r[1]); o.y = cvt_pk_bf16(r[2], r[3]); o.z = cvt_pk_bf16(r[4], r[5]); o.w = cvt_pk_bf16(r[6], r[7]);
                        *(u32x4*)(op + sl * 64 + 32 * pp + 8 * fq) = o; }
                } else {
#pragma unroll
                    for (int pp = 0; pp < 4; ++pp) { u32x4 o; o.x = cvt_pk_bf16(acc[mi][2 * pp][0], acc[mi][2 * pp][1]); o.y = cvt_pk_bf16(acc[mi][2 * pp][2], acc[mi][2 * pp][3]);
                        o.z = cvt_pk_bf16(acc[mi][2 * pp + 1][0], acc[mi][2 * pp + 1][1]); o.w = cvt_pk_bf16(acc[mi][2 * pp + 1][2], acc[mi][2 * pp + 1][3]);
                        *(u32x4*)(op + sl * 128 + 32 * pp + 8 * fq) = o; }
                }
            }
        }
#undef MOE_LOADB
#undef MOE_WAITB
#undef MOE_DMAA
#undef MOE_WRITEB
#undef MOE_COMPUTE
}
template <int MODE, int ABL = 0>
__device__ __forceinline__ void moe_phase(LAS unsigned char* lds, const int* list, const char* Abase, const float* W0, const float* W1, bf16_t* out, int G, int c, const float* gain = nullptr, const float* rsl = nullptr) {
    constexpr int K = (MODE == 2) ? DEXP : D, KS = K / 64, LDA = K, NW = (MODE == 1) ? DEXP : D  , LDO = (MODE == 1) ? DEXP : D;
    constexpr int BS_OFF = 0, AS_OFF = 32768, AW = 6144;
    const int tid = fresh_tid(), lane = tid & 63, w = __builtin_amdgcn_readfirstlane(tid >> 6), fr = lane & 15, fq = lane >> 4;
    const LAS int* tbl = (const LAS int*)(lds + TBL_OFF);
    const unsigned ldsb = (unsigned)__builtin_amdgcn_readfirstlane((int)(unsigned)(__UINTPTR_TYPE__)lds);
    const unsigned asb = ldsb + AS_OFF + (unsigned)w * AW;
    const int NU = (MODE == 3) ? 64 : __builtin_amdgcn_readfirstlane(tbl[MOE_PT_OFF + 32]) * 16;
    const int bL = lane & 15, bn = 32 * (2 * (w & 1) + (bL >> 3)) + 16 * (bL & 1) + 4 * ((bL & 7) >> 1), bk0 = 16 * (w >> 1), bk4 = lane >> 4;
    const int bkc = 2 * (w >> 1) + (bk4 >> 1);
    const int bwoff = bn * 128 + 8 * (bk4 & 1), bsw = bkc ^ ((bn >> 1) & 7);
    const int sw0 = (fq ^ ((fr >> 1) & 7)) * 16, sw1 = sw0 ^ 64;
    const LAS unsigned char* pa0 = lds + AS_OFF + w * AW + fr * 128 + sw0; const LAS unsigned char* pa1 = lds + AS_OFF + w * AW + fr * 128 + sw1;
    const LAS unsigned char* pb0 = lds + BS_OFF + fr * 128 + sw0; const LAS unsigned char* pb1 = lds + BS_OFF + fr * 128 + sw1;
    auto desc = [&](int ui) -> MoeDesc {
        MoeDesc d; d.valid = 0; d.e = 0; d.sl = 0; d.t0 = 0; d.nt = 0; d.cnt = 1; d.slot0 = 0; d.Ab = Abase; d.out = out; d.W0 = W0; d.W1 = W1;
        if constexpr (MODE == 3) {
            const int j = ((c + G - (G >> 1)) % G) + ui * G;
            if (j < NU) { const int l = j >> 5, kv = (j >> 4) & 1; d.sl = j & 15; d.cnt = NMEM; d.nt = NMEM / 16;
                d.Ab = Abase + (size_t)l * NMEM * D * 2; d.out = out + (size_t)(kv * 2 + l) * NMEM * D; d.W0 = (kv ? W1 : W0) + (size_t)l * D * D; d.valid = 1; }
        } else {
            const long L = (long)ui * G + c;
            if (L < NU) {
                int wg = (int)L; { const int q = NU / 8, r = NU % 8, xcd = wg % 8, off = wg / 8; wg = (xcd < r ? xcd * (q + 1) : r * (q + 1) + (xcd - r) * q) + off; }
                d.sl = wg & 15;
                const int pk = __builtin_amdgcn_readfirstlane(tbl[MOE_PARTS + (wg >> 4)]); const int e = pk & 31;
                d.e = e; d.t0 = (pk >> 5) & 1023; d.nt = pk >> 15;
                d.cnt = __builtin_amdgcn_readfirstlane(tbl[33 + e]);
                d.slot0 = __builtin_amdgcn_readfirstlane(tbl[e]) * 256;
                d.valid = 1;
            }
        }
        return d;
    };
    constexpr int STASH_OFF = AS_OFF + 2 * 8 * AW;
    LAS int* stash = (LAS int*)(lds + STASH_OFF + w * 1536) + lane;
    const unsigned stash_b = ldsb + STASH_OFF + (unsigned)w * 1536u;
    const unsigned kco0 = (unsigned)(((lane & 7) ^ (lane >> 4)) * 16), kco1 = (unsigned)(((lane & 7) ^ (4 + (lane >> 4))) * 16);
    auto fill = [&](const MoeDesc& d) {
#pragma unroll
        for (int q = 0; q < 6; ++q) { int idx = (d.t0 + (q >> 1) * 8 + w) * 16 + (q & 1) * 8 + (lane >> 3); idx = idx < d.cnt ? idx : 0;
            if constexpr (MODE == 1) glds4((const char*)list, (unsigned)(d.e * LISTCAP + idx) * 4u, stash_b + (unsigned)q * 256u);
            else stash[q * 64] = d.slot0 + idx; }
    };
    constexpr int GT_OFF = STASH_OFF + 8 * 1536, RS_OFF = GT_OFF + 8192;
    LAS float* gt = (LAS float*)(lds + GT_OFF);
    const LAS float* gtab = gt + bk0 + 4 * bk4;
    const LAS float* rstash = (const LAS float*)(lds + RS_OFF + w * 768) + lane;
    const unsigned rs_b = ldsb + RS_OFF + (unsigned)w * 768u;
    if constexpr (MODE == 1) { *(LAS f32x4*)(gt + 4 * tid) = *(const f32x4*)(gain + 4 * tid); }
    auto fill_rs = [&](const MoeDesc& d) {
        if constexpr (MODE == 1) {
#pragma unroll
            for (int mi = 0; mi < 3; ++mi) { int idx = (d.t0 + mi * 8 + w) * 16 + (lane & 15); idx = idx < d.cnt ? idx : 0;
                glds4((const char*)rsl, (unsigned)(d.e * LISTCAP + idx) * 4u, rs_b + (unsigned)mi * 256u); }
        }
    };
    MoeDesc cur = desc(0);
    if (cur.valid) {
    fill(cur);
    bool pre = false; u32x4 bst[2][4];
#pragma unroll 1
    for (int ui = 0;; ++ui) {
        const MoeDesc nxt = desc(ui + 1);
        if (MODE == 1 && !pre) asm volatile("s_waitcnt vmcnt(0)" ::: "memory");
        unsigned voff[6];
#pragma unroll
        for (int q = 0; q < 6; ++q) voff[q] = (unsigned)stash[q * 64] * (unsigned)(LDA * 2) + ((q & 1) ? kco1 : kco0);
        asm volatile("s_waitcnt lgkmcnt(0)" ::: "memory");
        if (nxt.valid) fill(nxt);
        fill_rs(cur);
        const int nt = cur.nt, nmt = (nt > 16 + w) ? 3 : (nt > 8 + w) ? 2 : (nt > w) ? 1 : 0;
        const MoeDesc& dn = nxt.valid ? nxt : cur;
        const float* wmat = ((MODE == 1 && (w & 1)) ? cur.W1 : cur.W0) + (size_t)cur.e * K * NW;
        const float* wmat_n = ((MODE == 1 && (w & 1)) ? dn.W1 : dn.W0) + (size_t)dn.e * K * NW;
        const unsigned long long wa = (unsigned long long)wmat, wan = (unsigned long long)wmat_n;
        const u32x4 wrsrc = {(unsigned)__builtin_amdgcn_readfirstlane((int)(unsigned)wa), (unsigned)__builtin_amdgcn_readfirstlane((int)(unsigned)(wa >> 32)) & 0xffffu, (unsigned)(K * NW * 4), 0x00020000u};
        const u32x4 wrsrc_n = {(unsigned)__builtin_amdgcn_readfirstlane((int)(unsigned)wan), (unsigned)__builtin_amdgcn_readfirstlane((int)(unsigned)(wan >> 32)) & 0xffffu, (unsigned)(K * NW * 4), 0x00020000u};
        const unsigned wsoff = (unsigned)__builtin_amdgcn_readfirstlane((bk0 * NW + ((MODE == 1) ? cur.sl * 64 : cur.sl * 128 + 64 * (w & 1))) * 4);
        const unsigned wsoff_n = (unsigned)__builtin_amdgcn_readfirstlane((bk0 * NW + ((MODE == 1) ? dn.sl * 64 : dn.sl * 128 + 64 * (w & 1))) * 4);
        const int bvoff = (4 * bk4 * NW + 4 * (lane & 15)) * 4;
#define MOE_CALL(N) moe_unit<MODE, N, ABL>(lds, cur.Ab, wrsrc, wsoff, bvoff, voff, asb, cur.out, w, fr, fq, bwoff, bsw, pa0, pa1, pb0, pb1, cur.t0, cur.cnt, cur.slot0, cur.sl, pre, bst, wrsrc_n, wsoff_n, dn.Ab, stash, kco0, kco1, gtab, rstash)
        if constexpr (MODE == 3) MOE_CALL(2);
        else if (nmt == 3) MOE_CALL(3);
        else if (nmt == 2) MOE_CALL(2);
        else MOE_CALL(1);
#undef MOE_CALL
        if (!nxt.valid) break;
        cur = nxt; pre = true;
    }
    asm volatile("s_waitcnt vmcnt(0)" ::: "memory");
    }
}

#ifndef MK_PER_PHASE
#define MK_PER_PHASE 0
#endif
#ifndef NEWMOE
#define NEWMOE 3
#endif
#ifndef PHMASK
#define PHMASK 0x3fff
#endif
#define PH(n) (((PHMASK) >> (n)) & 1)
#ifndef REPMASK
#define REPMASK 0
#endif
#define NREP(n) ((((REPMASK) >> (n)) & 1) ? 2 : 1)
#ifndef SUBMASK
#define SUBMASK 0xff
#endif
#define SUB(n) (((SUBMASK) >> (n)) & 1)
constexpr int NPH = 27;
struct Args { const float* in[27]; float* out; unsigned char* ws; int ph_lo, ph_hi, fused, pad; };

__global__ void __launch_bounds__(NTHR, 2) mk_fwd(Args args) {
    extern __shared__ __attribute__((aligned(16))) unsigned char lds_raw[];
    LAS unsigned char* lds0 = (LAS unsigned char*)lds_raw;
    const int tid = threadIdx.x, lane = tid & 63, wave = __builtin_amdgcn_readfirstlane(tid >> 6);
    unsigned* const ctl = (unsigned*)(args.ws + WS_CTL);
    for (int u = tid; u < (LDS_BYTES - MISC_OFF) / 4; u += NTHR) ((LAS unsigned*)(lds0 + MISC_OFF))[u] = 0u;
    __syncthreads();
    XcdBarrier bar; bar.bar = ctl + CW_BAR; bar.x = 0; bar.st = nullptr;
    if (args.fused) bar = xcd_barrier_post(ctl + CW_BAR, (volatile LAS unsigned*)(lds0 + MISC_OFF));
    const int lo = args.ph_lo;
#define IN(k) (args.fused || lo == (k))
#ifdef SEAM2X
#define SEAM() do { if (args.fused) { XcdBarrier b2 = bar; asm volatile("" : "+s"(b2.bar), "+s"(b2.x)); xcd_barrier(b2); xcd_barrier(b2); xcd_barrier(b2); } } while (0)
#else
#define SEAM() do { if (args.fused) { XcdBarrier b2 = bar; asm volatile("" : "+s"(b2.bar), "+s"(b2.x)); xcd_barrier(b2); } } while (0)
#endif

#define CAS __attribute__((address_space(4)))
#define KARG() ({ const CAS char* _k = (const CAS char*)__builtin_amdgcn_kernarg_segment_ptr(); asm volatile("" : "+s"(_k)); _k; })
#define INP(k) (*(const float* const CAS*)(ka + 8 * (k)))
#define hbuf (*(float* const CAS*)(ka + 216))
#define DEF_W LAS unsigned char* lds = lds0; asm volatile("" : "+s"(lds)); const LAS int* tbl = (const LAS int*)(lds + TBL_OFF); const int bx = fresh_bx(), G = fresh_s((int)gridDim.x); const CAS char* ka = KARG(); unsigned char* ws = *(unsigned char* const CAS*)(ka + 224);
#define W_EVIN ((bf16_t*)(ws + WS_WEVIN))
#define W_EVOUT ((bf16_t*)(ws + WS_WEVOUT))
#define W_ODIN ((bf16_t*)(ws + WS_WODIN))
#define W_ODOUT ((bf16_t*)(ws + WS_WODOUT))
#define W_XQ ((bf16_t*)(ws + WS_WXQ))
#define W_XK ((bf16_t*)(ws + WS_WXK))
#define W_XV ((bf16_t*)(ws + WS_WXV))
#define W_XO ((bf16_t*)(ws + WS_WXO))
#define W_POOL ((bf16_t*)(ws + WS_WPOOL))
#define MEMN ((bf16_t*)(ws + WS_MEMN))
#define KX ((bf16_t*)(ws + WS_KX))
#define VX ((bf16_t*)(ws + WS_VX))
#define GATES ((float*)(ws + WS_SMALL + SM_GATES))
#define BCUM ((float*)(ws + WS_SMALL + SM_BCUM))
#define GI ((float*)(ws + WS_SMALL + SM_GI))
#define MARR ((float*)(ws + WS_SMALL + SM_MARR))
#define APREV ((float*)(ws + WS_SMALL + SM_APREV))
#define BLG ((float*)(ws + WS_SMALL + SM_BL))
#define KN ((float*)(ws + WS_SMALL + SM_KN))
#define NST ((float*)(ws + WS_SMALL + SM_NST))
#define HN ((bf16_t*)(ws + WS_HN))
#define Z ((bf16_t*)(ws + WS_Z))
#define YCAT ((bf16_t*)(ws + WS_YCAT))
#define DPOOL ((bf16_t*)(ws + WS_DPOOL))
#define KC ((float*)(ws + WS_KC))
#define CST ((bf16_t*)(ws + WS_CST))
#define QX ((bf16_t*)(ws + WS_QX))
#define OATT ((bf16_t*)(ws + WS_OATT))
#define HID ((bf16_t*)(ws + WS_HID))
#define H16 ((bf16_t*)(ws + WS_H16))
#define WRT ((bf16_t*)(ws + WS_WEXP))
#define YB ((bf16_t*)(ws + WS_YB))
#define LIST ((int*)(ws + WS_LIST + (size_t)layer * MiB))
#define RSTD1 ((float*)(ws + WS_WEXP + (size_t)10 * MiB))
#define RSL ((float*)(ws + WS_WEXP + (size_t)(8 + layer) * MiB))
#define TOKINFO ((int*)(ws + WS_TOKINFO + (size_t)layer * 256 * 1024))
#define WG ((const bf16_t*)(ws + WS_WEXP + (size_t)layer * WEXP_LAYER))
#define WU (WG + WEXP_MAT / 2)
#define WD (WG + WEXP_MAT)
#define x_in INP(0)
#define mem_in INP(1)
#define mix_norm INP(2)
#define xattn_norm INP(3)
#define mem_norm INP(4)
#define ffn_norm INP(5)
#define final_norm INP(6)
#define ev_w_in INP(7)
#define ev_b_gates INP(8)
#define ev_pool_w INP(9)
#define ev_pool_scale INP(10)
#define ev_head_norm INP(11)
#define ev_w_out INP(12)
#define od_w_in INP(13)
#define od_conv_w INP(14)
#define od_w_out INP(15)
#define xa_wq INP(16)
#define xa_wk INP(17)
#define xa_wv INP(18)
#define xa_wo INP(19)
#define rt_group_w INP(20)
#define rt_group_b INP(21)
#define rt_expert_w INP(22)
#define rt_expert_b INP(23)
#define ex_w_gate INP(24)
#define ex_w_up INP(25)
#define ex_w_down INP(26)

    constexpr int I_EVIN = (D / 64) * (EVN / 64), I_SQ = (D / 64) * (D / 64), I_ODIN = (D / 64) * (ODN / 64), I_POOL = 4 * 4 * 4;
    constexpr int NP_ITEMS = I_EVIN + I_POOL, NITEMS = NP_ITEMS + I_ODIN + 6 * I_SQ;
#define TRANSPOSE_ITEMS(first, stride, lo, hi) \
        for (int it = (lo) + (first); it < (hi); it += (stride)) { \
            int r = it; const float* src; int ldw, K, N; bf16_t* dst; const float* gain = nullptr; \
            if (r < I_EVIN) { src = ev_w_in; ldw = EVW; K = D; N = EVN; dst = W_EVIN; } \
            else if ((r -= I_EVIN) < I_POOL) { const int m = r / 16; r -= m * 16; src = ev_pool_w + (size_t)m * 65536; ldw = 256; K = 256; N = 256; dst = W_POOL + (size_t)m * 65536; } \
            else if ((r -= I_POOL) < I_SQ) { src = ev_w_out; ldw = D; K = D; N = D; dst = W_EVOUT; } \
            else if ((r -= I_SQ) < I_SQ) { src = xa_wq; ldw = D; K = D; N = D; dst = W_XQ; gain = xattn_norm; } \
            else if ((r -= I_SQ) < I_SQ) { src = xa_wo; ldw = D; K = D; N = D; dst = W_XO; } \
            else if ((r -= I_SQ) < I_ODIN) { src = od_w_in; ldw = ODN; K = D; N = ODN; dst = W_ODIN; gain = mix_norm + D; } \
            else if ((r -= I_ODIN) < I_SQ) { src = od_w_out; ldw = D; K = D; N = D; dst = W_ODOUT; } \
            else if ((r -= I_SQ) < I_SQ) { src = xa_wq + (size_t)D * D; ldw = D; K = D; N = D; dst = W_XQ + (size_t)D * D; gain = xattn_norm + D; } \
            else { r -= I_SQ; src = xa_wo + (size_t)D * D; ldw = D; K = D; N = D; dst = W_XO + (size_t)D * D; } \
            const int nbn = N / 64; \
            transpose_item64(src, ldw, K, dst, r / nbn, r % nbn, scr, lane, gain); }

    if (PH(13) && IN(0)) { DEF_W
        LAS float* scr = (LAS float*)(lds + wave * 16640);
        const int gw = bx * NWAVES + wave, NGW = G * NWAVES;
        for (int rep = 0; rep < NREP(13); ++rep) { TRANSPOSE_ITEMS(gw, NGW, 0, NP_ITEMS) }
        for (int r = gw; r < 2 * NMEM; r += NGW) { const int l = r >> 8, row = r & 255; const float* s = mem_in + (size_t)row * D; const float* g = mem_norm + (size_t)l * D;
            f32x4 v[8]; float ss = 0.f;
#pragma unroll
            for (int j = 0; j < 8; ++j) { v[j] = *(const f32x4*)(s + 4 * lane + 256 * j); ss += (v[j][0] * v[j][0] + v[j][1] * v[j][1]) + (v[j][2] * v[j][2] + v[j][3] * v[j][3]); }
            const float rs = rsqrtf(wave_sum(ss) * (1.0f / D) + EPS);
#pragma unroll
            for (int j = 0; j < 8; ++j) { const f32x4 gg = *(const f32x4*)(g + 4 * lane + 256 * j); const f32x4 y = v[j] * rs * gg; u32x2 w; w.x = cvt_pk_bf16(y[0], y[1]); w.y = cvt_pk_bf16(y[2], y[3]);
                *(u32x2*)(MEMN + (size_t)l * NMEM * D + (size_t)row * D + 4 * lane + 256 * j) = w; } }
        for (int idx = bx * NTHR + tid; idx < 2 * 48 * D; idx += G * NTHR) { const int l = idx / (48 * D), n = (idx / D) % 48, k = idx % D;
            float wv = 0.f;
            if (n < 32) wv = rt_expert_w[((size_t)l * D + k) * NEXP + n]; else if (n < 36) wv = rt_group_w[((size_t)l * D + k) * 4 + (n - 32)];
            wv *= ffn_norm[(size_t)l * D + k];
            const unsigned hi = cvt_pk_bf16(wv, 0.f) & 0xffffu; const float rem = wv - bf2f((unsigned short)hi); const unsigned lo = cvt_pk_bf16(rem, 0.f) & 0xffffu;
            WRT[((size_t)l * 2 + 0) * 48 * D + (size_t)n * D + k] = (bf16_t)hi; WRT[((size_t)l * 2 + 1) * 48 * D + (size_t)n * D + k] = (bf16_t)lo; }
        __syncthreads();
        RowArgs ra{}; ra.hin = x_in; ra.gain = mix_norm; ra.hn = HN; ra.wgate = ev_w_in; ra.bgate = ev_b_gates; ra.gates = GATES;
        row_phase<RM_GATES, false>(lds, ra, G);
        SEAM();
    }

    { constexpr int layer = 0;
        const int pb = 1 + 13 * layer;
#define cnt_p ((unsigned*)(ws + WS_CTL) + CW_CNT + layer * 32 * 64)
        if (PH(0) && IN(pb + 0)) { DEF_W
            for (int rep = 0; rep < NREP(0); ++rep) {
            if (layer == 0) {
                if (SUB(4)) for (int h = bx; h < NH; h += G) mlstm_prep(lds, h, GATES, BCUM, GI, MARR, APREV, BLG);
                if (SUB(0)) { pg8::DenseSched S{(const char*)HN, (size_t)256 * D * 2, 0, (const char*)W_EVIN, (const char*)W_EVIN + (size_t)128 * D * 2, (size_t)256 * D * 2, (char*)Z, EVN, T / 256, EVN / 256, G, bx};
                  pg8::EpiBf16 E{}; pg8::gemm_phase<pg8::EpiBf16, pg8::DenseSched, true>(lds, D, D, D, S, E); }
                if (SUB(1)) moe_phase<3>(lds, nullptr, (const char*)MEMN, xa_wk, xa_wv, KX, G, bx);
                if (SUB(1) && bx >= (G >> 1)) {
                    __syncthreads();
                    const int tid_ = fresh_tid(), lane = tid_ & 63, wave = __builtin_amdgcn_readfirstlane(tid_ >> 6);
                    LAS float* scr = (LAS float*)(lds + wave * 16640);
                    const int b = bx - (G >> 1), nbu = G - (G >> 1), nkv = nbu < 64 ? nbu : 64, WA = nkv * NWAVES, WB = (nbu - nkv) * NWAVES;
                    const int NL = NITEMS - NP_ITEMS, NA = (int)((long)NL * WA / (WA + 5 * WB));
                    if (b < nkv) { TRANSPOSE_ITEMS(b * NWAVES + wave, WA, NP_ITEMS, NP_ITEMS + NA) }
                    else { TRANSPOSE_ITEMS((b - nkv) * NWAVES + wave, WB, NP_ITEMS + NA, NITEMS) }
                }
            } else {
                if (SUB(2)) { pg8::DenseSched S{(const char*)H16, (size_t)256 * D * 2, 0, (const char*)W_ODIN, (const char*)W_ODIN + (size_t)128 * D * 2, (size_t)256 * D * 2, (char*)Z, D, T / 256, D / 256, G, bx};
                  pg8::EpiBf16Rs E{RSTD1}; pg8::gemm_phase<pg8::EpiBf16Rs, pg8::DenseSched, true>(lds, D, D, D, S, E); }
                if (SUB(3)) { pg8::DenseSched S{(const char*)H16, (size_t)256 * D * 2, 0, (const char*)W_ODIN + (size_t)2048 * D * 2, (const char*)W_ODIN + (size_t)4096 * D * 2, (size_t)128 * D * 2, (char*)(Z + (size_t)T * D), D, T / 256, D / 128, G, bx};
                  pg8::EpiPairRs E{RSTD1}; pg8::gemm_phase<pg8::EpiPairRs, pg8::DenseSched, true>(lds, D, D, D, S, E); }
            }
            }
            SEAM();
        }
        if (PH(1) && IN(pb + 1)) { DEF_W
            for (int rep = 0; rep < NREP(1); ++rep) {
            if (layer == 0) {
                for (int u = bx; u < NCH * NH; u += G) mlstm_B(lds, u >> 2, u & 3, Z, GI, MARR, BLG, KC, KN);
                pool_diffs(Z, DPOOL, G);
            } else conv_gate(Z, Z + (size_t)T * D, od_conv_w, YCAT, G);
            }
            SEAM();
        }
        if (PH(2) && layer == 0 && IN(pb + 2)) { DEF_W
            for (int rep = 0; rep < NREP(2); ++rep) {
            if (SUB(5)) mlstm_scan(KC, KN, APREV, CST, NST, G);
            if (SUB(6)) { pg8::DenseSched S{(const char*)DPOOL, (size_t)256 * 1024 * 2, (size_t)256 * 2, (const char*)W_POOL, (const char*)W_POOL + (size_t)128 * 256 * 2, (size_t)256 * 256 * 2, (char*)YCAT, D, T / 256, 4, G, bx};
              pg8::EpiBf16Scale E{ev_pool_scale}; pg8::gemm_phase<pg8::EpiBf16Scale, pg8::DenseSched, true>(lds, 256, 1024, 256, S, E); }
            }
            SEAM();
        }
        if (PH(3) && layer == 0 && IN(pb + 3)) { DEF_W
            for (int rep = 0; rep < NREP(3); ++rep) {
            for (int u = bx; u < NCH * NH; u += G) mlstm_D(lds, u >> 2, u & 3, Z, GI, BCUM, MARR, CST, NST, ev_head_norm, YCAT);
            }
            SEAM();
        }
        if (PH(4) && IN(pb + 4)) { DEF_W
            pg8::DenseSched S{(const char*)YCAT, (size_t)256 * D * 2, 0, (const char*)(layer == 0 ? W_EVOUT : W_ODOUT), (const char*)(layer == 0 ? W_EVOUT : W_ODOUT) + (size_t)128 * D * 2, (size_t)256 * D * 2, (char*)H16, D, T / 256, D / 256, G, bx};
            float* ssq = (float*)(ws + WS_SMALL + SM_SSQP) + (size_t)layer * T * 32;
            if (layer == 0) { pg8::EpiResSsq<false> E{(const void*)x_in, ssq}; pg8::gemm_phase<pg8::EpiResSsq<false>, pg8::DenseSched, true>(lds, D, D, D, S, E); }
            else { pg8::EpiResSsq<true> E{(const void*)H16, ssq}; pg8::gemm_phase<pg8::EpiResSsq<true>, pg8::DenseSched, true>(lds, D, D, D, S, E); }
            SEAM();
        }
        if (PH(6) && IN(pb + 6)) { DEF_W
            for (int rep = 0; rep < NREP(6); ++rep) {
            const bf16_t* W = W_XQ + (size_t)layer * D * D;
            pg8::DenseSched S{(const char*)H16, (size_t)256 * D * 2, 0, (const char*)W, (const char*)W + (size_t)128 * D * 2, (size_t)256 * D * 2, (char*)QX, D, T / 256, D / 256, G, bx};
            pg8::EpiBf16RowScale E{(const float*)(ws + WS_SMALL + SM_SSQP) + (size_t)layer * T * 32, 1.0f / D, EPS}; pg8::gemm_phase<pg8::EpiBf16RowScale, pg8::DenseSched, true>(lds, D, D, D, S, E);
            }
            SEAM();
        }
        if (PH(7) && IN(pb + 7)) { DEF_W
            for (int rep = 0; rep < NREP(7); ++rep) {
            for (int u = bx; u < XH * (T / 128); u += G) xattn_unit(lds, u & 3, u >> 2, QX, KX + (size_t)layer * NMEM * D, VX + (size_t)layer * NMEM * D, OATT);
            }
            SEAM();
        }
        if (PH(8) && IN(pb + 8)) { DEF_W
            const bf16_t* W = W_XO + (size_t)layer * D * D;
            pg8::DenseSched S{(const char*)OATT, (size_t)256 * D * 2, 0, (const char*)W, (const char*)W + (size_t)128 * D * 2, (size_t)256 * D * 2, (char*)H16, D, T / 256, D / 256, G, bx};
            pg8::EpiResSsq<true> E{(const void*)H16, nullptr}; pg8::gemm_phase<pg8::EpiResSsq<true>, pg8::DenseSched, true>(lds, D, D, D, S, E);
            SEAM();
        }
        if (PH(9) && IN(pb + 9)) { DEF_W
            RowArgs ra{}; ra.hin16 = H16; ra.gain = ffn_norm + (size_t)layer * D; ra.hn = HN;
            ra.rgw = rt_group_w + (size_t)layer * D * 4; ra.rgb = rt_group_b + layer * 4; ra.rew = rt_expert_w + (size_t)layer * D * NEXP; ra.reb = rt_expert_b + layer * NEXP;
            ra.cnt = cnt_p; ra.list = LIST; ra.tokinfo = TOKINFO; ra.wr = WRT + (size_t)layer * 2 * 48 * D; ra.rsl = RSL;
            row_phase<RM_ROUTE, false, true, false>(lds, ra, G);
            SEAM();
        }
        if (PH(10) && IN(pb + 10)) { DEF_W
            moe_tables(lds, cnt_p);
#if (NEWMOE & 1)
            moe_phase<1>(lds, LIST, (const char*)H16, ex_w_gate + (size_t)layer * NEXP * D * DEXP, ex_w_up + (size_t)layer * NEXP * D * DEXP, HID, G, bx, ffn_norm + (size_t)layer * D, RSL);
#ifdef MOE_ABLV
            if (NREP(10) > 1) moe_phase<1, MOE_ABLV>(lds, LIST, (const char*)H16, ex_w_gate + (size_t)layer * NEXP * D * DEXP, ex_w_up + (size_t)layer * NEXP * D * DEXP, YB, G, bx, ffn_norm + (size_t)layer * D, RSL);
#else
            if (NREP(10) > 1) moe_phase<1>(lds, LIST, (const char*)H16, ex_w_gate + (size_t)layer * NEXP * D * DEXP, ex_w_up + (size_t)layer * NEXP * D * DEXP, YB, G, bx, ffn_norm + (size_t)layer * D, RSL);
#endif
#else
            Moe1Sched S{tbl, LIST, (const char*)HN, (const char*)WG, (const char*)WU, (char*)HID, G, bx};
            pg8::EpiPair<true> E{}; for (int rep = 0; rep < NREP(10); ++rep) pg8::gemm_phase<pg8::EpiPair<true>, Moe1Sched, true>(lds, D, D, D, S, E);
#endif
            SEAM();
        }
        if (PH(11) && IN(pb + 11)) { DEF_W
            if (!args.fused) moe_tables(lds, cnt_p);
#if (NEWMOE & 2)
            moe_phase<2>(lds, nullptr, (const char*)HID, ex_w_down + (size_t)layer * NEXP * D * DEXP, nullptr, YB, G, bx);
#ifdef MOE_ABLV
            if (NREP(11) > 1) moe_phase<2, MOE_ABLV>(lds, nullptr, (const char*)HID, ex_w_down + (size_t)layer * NEXP * D * DEXP, nullptr, Z, G, bx);
#else
            if (NREP(11) > 1) moe_phase<2>(lds, nullptr, (const char*)HID, ex_w_down + (size_t)layer * NEXP * D * DEXP, nullptr, Z, G, bx);
#endif
#else
            Moe2Sched S{tbl, (const char*)HID, (const char*)WD, (char*)YB, G, bx};
            pg8::EpiBf16 E{}; for (int rep = 0; rep < NREP(11); ++rep) pg8::gemm_phase<pg8::EpiBf16, Moe2Sched, true>(lds, DEXP, DEXP, DEXP, S, E);
#endif
            SEAM();
        }
        if (PH(12) && IN(pb + 12)) { DEF_W
            if (!args.fused) moe_tables(lds, cnt_p);
            if (layer == 0) { combine_phase<false>(lds, H16, YB, TOKINFO, nullptr, RSTD1, nullptr, G); SEAM(); }
            else combine_phase<true>(lds, H16, YB, TOKINFO, final_norm, nullptr, hbuf, G);
        }
    }
    { constexpr int layer = 1;
        const int pb = 1 + 13 * layer;
#define cnt_p ((unsigned*)(ws + WS_CTL) + CW_CNT + layer * 32 * 64)
        if (PH(0) && IN(pb + 0)) { DEF_W
            for (int rep = 0; rep < NREP(0); ++rep) {
            if (layer == 0) {
                if (SUB(4)) for (int h = bx; h < NH; h += G) mlstm_prep(lds, h, GATES, BCUM, GI, MARR, APREV, BLG);
                if (SUB(0)) { pg8::DenseSched S{(const char*)HN, (size_t)256 * D * 2, 0, (const char*)W_EVIN, (const char*)W_EVIN + (size_t)128 * D * 2, (size_t)256 * D * 2, (char*)Z, EVN, T / 256, EVN / 256, G, bx};
                  pg8::EpiBf16 E{}; pg8::gemm_phase<pg8::EpiBf16, pg8::DenseSched, true>(lds, D, D, D, S, E); }
                if (SUB(1)) moe_phase<3>(lds, nullptr, (const char*)MEMN, xa_wk, xa_wv, KX, G, bx);
                if (SUB(1) && bx >= (G >> 1)) {
                    __syncthreads();
                    const int tid_ = fresh_tid(), lane = tid_ & 63, wave = __builtin_amdgcn_readfirstlane(tid_ >> 6);
                    LAS float* scr = (LAS float*)(lds + wave * 16640);
                    const int b = bx - (G >> 1), nbu = G - (G >> 1), nkv = nbu < 64 ? nbu : 64, WA = nkv * NWAVES, WB = (nbu - nkv) * NWAVES;
                    const int NL = NITEMS - NP_ITEMS, NA = (int)((long)NL * WA / (WA + 5 * WB));
                    if (b < nkv) { TRANSPOSE_ITEMS(b * NWAVES + wave, WA, NP_ITEMS, NP_ITEMS + NA) }
                    else { TRANSPOSE_ITEMS((b - nkv) * NWAVES + wave, WB, NP_ITEMS + NA, NITEMS) }
                }
            } else {
                if (SUB(2)) { pg8::DenseSched S{(const char*)H16, (size_t)256 * D * 2, 0, (const char*)W_ODIN, (const char*)W_ODIN + (size_t)128 * D * 2, (size_t)256 * D * 2, (char*)Z, D, T / 256, D / 256, G, bx};
                  pg8::EpiBf16Rs E{RSTD1}; pg8::gemm_phase<pg8::EpiBf16Rs, pg8::DenseSched, true>(lds, D, D, D, S, E); }
                if (SUB(3)) { pg8::DenseSched S{(const char*)H16, (size_t)256 * D * 2, 0, (const char*)W_ODIN + (size_t)2048 * D * 2, (const char*)W_ODIN + (size_t)4096 * D * 2, (size_t)128 * D * 2, (char*)(Z + (size_t)T * D), D, T / 256, D / 128, G, bx};
                  pg8::EpiPairRs E{RSTD1}; pg8::gemm_phase<pg8::EpiPairRs, pg8::DenseSched, true>(lds, D, D, D, S, E); }
            }
            }
            SEAM();
        }
        if (PH(1) && IN(pb + 1)) { DEF_W
            for (int rep = 0; rep < NREP(1); ++rep) {
            if (layer == 0) {
                for (int u = bx; u < NCH * NH; u += G) mlstm_B(lds, u >> 2, u & 3, Z, GI, MARR, BLG, KC, KN);
                pool_diffs(Z, DPOOL, G);
            } else conv_gate(Z, Z + (size_t)T * D, od_conv_w, YCAT, G);
            }
            SEAM();
        }
        if (PH(2) && layer == 0 && IN(pb + 2)) { DEF_W
            for (int rep = 0; rep < NREP(2); ++rep) {
            if (SUB(5)) mlstm_scan(KC, KN, APREV, CST, NST, G);
            if (SUB(6)) { pg8::DenseSched S{(const char*)DPOOL, (size_t)256 * 1024 * 2, (size_t)256 * 2, (const char*)W_POOL, (const char*)W_POOL + (size_t)128 * 256 * 2, (size_t)256 * 256 * 2, (char*)YCAT, D, T / 256, 4, G, bx};
              pg8::EpiBf16Scale E{ev_pool_scale}; pg8::gemm_phase<pg8::EpiBf16Scale, pg8::DenseSched, true>(lds, 256, 1024, 256, S, E); }
            }
            SEAM();
        }
        if (PH(3) && layer == 0 && IN(pb + 3)) { DEF_W
            for (int rep = 0; rep < NREP(3); ++rep) {
            for (int u = bx; u < NCH * NH; u += G) mlstm_D(lds, u >> 2, u & 3, Z, GI, BCUM, MARR, CST, NST, ev_head_norm, YCAT);
            }
            SEAM();
        }
        if (PH(4) && IN(pb + 4)) { DEF_W
            pg8::DenseSched S{(const char*)YCAT, (size_t)256 * D * 2, 0, (const char*)(layer == 0 ? W_EVOUT : W_ODOUT), (const char*)(layer == 0 ? W_EVOUT : W_ODOUT) + (size_t)128 * D * 2, (size_t)256 * D * 2, (char*)H16, D, T / 256, D / 256, G, bx};
            float* ssq = (float*)(ws + WS_SMALL + SM_SSQP) + (size_t)layer * T * 32;
            if (layer == 0) { pg8::EpiResSsq<false> E{(const void*)x_in, ssq}; pg8::gemm_phase<pg8::EpiResSsq<false>, pg8::DenseSched, true>(lds, D, D, D, S, E); }
            else { pg8::EpiResSsq<true> E{(const void*)H16, ssq}; pg8::gemm_phase<pg8::EpiResSsq<true>, pg8::DenseSched, true>(lds, D, D, D, S, E); }
            SEAM();
        }
        if (PH(6) && IN(pb + 6)) { DEF_W
            for (int rep = 0; rep < NREP(6); ++rep) {
            const bf16_t* W = W_XQ + (size_t)layer * D * D;
            pg8::DenseSched S{(const char*)H16, (size_t)256 * D * 2, 0, (const char*)W, (const char*)W + (size_t)128 * D * 2, (size_t)256 * D * 2, (char*)QX, D, T / 256, D / 256, G, bx};
            pg8::EpiBf16RowScale E{(const float*)(ws + WS_SMALL + SM_SSQP) + (size_t)layer * T * 32, 1.0f / D, EPS}; pg8::gemm_phase<pg8::EpiBf16RowScale, pg8::DenseSched, true>(lds, D, D, D, S, E);
            }
            SEAM();
        }
        if (PH(7) && IN(pb + 7)) { DEF_W
            for (int rep = 0; rep < NREP(7); ++rep) {
            for (int u = bx; u < XH * (T / 128); u += G) xattn_unit(lds, u & 3, u >> 2, QX, KX + (size_t)layer * NMEM * D, VX + (size_t)layer * NMEM * D, OATT);
            }
            SEAM();
        }
        if (PH(8) && IN(pb + 8)) { DEF_W
            const bf16_t* W = W_XO + (size_t)layer * D * D;
            pg8::DenseSched S{(const char*)OATT, (size_t)256 * D * 2, 0, (const char*)W, (const char*)W + (size_t)128 * D * 2, (size_t)256 * D * 2, (char*)H16, D, T / 256, D / 256, G, bx};
            pg8::EpiResSsq<true> E{(const void*)H16, nullptr}; pg8::gemm_phase<pg8::EpiResSsq<true>, pg8::DenseSched, true>(lds, D, D, D, S, E);
            SEAM();
        }
        if (PH(9) && IN(pb + 9)) { DEF_W
            RowArgs ra{}; ra.hin16 = H16; ra.gain = ffn_norm + (size_t)layer * D; ra.hn = HN;
            ra.rgw = rt_group_w + (size_t)layer * D * 4; ra.rgb = rt_group_b + layer * 4; ra.rew = rt_expert_w + (size_t)layer * D * NEXP; ra.reb = rt_expert_b + layer * NEXP;
            ra.cnt = cnt_p; ra.list = LIST; ra.tokinfo = TOKINFO; ra.wr = WRT + (size_t)layer * 2 * 48 * D; ra.rsl = RSL;
            row_phase<RM_ROUTE, false, true, false>(lds, ra, G);
            SEAM();
        }
        if (PH(10) && IN(pb + 10)) { DEF_W
            moe_tables(lds, cnt_p);
#if (NEWMOE & 1)
            moe_phase<1>(lds, LIST, (const char*)H16, ex_w_gate + (size_t)layer * NEXP * D * DEXP, ex_w_up + (size_t)layer * NEXP * D * DEXP, HID, G, bx, ffn_norm + (size_t)layer * D, RSL);
#ifdef MOE_ABLV
            if (NREP(10) > 1) moe_phase<1, MOE_ABLV>(lds, LIST, (const char*)H16, ex_w_gate + (size_t)layer * NEXP * D * DEXP, ex_w_up + (size_t)layer * NEXP * D * DEXP, YB, G, bx, ffn_norm + (size_t)layer * D, RSL);
#else
            if (NREP(10) > 1) moe_phase<1>(lds, LIST, (const char*)H16, ex_w_gate + (size_t)layer * NEXP * D * DEXP, ex_w_up + (size_t)layer * NEXP * D * DEXP, YB, G, bx, ffn_norm + (size_t)layer * D, RSL);
#endif
#else
            Moe1Sched S{tbl, LIST, (const char*)HN, (const char*)WG, (const char*)WU, (char*)HID, G, bx};
            pg8::EpiPair<true> E{}; for (int rep = 0; rep < NREP(10); ++rep) pg8::gemm_phase<pg8::EpiPair<true>, Moe1Sched, true>(lds, D, D, D, S, E);
#endif
            SEAM();
        }
        if (PH(11) && IN(pb + 11)) { DEF_W
            if (!args.fused) moe_tables(lds, cnt_p);
#if (NEWMOE & 2)
            moe_phase<2>(lds, nullptr, (const char*)HID, ex_w_down + (size_t)layer * NEXP * D * DEXP, nullptr, YB, G, bx);
#ifdef MOE_ABLV
            if (NREP(11) > 1) moe_phase<2, MOE_ABLV>(lds, nullptr, (const char*)HID, ex_w_down + (size_t)layer * NEXP * D * DEXP, nullptr, Z, G, bx);
#else
            if (NREP(11) > 1) moe_phase<2>(lds, nullptr, (const char*)HID, ex_w_down + (size_t)layer * NEXP * D * DEXP, nullptr, Z, G, bx);
#endif
#else
            Moe2Sched S{tbl, (const char*)HID, (const char*)WD, (char*)YB, G, bx};
            pg8::EpiBf16 E{}; for (int rep = 0; rep < NREP(11); ++rep) pg8::gemm_phase<pg8::EpiBf16, Moe2Sched, true>(lds, DEXP, DEXP, DEXP, S, E);
#endif
            SEAM();
        }
        if (PH(12) && IN(pb + 12)) { DEF_W
            if (!args.fused) moe_tables(lds, cnt_p);
            if (layer == 0) { combine_phase<false>(lds, H16, YB, TOKINFO, nullptr, RSTD1, nullptr, G); SEAM(); }
            else combine_phase<true>(lds, H16, YB, TOKINFO, final_norm, nullptr, hbuf, G);
        }
    }
#undef IN
#undef SEAM
#undef KARG
#undef hbuf
#undef INP
#undef DEF_W
#undef W_EVIN
#undef W_EVOUT
#undef W_ODIN
#undef W_ODOUT
#undef W_XQ
#undef W_XK
#undef W_XV
#undef W_XO
#undef W_POOL
#undef MEMN
#undef KX
#undef VX
#undef GATES
#undef BCUM
#undef GI
#undef MARR
#undef APREV
#undef BLG
#undef KN
#undef NST
#undef HN
#undef Z
#undef YCAT
#undef DPOOL
#undef KC
#undef CST
#undef QX
#undef OATT
#undef HID
#undef H16
#undef WRT
#undef YB
#undef LIST
#undef RSL
#undef RSTD1
#undef TOKINFO
#undef WG
#undef WU
#undef WD
#undef cnt_p
#undef x_in
#undef mem_in
#undef mix_norm
#undef xattn_norm
#undef mem_norm
#undef ffn_norm
#undef final_norm
#undef ev_w_in
#undef ev_b_gates
#undef ev_pool_w
#undef ev_pool_scale
#undef ev_head_norm
#undef ev_w_out
#undef od_w_in
#undef od_conv_w
#undef od_w_out
#undef xa_wq
#undef xa_wk
#undef xa_wv
#undef xa_wo
#undef rt_group_w
#undef rt_group_b
#undef rt_expert_w
#undef rt_expert_b
#undef ex_w_gate
#undef ex_w_up
#undef ex_w_down
}

extern "C" void kernel_launch(void* const* d_in, const int* in_sizes, int n_in, void* d_out, int out_size, void* d_ws, size_t ws_size, hipStream_t stream) {
    static int grid = 0;
    if (grid == 0) {
        if (n_in != 27 || in_sizes[0] != T * D || out_size != T * D || ws_size < WS_END) { fprintf(stderr, "kernel_launch: unexpected shapes (n_in %d, in0 %d, out %d, ws %zu < %zu); nothing launched\n", n_in, n_in > 0 ? in_sizes[0] : -1, out_size, ws_size, (size_t)WS_END); grid = -1; return; }
        int dev = 0, cus = 0, per_cu = 0;
        if (hipGetDevice(&dev) != hipSuccess || hipDeviceGetAttribute(&cus, hipDeviceAttributeMultiprocessorCount, dev) != hipSuccess) { fprintf(stderr, "kernel_launch: device query failed\n"); grid = -1; return; }
        if (hipFuncSetAttribute((const void*)mk_fwd, hipFuncAttributeMaxDynamicSharedMemorySize, LDS_BYTES) != hipSuccess) { fprintf(stderr, "kernel_launch: hipFuncSetAttribute(%d B LDS) failed\n", LDS_BYTES); grid = -1; return; }
        if (hipOccupancyMaxActiveBlocksPerMultiprocessor(&per_cu, (const void*)mk_fwd, NTHR, LDS_BYTES) != hipSuccess || per_cu < 1) fprintf(stderr, "kernel_launch: note: occupancy query reports %d workgroups per CU\n", per_cu);
        (void)hipGetLastError();
        grid = cus;
    }
    if (grid < 0) return;
    if (hipMemsetAsync((char*)d_ws + WS_CTL, 0, CTL_ZERO_BYTES, stream) != hipSuccess) { fprintf(stderr, "kernel_launch: memset failed\n"); return; }
    Args a{};
    for (int i = 0; i < 27; ++i) a.in[i] = (const float*)d_in[i];
    a.out = (float*)d_out; a.ws = (unsigned char*)d_ws;
#if MK_PER_PHASE
    for (int p = 0; p < NPH; ++p) {
        if (p == 16 || p == 17) continue;
        a.ph_lo = p; a.ph_hi = p + 1; a.fused = 0;
        hipLaunchKernelGGL(mk_fwd, dim3(grid), dim3(NTHR), LDS_BYTES, stream, a);
    }
#else
    a.ph_lo = 0; a.ph_hi = NPH; a.fused = 1;
    hipLaunchKernelGGL(mk_fwd, dim3(grid), dim3(NTHR), LDS_BYTES, stream, a);
#endif
    const hipError_t le = hipPeekAtLastError();
    if (le != hipSuccess) fprintf(stderr, "kernel_launch: launch failed: %s (grid %d)\n", hipGetErrorName(le), grid);
}
```

```cpp
#include <hip/hip_runtime.h>
#include <cstdio>
#include <cstdint>

#define LAS __attribute__((address_space(3)))
typedef unsigned short bf16_t;
typedef short bf16x8 __attribute__((ext_vector_type(8)));
typedef short s16x4 __attribute__((ext_vector_type(4)));
typedef short v4i16_t __attribute__((ext_vector_type(4)));
typedef float f32x4 __attribute__((ext_vector_type(4)));
typedef float f32x2 __attribute__((ext_vector_type(2)));
typedef unsigned u32x4 __attribute__((ext_vector_type(4)));
typedef unsigned u32x2 __attribute__((ext_vector_type(2)));

__device__ __forceinline__ unsigned cvt_pk_bf16(float lo, float hi) { unsigned r; asm volatile("v_cvt_pk_bf16_f32 %0, %1, %2" : "=v"(r) : "v"(lo), "v"(hi)); return r; }
__device__ __forceinline__ float bf_lo(unsigned u) { return __builtin_bit_cast(float, u << 16); }
__device__ __forceinline__ float bf_hi(unsigned u) { return __builtin_bit_cast(float, u & 0xffff0000u); }
__device__ __forceinline__ float bf2f(unsigned short b) { return __builtin_bit_cast(float, ((unsigned)b) << 16); }

__device__ __forceinline__ int fresh_tid() { int t = threadIdx.x; asm volatile("" : "+v"(t)); return t; }
__device__ __forceinline__ int fresh_bx() { int t = blockIdx.x; asm volatile("" : "+s"(t)); return t; }
__device__ __forceinline__ int fresh_s(int t) { asm volatile("" : "+s"(t)); return t; }
__device__ __forceinline__ void glds16(const char* base, unsigned voff, unsigned lds_dst) {
    unsigned keep;
    asm volatile("s_mov_b32 %0, m0\n\ts_mov_b32 m0, %3\n\ts_nop 0\n\tglobal_load_lds_dwordx4 %1, %2\n\ts_mov_b32 m0, %0" : "=&s"(keep) : "v"(voff), "s"(base), "s"(lds_dst) : "memory");
}
namespace pg8 {
constexpr int BM = 256, BK = 64, HALF = 128, HTB = HALF * BK * 2  , STAGE_BYTES = 8 * HTB, NXCD = 8, WGM = 8;
__host__ __device__ __forceinline__ int lds_byte(int r, int c) { const int st = (r >> 4) * 2 + (c >> 5), rr = r & 15, cc = c & 31, ob = rr * 64 + cc * 2; return st * 1024 + (ob ^ (((ob >> 9) & 1) << 5)); }
__host__ __device__ __forceinline__ void stage_rc(int b, int& R, int& C) { const int st = b / 1024, sb = b % 1024, swz = sb ^ (((sb >> 9) & 1) << 5); R = (st >> 1) * 16 + swz / 64; C = (st & 1) * 32 + (swz % 64) / 2; }
__host__ __device__ __forceinline__ int perm32(int rho) { const int n = rho >> 4, i = rho & 15; return 8 * (i >> 2) + 4 * n + (i & 3); }

struct Unit { const char* a; const char* b0; const char* b1; char* out; int ldc, pm, pn, e; };

__device__ __forceinline__ bool tile_of(int i, int G, int c, int nM, int nN, int& pm, int& pn) {
    const int nwg = nM * nN; const long L = (long)i * G + c; if (L >= nwg) return false;
    int wgid = (int)L; { const int q = nwg / NXCD, r = nwg % NXCD, xcd = wgid % NXCD, off = wgid / NXCD; wgid = (xcd < r ? xcd * (q + 1) : r * (q + 1) + (xcd - r) * q) + off; }
    const int nig = WGM * nN, gid = wgid / nig, fm = gid * WGM, gsz = (nM - fm) < WGM ? (nM - fm) : WGM;
    pm = fm + ((wgid % nig) % gsz); pn = (wgid % nig) / gsz; return true;
}
struct DenseSched {
    static constexpr bool GATHER = false;
    const char* A; size_t a_mstep, a_nstep; const char* B0; const char* B1; size_t b_nstep; char* out; int ldc, nM, nN, G, c;
    __device__ __forceinline__ bool next(int i, Unit& u) const {
        int pm, pn; if (!tile_of(i, G, c, nM, nN, pm, pn)) return false;
        u.a = A + (size_t)pm * a_mstep + (size_t)pn * a_nstep; u.b0 = B0 + (size_t)pn * b_nstep; u.b1 = B1 + (size_t)pn * b_nstep; u.out = out; u.ldc = ldc; u.pm = pm; u.pn = pn; u.e = 0; return true;
    }
    __device__ __forceinline__ int arow(const Unit&, int r) const { return r; }
};

struct EpiBf16 {
    static constexpr bool PERM = true;
    __device__ __forceinline__ void operator()(const f32x4 (&acc)[2][2][4][2], const Unit& u, int wr, int wc, int fr, int fq) const {
        bf16_t* base = (bf16_t*)u.out; const int row0 = u.pm * BM + wr * 64 + fr, col0 = u.pn * BM + wc * 32 + 8 * fq;
#pragma unroll
        for (int ai = 0; ai < 2; ++ai)
#pragma unroll
            for (int m = 0; m < 4; ++m) { bf16_t* rowp = base + (size_t)(row0 + ai * HALF + m * 16) * u.ldc + col0;
#pragma unroll
                for (int bj = 0; bj < 2; ++bj) { const f32x4 v0 = acc[ai][bj][m][0], v1 = acc[ai][bj][m][1];
                    u32x4 w; w.x = cvt_pk_bf16(v0[0], v0[1]); w.y = cvt_pk_bf16(v0[2], v0[3]); w.z = cvt_pk_bf16(v1[0], v1[1]); w.w = cvt_pk_bf16(v1[2], v1[3]);
                    *(u32x4*)(rowp + bj * HALF) = w; } }
    }
};
struct EpiBf16Scale {
    static constexpr bool PERM = true;
    const float* scale;
    __device__ __forceinline__ void operator()(const f32x4 (&acc)[2][2][4][2], const Unit& u, int wr, int wc, int fr, int fq) const {
        bf16_t* base = (bf16_t*)u.out; const int row0 = u.pm * BM + wr * 64 + fr, col0 = u.pn * BM + wc * 32 + 8 * fq;
        f32x4 sv[2][2];
#pragma unroll
        for (int bj = 0; bj < 2; ++bj)
#pragma unroll
            for (int n = 0; n < 2; ++n) sv[bj][n] = *(const f32x4*)(scale + col0 + bj * HALF + 4 * n);
#pragma unroll
        for (int ai = 0; ai < 2; ++ai)
#pragma unroll
            for (int m = 0; m < 4; ++m) { bf16_t* rowp = base + (size_t)(row0 + ai * HALF + m * 16) * u.ldc + col0;
#pragma unroll
                for (int bj = 0; bj < 2; ++bj) { const f32x4 v0 = acc[ai][bj][m][0] * sv[bj][0], v1 = acc[ai][bj][m][1] * sv[bj][1];
                    u32x4 w; w.x = cvt_pk_bf16(v0[0], v0[1]); w.y = cvt_pk_bf16(v0[2], v0[3]); w.z = cvt_pk_bf16(v1[0], v1[1]); w.w = cvt_pk_bf16(v1[2], v1[3]);
                    *(u32x4*)(rowp + bj * HALF) = w; } }
    }
};
template <bool SILU> struct EpiPair {
    static constexpr bool PERM = true;
    __device__ __forceinline__ void operator()(const f32x4 (&acc)[2][2][4][2], const Unit& u, int wr, int wc, int fr, int fq) const {
        bf16_t* base = (bf16_t*)u.out; const int row0 = u.pm * BM + wr * 64 + fr, col0 = u.pn * HALF + wc * 32 + 8 * fq;
#pragma unroll
        for (int ai = 0; ai < 2; ++ai)
#pragma unroll
            for (int m = 0; m < 4; ++m) { bf16_t* rowp = base + (size_t)(row0 + ai * HALF + m * 16) * u.ldc + col0;
                float r[8];
#pragma unroll
                for (int n = 0; n < 2; ++n)
#pragma unroll
                    for (int j = 0; j < 4; ++j) { const float g = acc[ai][0][m][n][j], up = acc[ai][1][m][n][j];
                        r[n * 4 + j] = SILU ? (g * __builtin_amdgcn_rcpf(1.0f + __expf(-g))) * up : g * up; }
                u32x4 w; w.x = cvt_pk_bf16(r[0], r[1]); w.y = cvt_pk_bf16(r[2], r[3]); w.z = cvt_pk_bf16(r[4], r[5]); w.w = cvt_pk_bf16(r[6], r[7]);
                *(u32x4*)rowp = w; }
    }
};
struct EpiRes {
    static constexpr bool PERM = false;
    const float* res;
    __device__ __forceinline__ void operator()(const f32x4 (&acc)[2][2][4][2], const Unit& u, int wr, int wc, int fr, int fq) const {
        float* base = (float*)u.out; const int row0 = u.pm * BM + wr * 64 + fr, col0 = u.pn * BM + wc * 32 + 4 * fq;
#pragma unroll
        for (int ai = 0; ai < 2; ++ai)
#pragma unroll
            for (int m = 0; m < 4; ++m) { const size_t ro = (size_t)(row0 + ai * HALF + m * 16) * u.ldc + col0;
                f32x4 rv[2][2];
#pragma unroll
                for (int bj = 0; bj < 2; ++bj)
#pragma unroll
                    for (int n = 0; n < 2; ++n) rv[bj][n] = *(const f32x4*)(res + ro + bj * HALF + n * 16);
#pragma unroll
                for (int bj = 0; bj < 2; ++bj)
#pragma unroll
                    for (int n = 0; n < 2; ++n) *(f32x4*)(base + ro + bj * HALF + n * 16) = acc[ai][bj][m][n] + rv[bj][n]; }
    }
};

template <bool RES16> struct EpiResSsq {
    static constexpr bool PERM = true;
    const void* res; float* ssq;
    __device__ __forceinline__ void operator()(const f32x4 (&acc)[2][2][4][2], const Unit& u, int wr, int wc, int fr, int fq) const {
        bf16_t* base = (bf16_t*)u.out; const int row0 = u.pm * BM + wr * 64 + fr, col0 = u.pn * BM + wc * 32 + 8 * fq;
        if constexpr (RES16) {
            u32x4 t[2][4][2];
#pragma unroll
            for (int ai = 0; ai < 2; ++ai)
#pragma unroll
                for (int m = 0; m < 4; ++m)
#pragma unroll
                    for (int bj = 0; bj < 2; ++bj) t[ai][m][bj] = *(const u32x4*)((const bf16_t*)res + (size_t)(row0 + ai * HALF + m * 16) * u.ldc + col0 + bj * HALF);
#pragma unroll
            for (int ai = 0; ai < 2; ++ai)
#pragma unroll
                for (int m = 0; m < 4; ++m) { const int row = row0 + ai * HALF + m * 16; const size_t ro = (size_t)row * u.ldc + col0;
                    float s = 0.f;
#pragma unroll
                    for (int bj = 0; bj < 2; ++bj) { const u32x4 tt = t[ai][m][bj];
                        const f32x4 v0 = acc[ai][bj][m][0] + (f32x4){bf_lo(tt.x), bf_hi(tt.x), bf_lo(tt.y), bf_hi(tt.y)}, v1 = acc[ai][bj][m][1] + (f32x4){bf_lo(tt.z), bf_hi(tt.z), bf_lo(tt.w), bf_hi(tt.w)};
                        u32x4 w; w.x = cvt_pk_bf16(v0[0], v0[1]); w.y = cvt_pk_bf16(v0[2], v0[3]); w.z = cvt_pk_bf16(v1[0], v1[1]); w.w = cvt_pk_bf16(v1[2], v1[3]);
                        *(u32x4*)(base + ro + bj * HALF) = w;
                        s += ((v0[0] * v0[0] + v0[1] * v0[1]) + (v0[2] * v0[2] + v0[3] * v0[3])) + ((v1[0] * v1[0] + v1[1] * v1[1]) + (v1[2] * v1[2] + v1[3] * v1[3])); }
                    if (ssq) { s += __shfl_xor(s, 16); s += __shfl_xor(s, 32);
                        if (fq == 0) ssq[(size_t)row * 32 + u.pn * 4 + wc] = s; } }
        } else {
#pragma unroll
        for (int ai = 0; ai < 2; ++ai)
#pragma unroll
            for (int m = 0; m < 4; ++m) { const int row = row0 + ai * HALF + m * 16; const size_t ro = (size_t)row * u.ldc + col0;
                f32x4 rv[2][2];
#pragma unroll
                for (int bj = 0; bj < 2; ++bj) { rv[bj][0] = *(const f32x4*)((const float*)res + ro + bj * HALF); rv[bj][1] = *(const f32x4*)((const float*)res + ro + bj * HALF + 4); }
                float s = 0.f;
#pragma unroll
                for (int bj = 0; bj < 2; ++bj) { const f32x4 v0 = acc[ai][bj][m][0] + rv[bj][0], v1 = acc[ai][bj][m][1] + rv[bj][1];
                    u32x4 w; w.x = cvt_pk_bf16(v0[0], v0[1]); w.y = cvt_pk_bf16(v0[2], v0[3]); w.z = cvt_pk_bf16(v1[0], v1[1]); w.w = cvt_pk_bf16(v1[2], v1[3]);
                    *(u32x4*)(base + ro + bj * HALF) = w;
                    s += ((v0[0] * v0[0] + v0[1] * v0[1]) + (v0[2] * v0[2] + v0[3] * v0[3])) + ((v1[0] * v1[0] + v1[1] * v1[1]) + (v1[2] * v1[2] + v1[3] * v1[3])); }
                if (ssq) { s += __shfl_xor(s, 16); s += __shfl_xor(s, 32);
                    if (fq == 0) ssq[(size_t)row * 32 + u.pn * 4 + wc] = s; } }
        }
    }
};
struct EpiBf16RowScale {
    static constexpr bool PERM = true;
    const float* ssq; float inv_n, eps;
    __device__ __forceinline__ void operator()(const f32x4 (&acc)[2][2][4][2], const Unit& u, int wr, int wc, int fr, int fq) const {
        bf16_t* base = (bf16_t*)u.out; const int row0 = u.pm * BM + wr * 64 + fr, col0 = u.pn * BM + wc * 32 + 8 * fq;
#pragma unroll
        for (int ai = 0; ai < 2; ++ai)
#pragma unroll
            for (int m = 0; m < 4; ++m) { const int row = row0 + ai * HALF + m * 16; bf16_t* rowp = base + (size_t)row * u.ldc + col0;
                const f32x4 pa = *(const f32x4*)(ssq + (size_t)row * 32 + 8 * fq), pb = *(const f32x4*)(ssq + (size_t)row * 32 + 8 * fq + 4);
                float ps = ((pa[0] + pa[1]) + (pa[2] + pa[3])) + ((pb[0] + pb[1]) + (pb[2] + pb[3]));
                ps += __shfl_xor(ps, 16); ps += __shfl_xor(ps, 32);
                const float rs = rsqrtf(ps * inv_n + eps);
#pragma unroll
                for (int bj = 0; bj < 2; ++bj) { const f32x4 v0 = acc[ai][bj][m][0] * rs, v1 = acc[ai][bj][m][1] * rs;
                    u32x4 w; w.x = cvt_pk_bf16(v0[0], v0[1]); w.y = cvt_pk_bf16(v0[2], v0[3]); w.z = cvt_pk_bf16(v1[0], v1[1]); w.w = cvt_pk_bf16(v1[2], v1[3]);
                    *(u32x4*)(rowp + bj * HALF) = w; } }
    }
};

struct EpiBf16Rs {
    static constexpr bool PERM = true;
    const float* rs;
    __device__ __forceinline__ void operator()(const f32x4 (&acc)[2][2][4][2], const Unit& u, int wr, int wc, int fr, int fq) const {
        bf16_t* base = (bf16_t*)u.out; const int row0 = u.pm * BM + wr * 64 + fr, col0 = u.pn * BM + wc * 32 + 8 * fq;
#pragma unroll
        for (int ai = 0; ai < 2; ++ai)
#pragma unroll
            for (int m = 0; m < 4; ++m) { const int row = row0 + ai * HALF + m * 16; bf16_t* rowp = base + (size_t)row * u.ldc + col0; const float r = rs[row];
#pragma unroll
                for (int bj = 0; bj < 2; ++bj) { const f32x4 v0 = acc[ai][bj][m][0] * r, v1 = acc[ai][bj][m][1] * r;
                    u32x4 w; w.x = cvt_pk_bf16(v0[0], v0[1]); w.y = cvt_pk_bf16(v0[2], v0[3]); w.z = cvt_pk_bf16(v1[0], v1[1]); w.w = cvt_pk_bf16(v1[2], v1[3]);
                    *(u32x4*)(rowp + bj * HALF) = w; } }
    }
};
struct EpiPairRs {
    static constexpr bool PERM = true;
    const float* rs;
    __device__ __forceinline__ void operator()(const f32x4 (&acc)[2][2][4][2], const Unit& u, int wr, int wc, int fr, int fq) const {
        bf16_t* base = (bf16_t*)u.out; const int row0 = u.pm * BM + wr * 64 + fr, col0 = u.pn * HALF + wc * 32 + 8 * fq;
#pragma unroll
        for (int ai = 0; ai < 2; ++ai)
#pragma unroll
            for (int m = 0; m < 4; ++m) { const int row = row0 + ai * HALF + m * 16; bf16_t* rowp = base + (size_t)row * u.ldc + col0; const float q = rs[row], q2 = q * q;
                float r[8];
#pragma unroll
                for (int n = 0; n < 2; ++n)
#pragma unroll
                    for (int j = 0; j < 4; ++j) r[n * 4 + j] = acc[ai][0][m][n][j] * acc[ai][1][m][n][j] * q2;
                u32x4 w; w.x = cvt_pk_bf16(r[0], r[1]); w.y = cvt_pk_bf16(r[2], r[3]); w.z = cvt_pk_bf16(r[4], r[5]); w.w = cvt_pk_bf16(r[6], r[7]);
                *(u32x4*)rowp = w; }
    }
};

template <class Epi, class Sched, bool ALIGN_EPI>
__device__ __forceinline__ void gemm_phase(LAS unsigned char* lds, const int K, const int lda, const int ldb, const Sched& S, const Epi& E) {
    const int tid = fresh_tid(), wid = __builtin_amdgcn_readfirstlane(tid >> 6), lane = tid & 63, wr = wid >> 2, wc = wid & 3, fr = lane & 15, fq = lane >> 4;
    const int nt = K / BK;
    int sR[2], sC[2]; unsigned voffB[2], vA[2][2], nvA[2][2];
#pragma unroll
    for (int i = 0; i < 2; ++i) { stage_rc(tid * 16 + i * 8192, sR[i], sC[i]); const int Rb = Epi::PERM ? ((sR[i] & ~31) + perm32(sR[i] & 31)) : sR[i];
        voffB[i] = (unsigned)(Rb * ldb + sC[i]) * 2u; }
    const size_t kstep = (size_t)(BK * 2);
    const unsigned ldsb = (unsigned)__builtin_amdgcn_readfirstlane((int)(unsigned)(__UINTPTR_TYPE__)lds) + (unsigned)wid * 1024u;
    const size_t hstepA = (size_t)HALF * lda * 2;
    const int aoff = lds_byte(wr * 64 + fr, fq * 8), boff = lds_byte(wc * 32 + fr, fq * 8);
#define PG8_SA(b, h) (((b) * 2 + (h)) * HTB)
#define PG8_SB(b, h) ((4 + (b) * 2 + (h)) * HTB)
#define PG8_STAGE(bufoff, gbase, voff) do { _Pragma("unroll") for (int _i = 0; _i < 2; ++_i) \
        glds16((const char*)(gbase), (voff)[_i], ldsb + (unsigned)(bufoff) + (unsigned)(_i * 8192)); } while (0)
#define PG8_STAGE_A(bufoff, gbase, h, VA) do { if constexpr (Sched::GATHER) { PG8_STAGE(bufoff, gbase, (VA)[h]); } else { PG8_STAGE(bufoff, (gbase) + (h) * hstepA, (VA)[0]); } } while (0)
#define PG8_LDA(dst, b, h) do { _Pragma("unroll") for (int m = 0; m < 4; ++m) _Pragma("unroll") for (int k = 0; k < 2; ++k) dst[m][k] = *(const LAS bf16x8*)(lds + PG8_SA(b, h) + aoff + m * 2048 + k * 1024); } while (0)
#define PG8_LDB(dst, b, h) do { _Pragma("unroll") for (int n = 0; n < 2; ++n) _Pragma("unroll") for (int k = 0; k < 2; ++k) dst[n][k] = *(const LAS bf16x8*)(lds + PG8_SB(b, h) + boff + n * 2048 + k * 1024); } while (0)
#define PG8_MMA(ai, bj, At, Bt) do { __builtin_amdgcn_s_setprio(1); _Pragma("unroll") for (int m = 0; m < 4; ++m) _Pragma("unroll") for (int n = 0; n < 2; ++n) _Pragma("unroll") for (int k = 0; k < 2; ++k) \
        acc[ai][bj][m][n] = __builtin_amdgcn_mfma_f32_16x16x32_bf16(Bt[n][k], At[m][k], acc[ai][bj][m][n], 0, 0, 0); __builtin_amdgcn_s_setprio(0); } while (0)
#define PG8_WAIT_V(n) asm volatile("s_waitcnt vmcnt(" #n ")" ::: "memory")
#define PG8_WAIT_L(n) asm volatile("s_waitcnt lgkmcnt(" #n ")" ::: "memory")
#define PG8_BAR __builtin_amdgcn_s_barrier()
#define PG8_SCHED __builtin_amdgcn_sched_barrier(0)
    Unit cur, nxt; int ui = 0;
    if (!S.next(0, cur)) return;
#pragma unroll
    for (int h = 0; h < 2; ++h)
#pragma unroll
        for (int i = 0; i < 2; ++i) vA[h][i] = Sched::GATHER ? (unsigned)(S.arow(cur, h * HALF + sR[i]) * lda + sC[i]) * 2u : (unsigned)(sR[i] * lda + sC[i]) * 2u;
    f32x4 acc[2][2][4][2];
#pragma unroll
    for (int a = 0; a < 2; ++a)
#pragma unroll
        for (int b = 0; b < 2; ++b)
#pragma unroll
            for (int m = 0; m < 4; ++m)
#pragma unroll
                for (int n = 0; n < 2; ++n) acc[a][b][m][n] = (f32x4){0.f, 0.f, 0.f, 0.f};
    bf16x8 At[4][2], B0[2][2], B1[2][2];
    PG8_STAGE(PG8_SB(0, 0), cur.b0, voffB); PG8_STAGE(PG8_SB(0, 1), cur.b1, voffB); PG8_STAGE_A(PG8_SA(0, 0), cur.a, 0, vA); PG8_STAGE_A(PG8_SA(0, 1), cur.a, 1, vA);
    if (wr == 1) PG8_BAR;
    PG8_WAIT_V(2); PG8_BAR;
    PG8_STAGE(PG8_SB(1, 0), cur.b0 + kstep, voffB); PG8_STAGE_A(PG8_SA(1, 0), cur.a + kstep, 0, vA); PG8_STAGE(PG8_SB(1, 1), cur.b1 + kstep, voffB);
    PG8_WAIT_V(6); PG8_BAR;
    for (;;) {
        const bool has_next = S.next(ui + 1, nxt);
        const char* nA = has_next ? nxt.a : cur.a; const char* nB0 = has_next ? nxt.b0 : cur.b0; const char* nB1 = has_next ? nxt.b1 : cur.b1;
        if constexpr (Sched::GATHER) {
#pragma unroll
            for (int h = 0; h < 2; ++h)
#pragma unroll
                for (int i = 0; i < 2; ++i) nvA[h][i] = has_next ? (unsigned)(S.arow(nxt, h * HALF + sR[i]) * lda + sC[i]) * 2u : vA[h][i];
        }
        for (int t = 0; t < nt; t += 2) {
            const bool last = (t == nt - 2);
            const char* a1 = cur.a + (size_t)(t + 1) * kstep;
            const char* a2 = last ? nA : cur.a + (size_t)(t + 2) * kstep;
            const char* b20 = last ? nB0 : cur.b0 + (size_t)(t + 2) * kstep; const char* b21 = last ? nB1 : cur.b1 + (size_t)(t + 2) * kstep;
            const char* a3 = a2 + kstep; const char* b30 = b20 + kstep; const char* b31 = b21 + kstep;
            unsigned wA[2][2];
#pragma unroll
            for (int h = 0; h < 2; ++h)
#pragma unroll
                for (int i = 0; i < 2; ++i) wA[h][i] = (Sched::GATHER && last) ? nvA[h][i] : vA[h][i];
            PG8_LDB(B0, 0, 0); PG8_LDB(B1, 0, 1); PG8_SCHED; PG8_LDA(At, 0, 0); PG8_STAGE_A(PG8_SA(1, 1), a1, 1, vA);
            PG8_WAIT_V(8); PG8_WAIT_L(0); PG8_BAR; PG8_MMA(0, 0, At, B0); PG8_MMA(0, 1, At, B1); PG8_BAR; PG8_SCHED;
            PG8_LDA(At, 0, 1); PG8_STAGE(PG8_SB(0, 0), b20, voffB); PG8_STAGE(PG8_SB(0, 1), b21, voffB); PG8_STAGE_A(PG8_SA(0, 0), a2, 0, wA);
            PG8_WAIT_V(8); PG8_WAIT_L(0); PG8_BAR; PG8_MMA(1, 0, At, B0); PG8_MMA(1, 1, At, B1); PG8_BAR; PG8_SCHED;
            PG8_LDB(B0, 1, 0); PG8_LDB(B1, 1, 1); PG8_SCHED; PG8_LDA(At, 1, 0); PG8_STAGE_A(PG8_SA(0, 1), a2, 1, wA);
            PG8_WAIT_V(8); PG8_WAIT_L(0); PG8_BAR; PG8_MMA(0, 0, At, B0); PG8_MMA(0, 1, At, B1); PG8_BAR; PG8_SCHED;
            PG8_LDA(At, 1, 1); PG8_STAGE(PG8_SB(1, 0), b30, voffB); PG8_STAGE(PG8_SB(1, 1), b31, voffB); PG8_STAGE_A(PG8_SA(1, 0), a3, 0, wA);
            PG8_WAIT_V(8); PG8_WAIT_L(0); PG8_BAR; PG8_MMA(1, 0, At, B0); PG8_MMA(1, 1, At, B1); PG8_BAR; PG8_SCHED;
        }
        if constexpr (ALIGN_EPI) { if (wr == 0) PG8_BAR; }
        E(acc, cur, wr, wc, fr, fq);
        if (!has_next) break;
#pragma unroll
        for (int a = 0; a < 2; ++a)
#pragma unroll
            for (int b = 0; b < 2; ++b)
#pragma unroll
                for (int m = 0; m < 4; ++m)
#pragma unroll
                    for (int n = 0; n < 2; ++n) acc[a][b][m][n] = (f32x4){0.f, 0.f, 0.f, 0.f};
        cur = nxt; ++ui;
        if constexpr (Sched::GATHER) {
#pragma unroll
            for (int h = 0; h < 2; ++h)
#pragma unroll
                for (int i = 0; i < 2; ++i) vA[h][i] = nvA[h][i];
        }
        if constexpr (ALIGN_EPI) { if (wr == 1) PG8_BAR; }
    }
    PG8_WAIT_V(0);
    if constexpr (!ALIGN_EPI) { if (wr == 0) PG8_BAR; }
    PG8_BAR;
#undef PG8_SA
#undef PG8_SB
#undef PG8_STAGE
#undef PG8_STAGE_A
#undef PG8_LDA
#undef PG8_LDB
#undef PG8_MMA
#undef PG8_WAIT_V
#undef PG8_WAIT_L
#undef PG8_BAR
#undef PG8_SCHED
}
}
#define XB_TMO      128
#define XB_XCNT(j)  (256  + 64 * (j))
#define XB_XSUB(j)  (1280 + 64 * (j))
#define XB_XGEN(j)  (2304 + 64 * (j))
#define XB_TOP      3328
#define XB_TOPGEN   3392
#define XCD_BAR_WORDS 3456
#define XB_SPIN_CAP (1u << 21)

__device__ __forceinline__ unsigned xb_ld(unsigned* p)              { return __hip_atomic_load(p, __ATOMIC_RELAXED, __HIP_MEMORY_SCOPE_AGENT); }
__device__ __forceinline__ unsigned xb_add(unsigned* p, unsigned v) { return __hip_atomic_fetch_add(p, v, __ATOMIC_RELAXED, __HIP_MEMORY_SCOPE_AGENT); }
__device__ __forceinline__ unsigned xb_xcc_id() { return (unsigned)__builtin_amdgcn_s_getreg((3 << 11) | 20) & 0xFu; }
#define XB_SPIN(cond, bar) do { unsigned _sp = 0; while (cond) { __builtin_amdgcn_s_sleep(1); \
    if ((++_sp & 255u) == 0u) { if (xb_ld(&(bar)[XB_TMO])) break; if (_sp > XB_SPIN_CAP) { atomicAdd(&(bar)[XB_TMO], 1u); break; } } } } while (0)

struct XcdBarrier {
    unsigned* bar; unsigned x;
    volatile LAS unsigned* st;
};

__device__ __forceinline__ XcdBarrier xcd_barrier_post(unsigned* bar, volatile LAS unsigned* st) {
    XcdBarrier b; b.bar = bar; b.x = xb_xcc_id(); b.st = st;
    if (threadIdx.x == 0) (void)xb_add(&bar[XB_XCNT(b.x)], 1u);
    return b;
}
__device__ __forceinline__ void xcd_barrier_complete(unsigned* bar, unsigned x, unsigned& nloc, unsigned& nx) {
    const unsigned G = gridDim.x * gridDim.y * gridDim.z;
    unsigned sum, cnt, mine, sp = 0u;
    for (;;) {
        sum = 0u; cnt = 0u; mine = 0u;
#pragma unroll
        for (unsigned j = 0; j < 16; ++j) { const unsigned c = xb_ld(&bar[XB_XCNT(j)]); sum += c; cnt += (c > 0u) ? 1u : 0u; mine = (j == x) ? c : mine; }
        if (sum == G) break;
        __builtin_amdgcn_s_sleep(1);
        if ((++sp & 255u) == 0u) { if (xb_ld(&bar[XB_TMO])) break; if (sp > XB_SPIN_CAP) { atomicAdd(&bar[XB_TMO], 1u); break; } }
    }
    nloc = mine > 0u ? mine : 1u; nx = cnt > 0u ? cnt : 1u;
}

__device__ __forceinline__ void xcd_barrier(const XcdBarrier& b) {
    asm volatile("s_waitcnt vmcnt(0)" ::: "memory");
    __syncthreads();
    if (threadIdx.x == 0) {
        unsigned* bar = b.bar;
        __builtin_amdgcn_s_waitcnt(0);
        unsigned nloc = b.st[0], nx = b.st[1];
        if (nloc == 0u) { xcd_barrier_complete(bar, b.x, nloc, nx); b.st[0] = nloc; b.st[1] = nx; }
        const unsigned old = xb_add(&bar[XB_XSUB(b.x)], 1u);
        const unsigned gen = old / nloc;
        if (old + 1u == (gen + 1u) * nloc) {
            __builtin_amdgcn_fence(__ATOMIC_RELEASE, "agent");
            asm volatile("s_waitcnt vmcnt(0)" ::: "memory");
            const unsigned og = xb_add(&bar[XB_TOP], 1u);
            const unsigned tg = og / nx;
            if (og + 1u == (tg + 1u) * nx) xb_add(&bar[XB_TOPGEN], 1u);
            else XB_SPIN(xb_ld(&bar[XB_TOPGEN]) == tg, bar);
            __builtin_amdgcn_fence(__ATOMIC_ACQUIRE, "agent");
            xb_add(&bar[XB_XGEN(b.x)], 1u);
            asm volatile("s_waitcnt vmcnt(0)" ::: "memory");
        } else {
            XB_SPIN(xb_ld(&bar[XB_XGEN(b.x)]) == gen, bar);
            __builtin_amdgcn_fence(__ATOMIC_ACQUIRE, "agent");
            asm volatile("s_waitcnt vmcnt(0)" ::: "memory");
        }
    }
    __syncthreads();
}

constexpr int T = 8192, D = 2048, NMEM = 256;
constexpr int EVW = 5128, EVN = 5120, ODN = 6144;
constexpr int NH = 4, DH = 256, CH = 128, NCH = 64;
constexpr int XH = 4, XD = 512;
constexpr int NEXP = 32, DEXP = 1024, LISTCAP = 8192;
constexpr float EPS = 1e-6f;
constexpr int NWAVES = 8, NTHR = 512;

constexpr size_t MiB = 1u << 20;
constexpr size_t WS_CTL = 0, CTL_ZERO_BYTES = 192 * 1024, CTL_SSQ = 64 * 1024;
constexpr size_t WS_WEVIN = 1 * MiB, WS_WEVOUT = 21 * MiB, WS_WODIN = 29 * MiB, WS_WODOUT = 53 * MiB;
constexpr size_t WS_WXQ = 61 * MiB, WS_WXK = 77 * MiB, WS_WXV = 93 * MiB, WS_WXO = 109 * MiB, WS_WPOOL = 125 * MiB;
constexpr size_t WS_MEMN = 126 * MiB, WS_KX = 128 * MiB, WS_VX = 130 * MiB, WS_SMALL = 132 * MiB;
constexpr size_t WS_WEXP = 136 * MiB, WEXP_LAYER = 384 * MiB, WEXP_MAT = 128 * MiB, WEXP_ONE = (size_t)DEXP * D * 2;
constexpr size_t WS_HN = 904 * MiB, WS_Z = 936 * MiB, WS_YCAT = 1032 * MiB, WS_DPOOL = 1064 * MiB, WS_KC = 1080 * MiB, WS_CST = 1144 * MiB;
constexpr size_t WS_QX = 1192 * MiB, WS_OATT = 1224 * MiB, WS_HID = 1256 * MiB, WS_YB = 1304 * MiB, WS_LIST = 1400 * MiB, WS_TOKINFO = 1402 * MiB, WS_H16 = 1404 * MiB, WS_END = 1436 * MiB;
constexpr size_t SM_GATES = 0, SM_BCUM = 256 * 1024, SM_GI = 384 * 1024, SM_MARR = 512 * 1024, SM_APREV = 516 * 1024, SM_BL = 520 * 1024, SM_KN = 1 * MiB, SM_NST = 1 * MiB + 256 * 1024, SM_SSQP = 2 * MiB;
constexpr int CW_BAR = 4096;
constexpr int CW_CNT = 8192;
constexpr int LDS_BYTES = 159744, MISC_OFF = 159232, TBL_OFF = 157696;

__device__ __forceinline__ float wave_sum(float v) {
#pragma unroll
    for (int o = 1; o < 64; o <<= 1) v += __shfl_xor(v, o);
    return v;
}
__device__ __forceinline__ float wave_max(float v) {
#pragma unroll
    for (int o = 1; o < 64; o <<= 1) v = fmaxf(v, __shfl_xor(v, o));
    return v;
}
template <int N, int BIT> struct WRed {
    static __device__ __forceinline__ void run(float* v, int lane) {
        const bool up = (lane & BIT) != 0;
#pragma unroll
        for (int i = 0; i < N / 2; ++i) { const float keep = up ? v[i + N / 2] : v[i]; const float send = up ? v[i] : v[i + N / 2]; v[i] = keep + __shfl_xor(send, BIT); }
        WRed<N / 2, BIT / 2>::run(v, lane);
    }
};
template <int BIT> struct WRed<1, BIT> { static __device__ __forceinline__ void run(float*, int) {} };
template <int N> struct Log2 { static constexpr int v = 1 + Log2<N / 2>::v; };
template <> struct Log2<1> { static constexpr int v = 0; };
template <int N> __device__ __forceinline__ float wave_reduce_pow2(float (&v)[N], int lane) {
    WRed<N, 32>::run(v, lane);
    float r = v[0];
#pragma unroll
    for (int s = Log2<N>::v; s < 6; ++s) r += __shfl_xor(r, 32 >> s);
    return r;
}
__device__ __forceinline__ float logsigf(float x) { return fminf(x, 0.f) - log1pf(expf(-fabsf(x))); }

__device__ __forceinline__ void transpose_item64(const float* W, int ldw, int K, bf16_t* WT, int kb, int nb, LAS float* scr, int lane, const float* gain) {
    const int k0 = kb * 64, n0 = nb * 64;
    const float* src = W + (size_t)(k0 + (lane >> 4)) * ldw + n0 + 4 * (lane & 15);
    f32x4 v[16];
#pragma unroll
    for (int i = 0; i < 16; ++i) v[i] = *(const f32x4*)(src + (size_t)(4 * i) * ldw);
    if (gain) {
#pragma unroll
        for (int i = 0; i < 16; ++i) v[i] = v[i] * gain[k0 + 4 * i + (lane >> 4)]; }
#pragma unroll
    for (int i = 0; i < 16; ++i) { LAS float* d = scr + (4 * i + (lane >> 4)) * 65 + 4 * (lane & 15); d[0] = v[i][0]; d[1] = v[i][1]; d[2] = v[i][2]; d[3] = v[i][3]; }
    asm volatile("s_waitcnt lgkmcnt(0)" ::: "memory");
    const int kc = lane & 7;
#pragma unroll
    for (int j = 0; j < 8; ++j) { const int n = (lane >> 3) + 8 * j; const LAS float* s = scr + (8 * kc) * 65 + n;
        u32x4 o; o.x = cvt_pk_bf16(s[0], s[65]); o.y = cvt_pk_bf16(s[130], s[195]); o.z = cvt_pk_bf16(s[260], s[325]); o.w = cvt_pk_bf16(s[390], s[455]);
        *(u32x4*)(WT + (size_t)(n0 + n) * K + k0 + 8 * kc) = o; }
    asm volatile("s_waitcnt lgkmcnt(0)" ::: "memory");
}

template <int ROWS, int COLS, int PAD> __device__ __forceinline__ void stage_tile(LAS unsigned char* dst, const bf16_t* src, size_t ld, int tid) {
    constexpr int CPR = COLS / 8, TOTAL = ROWS * CPR, RS = (COLS + PAD) * 2, NI = TOTAL / NTHR;
    static_assert(TOTAL % NTHR == 0, "stage_tile");
    u32x4 v[NI];
#pragma unroll
    for (int i = 0; i < NI; ++i) { const int idx = tid + i * NTHR, r = idx / CPR, c = idx % CPR; v[i] = *(const u32x4*)(src + (size_t)r * ld + c * 8); }
#pragma unroll
    for (int i = 0; i < NI; ++i) { const int idx = tid + i * NTHR, r = idx / CPR, c = idx % CPR; *(LAS u32x4*)(dst + r * RS + c * 16) = v[i]; }
}
template <int ROWS, int COLS> __device__ __forceinline__ void stage_load(u32x4 (&v)[ROWS * (COLS / 8) / NTHR], const bf16_t* src, size_t ld, int tid) {
    constexpr int CPR = COLS / 8, NI = ROWS * CPR / NTHR;
#pragma unroll
    for (int i = 0; i < NI; ++i) { const int idx = tid + i * NTHR, r = idx / CPR, c = idx % CPR; v[i] = *(const u32x4*)(src + (size_t)r * ld + c * 8); }
}
template <int ROWS, int COLS, int PAD> __device__ __forceinline__ void stage_store(LAS unsigned char* dst, const u32x4 (&v)[ROWS * (COLS / 8) / NTHR], int tid) {
    constexpr int CPR = COLS / 8, NI = ROWS * CPR / NTHR, RS = (COLS + PAD) * 2;
#pragma unroll
    for (int i = 0; i < NI; ++i) { const int idx = tid + i * NTHR, r = idx / CPR, c = idx % CPR; *(LAS u32x4*)(dst + r * RS + c * 16) = v[i]; }
}
__device__ __forceinline__ bf16x8 row_frag(const LAS unsigned char* tile, int RS, int n0, int k0, int lane) {
    return *(const LAS bf16x8*)(tile + (n0 + (lane & 15)) * RS + (k0 + 8 * (lane >> 4)) * 2);
}
__device__ __forceinline__ s16x4 tr4(const LAS unsigned char* p) { return __builtin_bit_cast(s16x4, __builtin_amdgcn_ds_read_tr16_b64_v4i16((LAS v4i16_t*)p)); }
__device__ __forceinline__ bf16x8 tr_frag(const LAS unsigned char* tile, int RS, int k0, int n0, int lane) {
    const int g = lane >> 4, i = lane & 15, q = i >> 2, pp = i & 3;
    const LAS unsigned char* a = tile + (k0 + 8 * g + q) * RS + (n0 + 4 * pp) * 2;
    const s16x4 lo = tr4(a), hi = tr4(a + 4 * RS);
    return (bf16x8){lo[0], lo[1], lo[2], lo[3], hi[0], hi[1], hi[2], hi[3]};
}
#define MFMA16(b, a, c) __builtin_amdgcn_mfma_f32_16x16x32_bf16((b), (a), (c), 0, 0, 0)

enum { RM_PLAIN = 0, RM_GATES = 1, RM_ROUTE = 2, RM_COMBINE = 3 };
struct RowArgs {
    const float* hin; float* hout; const bf16_t* hin16; bf16_t* hout16; const float* gain; bf16_t* hn; float* fout;
    const float* wgate; const float* bgate; float* gates;
    const float* rgw; const float* rgb; const float* rew; const float* reb; unsigned* cnt; int* list; int* tokinfo;
    const bf16_t* yb; const int* tokinfo_in;
    float* rsl;
    const bf16_t* wr;
};
template <int MODE, bool OUTF32, bool HIN16 = false, bool HOUT16 = false>
__device__ __forceinline__ void row_phase(LAS unsigned char* lds, const RowArgs& a, int G) {
    constexpr int NRED = 40, RG = (MODE == RM_ROUTE) ? 4 : 32;
    const int tid = fresh_tid(), lane = tid & 63, wave = __builtin_amdgcn_readfirstlane(tid >> 6);
    LAS float* red = (LAS float*)lds;
    LAS float* rstd_l = (LAS float*)(lds + 40960);
    LAS float* fin = (LAS float*)(lds + 41088);
    LAS int* cntl = (LAS int*)(lds + 46208);
    LAS int* basel = (LAS int*)(lds + 46336);
    const LAS int* tbl = (const LAS int*)(lds + TBL_OFF);
    const f32x4 g4 = *(const f32x4*)(a.gain + 4 * tid);
    for (int rb = fresh_bx(); rb < T / 32; rb += G) {
        const int row0 = rb * 32;
    float wg8[4][8]; float we[4][32]; float wgr[4][4];
    if constexpr (MODE == RM_GATES) {
#pragma unroll
        for (int i = 0; i < 4; ++i) { const f32x4 lo = *(const f32x4*)(a.wgate + (size_t)(4 * tid + i) * EVW + EVN), hi = *(const f32x4*)(a.wgate + (size_t)(4 * tid + i) * EVW + EVN + 4);
#pragma unroll
            for (int o = 0; o < 4; ++o) { wg8[i][o] = lo[o] * g4[i]; wg8[i][4 + o] = hi[o] * g4[i]; } }
    }
    if constexpr (MODE == RM_ROUTE && !HIN16) {
#pragma unroll
        for (int i = 0; i < 4; ++i) {
#pragma unroll
            for (int o4 = 0; o4 < 8; ++o4) { const f32x4 w = *(const f32x4*)(a.rew + (size_t)(4 * tid + i) * NEXP + 4 * o4);
#pragma unroll
                for (int o = 0; o < 4; ++o) we[i][4 * o4 + o] = w[o] * g4[i]; }
            const f32x4 w = *(const f32x4*)(a.rgw + (size_t)(4 * tid + i) * 4);
#pragma unroll
            for (int o = 0; o < 4; ++o) wgr[i][o] = w[o] * g4[i];
        }
    }
        if (MODE == RM_ROUTE && tid < 32) cntl[tid] = 0;
        f32x4 xs[RG];
        if constexpr (MODE == RM_ROUTE && HIN16) {
            const int fr = lane & 15, fq = lane >> 4;
            f32x4 acc[2][3]; float sq[2] = {0.f, 0.f};
#pragma unroll
            for (int mt = 0; mt < 2; ++mt)
#pragma unroll
                for (int nt = 0; nt < 3; ++nt) acc[mt][nt] = (f32x4){0.f, 0.f, 0.f, 0.f};
#pragma unroll 2
            for (int ks = 0; ks < 8; ++ks) { const int k0 = 256 * wave + 32 * ks + 8 * fq;
                bf16x8 af[2], bh[3], bl[3];
#pragma unroll
                for (int mt = 0; mt < 2; ++mt) af[mt] = *(const bf16x8*)(a.hin16 + (size_t)(row0 + 16 * mt + fr) * D + k0);
#pragma unroll
                for (int nt = 0; nt < 3; ++nt) { bh[nt] = *(const bf16x8*)(a.wr + (size_t)(16 * nt + fr) * D + k0); bl[nt] = *(const bf16x8*)(a.wr + (size_t)(48 + 16 * nt + fr) * D + k0); }
#pragma unroll
                for (int mt = 0; mt < 2; ++mt) {
#pragma unroll
                    for (int e = 0; e < 8; ++e) { const float v = bf2f((unsigned short)af[mt][e]); sq[mt] += v * v; }
#pragma unroll
                    for (int nt = 0; nt < 3; ++nt) { acc[mt][nt] = MFMA16(bh[nt], af[mt], acc[mt][nt]); acc[mt][nt] = MFMA16(bl[nt], af[mt], acc[mt][nt]); } }
            }
#pragma unroll
            for (int mt = 0; mt < 2; ++mt) { const int r = 16 * mt + fr;
#pragma unroll
                for (int nt = 0; nt < 3; ++nt)
#pragma unroll
                    for (int i = 0; i < 4; ++i) { const int o = 16 * nt + 4 * fq + i; if (o < 36) red[(r * 8 + wave) * NRED + o] = acc[mt][nt][i]; }
                float s = sq[mt]; s += __shfl_xor(s, 16); s += __shfl_xor(s, 32);
                if (fq == 0) red[(r * 8 + wave) * NRED + 36] = s; }
        } else {
        u32x2 xnext[(MODE == RM_ROUTE && HIN16) ? RG : 1];
        if constexpr (MODE == RM_ROUTE && HIN16) {
#pragma unroll
            for (int i = 0; i < RG; ++i) xnext[i] = *(const u32x2*)(a.hin16 + (size_t)(row0 + i) * D + 4 * tid);
        }
        for (int grp = 0; grp < 32 / RG; ++grp) {
            if constexpr (MODE == RM_ROUTE && HIN16) {
#pragma unroll
                for (int i = 0; i < RG; ++i) xs[i] = (f32x4){bf_lo(xnext[i].x), bf_hi(xnext[i].x), bf_lo(xnext[i].y), bf_hi(xnext[i].y)};
                const int gn = (grp + 1 < 32 / RG) ? grp + 1 : grp;
#pragma unroll
                for (int i = 0; i < RG; ++i) xnext[i] = *(const u32x2*)(a.hin16 + (size_t)(row0 + gn * RG + i) * D + 4 * tid);
            } else {
#pragma unroll
            for (int i = 0; i < RG; ++i) {
                if constexpr (HIN16) { const u32x2 t = *(const u32x2*)(a.hin16 + (size_t)(row0 + grp * RG + i) * D + 4 * tid); xs[i] = (f32x4){bf_lo(t.x), bf_hi(t.x), bf_lo(t.y), bf_hi(t.y)}; }
                else xs[i] = *(const f32x4*)(a.hin + (size_t)(row0 + grp * RG + i) * D + 4 * tid); }
            }
            if constexpr (MODE == RM_COMBINE) {
#pragma unroll
                for (int i = 0; i < RG; ++i) { const int row = row0 + grp * RG + i; const int* ti = a.tokinfo_in + (size_t)row * 8;
                    const int e0 = ti[0], p0 = ti[1], e1 = ti[3], p1 = ti[4]; const float w0 = __builtin_bit_cast(float, ti[2]), w1 = __builtin_bit_cast(float, ti[5]);
                    const size_t s0 = (size_t)tbl[e0] * 256 + p0, s1 = (size_t)tbl[e1] * 256 + p1;
                    const u32x2 y0 = *(const u32x2*)(a.yb + s0 * D + 4 * tid), y1 = *(const u32x2*)(a.yb + s1 * D + 4 * tid);
                    f32x4 x = xs[i];
                    x[0] += w0 * bf_lo(y0.x) + w1 * bf_lo(y1.x); x[1] += w0 * bf_hi(y0.x) + w1 * bf_hi(y1.x);
                    x[2] += w0 * bf_lo(y0.y) + w1 * bf_lo(y1.y); x[3] += w0 * bf_hi(y0.y) + w1 * bf_hi(y1.y);
                    xs[i] = x;
                    if constexpr (HOUT16) { u32x2 w; w.x = cvt_pk_bf16(x[0], x[1]); w.y = cvt_pk_bf16(x[2], x[3]); *(u32x2*)(a.hout16 + (size_t)row * D + 4 * tid) = w; }
                    else *(f32x4*)(a.hout + (size_t)row * D + 4 * tid) = x; }
            }
#pragma unroll
            for (int i = 0; i < RG; ++i) {
                const f32x4 x = xs[i]; const int r = grp * RG + i;
                float ssq[1]; ssq[0] = (x[0] * x[0] + x[1] * x[1]) + (x[2] * x[2] + x[3] * x[3]);
                if constexpr (MODE == RM_GATES) {
                    float v[8];
#pragma unroll
                    for (int o = 0; o < 8; ++o) v[o] = (x[0] * wg8[0][o] + x[1] * wg8[1][o]) + (x[2] * wg8[2][o] + x[3] * wg8[3][o]);
                    const float rv = wave_reduce_pow2<8>(v, lane);
                    if ((lane & 7) == 0) red[(r * 8 + wave) * NRED + (lane >> 3)] = rv;
                }
                if constexpr (MODE == RM_ROUTE) {
                    float v[32];
#pragma unroll
                    for (int o = 0; o < 32; ++o) v[o] = (x[0] * we[0][o] + x[1] * we[1][o]) + (x[2] * we[2][o] + x[3] * we[3][o]);
                    const float rv = wave_reduce_pow2<32>(v, lane);
                    if ((lane & 1) == 0) red[(r * 8 + wave) * NRED + (lane >> 1)] = rv;
                    float u[4];
#pragma unroll
                    for (int o = 0; o < 4; ++o) u[o] = (x[0] * wgr[0][o] + x[1] * wgr[1][o]) + (x[2] * wgr[2][o] + x[3] * wgr[3][o]);
                    const float ru = wave_reduce_pow2<4>(u, lane);
                    if ((lane & 15) == 0) red[(r * 8 + wave) * NRED + 32 + (lane >> 4)] = ru;
                }
                const float rs = wave_reduce_pow2<1>(ssq, lane);
                if (lane == 0) red[(r * 8 + wave) * NRED + 36] = rs;
            }
        }
        }
        __syncthreads();
        int fe0 = 0, fe1 = 0, lp0 = 0, lp1 = 0; float fw0 = 0.f, fw1 = 0.f, frs = 0.f;
        if (tid < 32) {
            const int r = tid, row = row0 + r;
            float s = 0.f;
#pragma unroll
            for (int w = 0; w < 8; ++w) s += red[(r * 8 + w) * NRED + 36];
            const float rstd = rsqrtf(s * (1.0f / D) + EPS);
            rstd_l[r] = rstd; frs = rstd;
            if constexpr (MODE == RM_GATES) {
#pragma unroll
                for (int o = 0; o < 8; ++o) { float d = 0.f;
#pragma unroll
                    for (int w = 0; w < 8; ++w) d += red[(r * 8 + w) * NRED + o];
                    a.gates[(size_t)row * 8 + o] = d * rstd + a.bgate[o]; }
            }
            if constexpr (MODE == RM_ROUTE) {
#pragma unroll
                for (int o = 0; o < 36; ++o) { float d = 0.f;
#pragma unroll
                    for (int w = 0; w < 8; ++w) d += red[(r * 8 + w) * NRED + o];
                    fin[r * NRED + o] = d * rstd + (o < 32 ? a.reb[o] : a.rgb[o - 32]); }
                const float l0 = fin[r * NRED + 32], l1 = fin[r * NRED + 33], l2 = fin[r * NRED + 34], l3 = fin[r * NRED + 35];
                int gsel = 0; float mx = l0;
                if (l1 > mx) { mx = l1; gsel = 1; }
                if (l2 > mx) { mx = l2; gsel = 2; }
                if (l3 > mx) { mx = l3; gsel = 3; }
                const float gp = 1.0f / (expf(l0 - mx) + expf(l1 - mx) + expf(l2 - mx) + expf(l3 - mx));
                float v1 = -INFINITY, v2 = -INFINITY; int i1 = 0, i2 = 0;
                for (int j = 0; j < 8; ++j) { const float v = fin[r * NRED + gsel * 8 + j]; if (v > v1) { v1 = v; i1 = j; } }
                for (int j = 0; j < 8; ++j) { const float v = fin[r * NRED + gsel * 8 + j]; if (j != i1 && v > v2) { v2 = v; i2 = j; } }
                const float e21 = expf(v2 - v1), inv = 1.0f / (1.0f + e21);
                fw0 = gp * inv; fw1 = gp * e21 * inv; fe0 = gsel * 8 + i1; fe1 = gsel * 8 + i2;
                lp0 = atomicAdd((int*)&cntl[fe0], 1); lp1 = atomicAdd((int*)&cntl[fe1], 1);
            }
        }
        __syncthreads();
        if constexpr (MODE == RM_ROUTE) {
            if (tid < 32) { const int c = cntl[tid]; basel[tid] = c ? (int)__hip_atomic_fetch_add(a.cnt + tid * 64, (unsigned)c, __ATOMIC_RELAXED, __HIP_MEMORY_SCOPE_AGENT) : 0; }
            __syncthreads();
            if (tid < 32) { const int row = row0 + tid; const int p0 = basel[fe0] + lp0, p1 = basel[fe1] + lp1;
                a.list[(size_t)fe0 * LISTCAP + p0] = row; a.list[(size_t)fe1 * LISTCAP + p1] = row;
                if constexpr (HIN16) { a.rsl[(size_t)fe0 * LISTCAP + p0] = frs; a.rsl[(size_t)fe1 * LISTCAP + p1] = frs; }
                int* ti = a.tokinfo + (size_t)row * 8;
                ti[0] = fe0; ti[1] = p0; ti[2] = __builtin_bit_cast(int, fw0); ti[3] = fe1; ti[4] = p1; ti[5] = __builtin_bit_cast(int, fw1); ti[6] = 0; ti[7] = 0; }
        }
        constexpr bool SRC16 = (MODE == RM_COMBINE) ? HOUT16 : HIN16;
        const float* src2 = (MODE == RM_COMBINE) ? (const float*)a.hout : a.hin; const bf16_t* src216 = (MODE == RM_COMBINE) ? (const bf16_t*)a.hout16 : a.hin16;
        if constexpr (MODE == RM_ROUTE && HIN16) {
        } else if constexpr (RG == 32) {
            if constexpr (OUTF32) {
#pragma unroll
                for (int i = 0; i < 32; ++i) { const int row = row0 + i; const float rs = rstd_l[i]; const f32x4 y = xs[i] * rs * g4; *(f32x4*)(a.fout + (size_t)row * D + 4 * tid) = y; }
            } else {
#pragma unroll
                for (int i = 0; i < 32; i += 2) { u32x2 ab[2];
#pragma unroll
                    for (int n = 0; n < 2; ++n) { const float rs = rstd_l[i + n]; const f32x4 y = xs[i + n] * rs * g4; ab[n].x = cvt_pk_bf16(y[0], y[1]); ab[n].y = cvt_pk_bf16(y[2], y[3]); }
                    const bool odd = tid & 1; const u32x2 give = odd ? ab[0] : ab[1];
                    u32x2 got; got.x = (unsigned)__shfl_xor((int)give.x, 1); got.y = (unsigned)__shfl_xor((int)give.y, 1);
                    u32x4 w; if (odd) { w.x = got.x; w.y = got.y; w.z = ab[1].x; w.w = ab[1].y; } else { w.x = ab[0].x; w.y = ab[0].y; w.z = got.x; w.w = got.y; }
                    *(u32x4*)(a.hn + (size_t)(row0 + i + (odd ? 1 : 0)) * D + 4 * (tid & ~1)) = w; }
            }
        } else {
        for (int grp = 0; grp < 4; ++grp) {
            f32x4 ys[8];
#pragma unroll
            for (int i = 0; i < 8; ++i) {
                if constexpr (SRC16) { const u32x2 t = *(const u32x2*)(src216 + (size_t)(row0 + grp * 8 + i) * D + 4 * tid); ys[i] = (f32x4){bf_lo(t.x), bf_hi(t.x), bf_lo(t.y), bf_hi(t.y)}; }
                else ys[i] = *(const f32x4*)(src2 + (size_t)(row0 + grp * 8 + i) * D + 4 * tid); }
#pragma unroll
            for (int i = 0; i < 8; ++i) { const int row = row0 + grp * 8 + i; const float rs = rstd_l[grp * 8 + i]; const f32x4 y = ys[i] * rs * g4;
                if constexpr (OUTF32) *(f32x4*)(a.fout + (size_t)row * D + 4 * tid) = y;
                else { u32x2 w; w.x = cvt_pk_bf16(y[0], y[1]); w.y = cvt_pk_bf16(y[2], y[3]); *(u32x2*)(a.hn + (size_t)row * D + 4 * tid) = w; } }
        }
        }
        __syncthreads();
    }
}

template <bool FINAL>
__device__ __forceinline__ void combine_phase(LAS unsigned char* lds, bf16_t* h16, const bf16_t* yb, const int* tokinfo, const float* gain, float* rsout, float* fout, int G) {
    const int tid = fresh_tid(), lane = tid & 63, wave = __builtin_amdgcn_readfirstlane(tid >> 6);
    const LAS int* tbl = (const LAS int*)(lds + TBL_OFF);
    const int gw = fresh_bx() * NWAVES + wave, NGW = G * NWAVES;
    auto ldti = [&](int r, int (&t)[6]) { const int* ti = tokinfo + (size_t)r * 8;
#pragma unroll
        for (int i = 0; i < 6; ++i) t[i] = ti[i]; };
    auto issue = [&](int r, const int (&t)[6], u32x4 (&hv)[4], u32x4 (&y0)[4], u32x4 (&y1)[4]) {
        const size_t s0 = (size_t)tbl[t[0]] * 256 + t[1], s1 = (size_t)tbl[t[3]] * 256 + t[4];
#pragma unroll
        for (int j = 0; j < 4; ++j) { const int col = 8 * lane + 512 * j;
            hv[j] = *(const u32x4*)(h16 + (size_t)r * D + col); y0[j] = *(const u32x4*)(yb + s0 * D + col); y1[j] = *(const u32x4*)(yb + s1 * D + col); } };
    int row = gw;
    if (row < T) {
        int tc[6], tn[6] = {0, 0, 0, 0, 0, 0};
        u32x4 hv[4], y0[4], y1[4], hvn[4], y0n[4], y1n[4];
        ldti(row, tc);
        if (row + NGW < T) ldti(row + NGW, tn);
        issue(row, tc, hv, y0, y1);
#pragma unroll 1
        for (;;) {
            const int rn = row + NGW; const bool more = rn < T;
            int tnn[6] = {0, 0, 0, 0, 0, 0};
            if (more && rn + NGW < T) ldti(rn + NGW, tnn);
            if (more) issue(rn, tn, hvn, y0n, y1n);
            const float w0 = __builtin_bit_cast(float, tc[2]), w1 = __builtin_bit_cast(float, tc[5]);
            float x[4][8]; float ss = 0.f;
#pragma unroll
            for (int j = 0; j < 4; ++j) {
                const unsigned hw[4] = {hv[j].x, hv[j].y, hv[j].z, hv[j].w}, aw[4] = {y0[j].x, y0[j].y, y0[j].z, y0[j].w}, bw[4] = {y1[j].x, y1[j].y, y1[j].z, y1[j].w};
#pragma unroll
                for (int q = 0; q < 4; ++q) { x[j][2 * q] = bf_lo(hw[q]) + w0 * bf_lo(aw[q]) + w1 * bf_lo(bw[q]); x[j][2 * q + 1] = bf_hi(hw[q]) + w0 * bf_hi(aw[q]) + w1 * bf_hi(bw[q]); }
#pragma unroll
                for (int q = 0; q < 8; ++q) ss += x[j][q] * x[j][q];
            }
            const float rs = rsqrtf(wave_sum(ss) * (1.0f / D) + EPS);
#pragma unroll
            for (int j = 0; j < 4; ++j) { const int col = 8 * lane + 512 * j;
                if constexpr (!FINAL) { u32x4 w; w.x = cvt_pk_bf16(x[j][0], x[j][1]); w.y = cvt_pk_bf16(x[j][2], x[j][3]); w.z = cvt_pk_bf16(x[j][4], x[j][5]); w.w = cvt_pk_bf16(x[j][6], x[j][7]);
                    *(u32x4*)(h16 + (size_t)row * D + col) = w; }
                if constexpr (FINAL) { const f32x4 g0 = *(const f32x4*)(gain + col), g1 = *(const f32x4*)(gain + col + 4);
                    const f32x4 a0 = (f32x4){x[j][0], x[j][1], x[j][2], x[j][3]} * rs * g0, a1 = (f32x4){x[j][4], x[j][5], x[j][6], x[j][7]} * rs * g1;
                    *(f32x4*)(fout + (size_t)row * D + col) = a0; *(f32x4*)(fout + (size_t)row * D + col + 4) = a1; }
            }
            if constexpr (!FINAL) { if (lane == 0) rsout[row] = rs; }
            if (!more) break;
            row = rn;
#pragma unroll
            for (int i = 0; i < 6; ++i) { tc[i] = tn[i]; tn[i] = tnn[i]; }
#pragma unroll
            for (int j = 0; j < 4; ++j) { hv[j] = hvn[j]; y0[j] = y0n[j]; y1[j] = y1n[j]; }
        }
    }
}
constexpr int MOE_PT_OFF = 80, MOE_PARTS = 128;
__device__ __forceinline__ void moe_tables(LAS unsigned char* lds, const unsigned* cnt) {
    LAS int* tbl = (LAS int*)(lds + TBL_OFF);
    __syncthreads();
    const int tq = fresh_tid();
    if (tq < 64) {
        const int e = tq & 31; const int c = (tq < 32) ? (int)__hip_atomic_load(cnt + e * 64, __ATOMIC_RELAXED, __HIP_MEMORY_SCOPE_AGENT) : 0;
        const int t256 = (c + 255) >> 8, t16 = (c + 15) >> 4, np = (t16 + 23) / 24;
        int s1 = t256, s2 = np;
#pragma unroll
        for (int d = 1; d < 32; d <<= 1) { const int a = __shfl_up(s1, d), b = __shfl_up(s2, d); if (tq >= d) { s1 += a; s2 += b; } }
        if (tq < 32) { tbl[e] = s1 - t256; tbl[33 + e] = c; tbl[MOE_PT_OFF + e] = s2 - np;
            if (e == 31) { tbl[32] = s1; tbl[MOE_PT_OFF + 32] = s2; }
            const int tpp = np ? (t16 + np - 1) / np : 0;
            for (int p = 0; p < np; ++p) { const int t0 = p * tpp, nt = (t16 - t0) < tpp ? (t16 - t0) : tpp; tbl[MOE_PARTS + (s2 - np) + p] = e | (t0 << 5) | (nt << 15); } }
    }
    __syncthreads();
}
struct Moe1Sched {
    static constexpr bool GATHER = true;
    const LAS int* tbl; const int* list; const char* xn; const char* wg; const char* wu; char* hid; int G, c;
    __device__ __forceinline__ bool next(int i, pg8::Unit& u) const {
        const int MT = __builtin_amdgcn_readfirstlane(tbl[32]); const int U = MT * 8; const long L = (long)i * G + c; if (L >= U) return false;
        int wgid = (int)L; { const int q = U / 8, r = U % 8, xcd = wgid % 8, off = wgid / 8; wgid = (xcd < r ? xcd * (q + 1) : r * (q + 1) + (xcd - r) * q) + off; }
        const int mtg = wgid >> 3, nt = wgid & 7; int e = 0;
        for (int k = 1; k < 32; ++k) e += (__builtin_amdgcn_readfirstlane(tbl[k]) <= mtg) ? 1 : 0;
        e = __builtin_amdgcn_readfirstlane(e);
        const int ml = mtg - __builtin_amdgcn_readfirstlane(tbl[e]);
        u.a = xn; u.b0 = wg + (size_t)e * WEXP_ONE + (size_t)nt * (128 * D * 2); u.b1 = wu + (size_t)e * WEXP_ONE + (size_t)nt * (128 * D * 2);
        u.out = hid; u.ldc = DEXP; u.pm = mtg; u.pn = nt; u.e = e | (ml << 8); return true;
    }
    __device__ __forceinline__ int arow(const pg8::Unit& u, int r) const {
        const int e = u.e & 255, ml = u.e >> 8; const int cntv = __builtin_amdgcn_readfirstlane(tbl[33 + e]); int idx = ml * 256 + r; idx = idx < cntv ? idx : 0;
        return list[(size_t)e * LISTCAP + idx];
    }
};
struct Moe2Sched {
    static constexpr bool GATHER = false;
    const LAS int* tbl; const char* hid; const char* wd; char* yb; int G, c;
    __device__ __forceinline__ bool next(int i, pg8::Unit& u) const {
        const int MT = __builtin_amdgcn_readfirstlane(tbl[32]); const int U = MT * 8; const long L = (long)i * G + c; if (L >= U) return false;
        int wgid = (int)L; { const int q = U / 8, r = U % 8, xcd = wgid % 8, off = wgid / 8; wgid = (xcd < r ? xcd * (q + 1) : r * (q + 1) + (xcd - r) * q) + off; }
        const int mtg = wgid >> 3, pn = wgid & 7; int e = 0;
        for (int k = 1; k < 32; ++k) e += (__builtin_amdgcn_readfirstlane(tbl[k]) <= mtg) ? 1 : 0;
        e = __builtin_amdgcn_readfirstlane(e);
        u.a = hid + (size_t)mtg * (256 * DEXP * 2); u.b0 = wd + (size_t)e * WEXP_ONE + (size_t)pn * (256 * DEXP * 2); u.b1 = u.b0 + (size_t)128 * DEXP * 2;
        u.out = yb; u.ldc = D; u.pm = mtg; u.pn = pn; u.e = e; return true;
    }
    __device__ __forceinline__ int arow(const pg8::Unit&, int r) const { return r; }
};
struct KVSched {
    static constexpr bool GATHER = false;
    const char* memn; const char* wk; const char* wv; char* kx; char* vx; int G, c;
    __device__ __forceinline__ bool next(int i, pg8::Unit& u) const {
        const int j = ((c + G - (G >> 1)) % G) + i * G; if (j >= 32) return false;
        const int l = j >> 4, kv = (j >> 3) & 1, idx = j & 7;
        u.a = memn + (size_t)l * (NMEM * D * 2);
        const char* wb = (kv ? wv : wk) + (size_t)l * ((size_t)D * D * 2) + (size_t)idx * (256 * D * 2);
        u.b0 = wb; u.b1 = wb + (size_t)128 * D * 2; u.out = (kv ? vx : kx) + (size_t)l * (NMEM * D * 2); u.ldc = D; u.pm = 0; u.pn = idx; u.e = 0; return true;
    }
    __device__ __forceinline__ int arow(const pg8::Unit&, int r) const { return r; }
};

__device__ __forceinline__ void mlstm_prep(LAS unsigned char* lds, int h, const float* gates, float* bcum, float* gi, float* marr, float* aprev, float* blg) {
    const int tid = fresh_tid(), lane = tid & 63, wave = tid >> 6;
    LAS float* bl = (LAS float*)lds; LAS float* dm = bl + 64;
    for (int c = wave; c < NCH; c += NWAVES) {
        const int t = c * CH + 2 * lane;
        const float i0 = gates[(size_t)t * 8 + h], i1 = gates[(size_t)(t + 1) * 8 + h], f0 = gates[(size_t)t * 8 + 4 + h], f1 = gates[(size_t)(t + 1) * 8 + 4 + h];
        const float l0 = logsigf(f0), l1 = logsigf(f1);
        float p = l0 + l1;
#pragma unroll
        for (int o = 1; o < 64; o <<= 1) { const float n = __shfl_up(p, o); if (lane >= o) p += n; }
        const float bc1 = p, bc0 = p - l1, blast = __shfl(p, 63);
        bcum[(size_t)t * 4 + h] = bc0; bcum[(size_t)(t + 1) * 4 + h] = bc1;
        gi[(size_t)t * 4 + h] = i0 - bc0; gi[(size_t)(t + 1) * 4 + h] = i1 - bc1;
        const float d = wave_max(fmaxf(blast - bc0 + i0, blast - bc1 + i1));
        if (lane == 0) { bl[c] = blast; dm[c] = d; }
    }
    __syncthreads();
    if (tid == 0) {
        float m = 0.f;
        for (int c = 0; c < NCH; ++c) { marr[h * 65 + c] = m; const float b = bl[c], mn = fmaxf(b + m, dm[c]); aprev[h * 64 + c] = expf(b + m - mn); blg[h * 64 + c] = b; m = mn; }
        marr[h * 65 + NCH] = m;
    }
    __syncthreads();
}

__device__ __forceinline__ void mlstm_B(LAS unsigned char* lds, int c, int h, const bf16_t* Z, const float* gi, const float* marr, const float* blg, float* KC, float* KN) {
    constexpr int RS = (DH + 16) * 2;
    const int tid = fresh_tid(), lane = tid & 63, wave = __builtin_amdgcn_readfirstlane(tid >> 6), fr = lane & 15, fq = lane >> 4;
    LAS unsigned char* Vt = lds; LAS unsigned char* Kt = lds + CH * RS; LAS float* asc = (LAS float*)(lds + 2 * CH * RS);
    const int t0 = c * CH;
    __syncthreads();
    if (tid < CH) asc[tid] = expf(blg[h * 64 + c] + gi[(size_t)(t0 + tid) * 4 + h] - marr[h * 65 + c + 1]);
    __syncthreads();
    stage_tile<CH, DH, 16>(Vt, Z + (size_t)t0 * EVN + 3072 + h * DH, EVN, tid);
    {
        u32x4 v[8];
#pragma unroll
        for (int i = 0; i < 8; ++i) { const int idx = tid + i * NTHR, r = idx >> 5, cc = idx & 31; v[i] = *(const u32x4*)(Z + (size_t)(t0 + r) * EVN + 2048 + h * DH + cc * 8); }
#pragma unroll
        for (int i = 0; i < 8; ++i) { const int idx = tid + i * NTHR, r = idx >> 5, cc = idx & 31; const float s = asc[r]; u32x4 o;
            o.x = cvt_pk_bf16(bf_lo(v[i].x) * s, bf_hi(v[i].x) * s); o.y = cvt_pk_bf16(bf_lo(v[i].y) * s, bf_hi(v[i].y) * s);
            o.z = cvt_pk_bf16(bf_lo(v[i].z) * s, bf_hi(v[i].z) * s); o.w = cvt_pk_bf16(bf_lo(v[i].w) * s, bf_hi(v[i].w) * s);
            *(LAS u32x4*)(Kt + r * RS + cc * 16) = o; }
    }
    __syncthreads();
    const int wr2 = wave >> 2, wc2 = wave & 3;
    f32x4 acc[8][4];
#pragma unroll
    for (int mi = 0; mi < 8; ++mi)
#pragma unroll
        for (int nj = 0; nj < 4; ++nj) acc[mi][nj] = (f32x4){0.f, 0.f, 0.f, 0.f};
#pragma unroll
    for (int ks = 0; ks < 4; ++ks) {
        bf16x8 bk[4];
#pragma unroll
        for (int nj = 0; nj < 4; ++nj) bk[nj] = tr_frag(Kt, RS, 32 * ks, 64 * wc2 + 16 * nj, lane);
#pragma unroll
        for (int mi = 0; mi < 8; ++mi) { const bf16x8 av = tr_frag(Vt, RS, 32 * ks, 128 * wr2 + 16 * mi, lane);
#pragma unroll
            for (int nj = 0; nj < 4; ++nj) acc[mi][nj] = MFMA16(bk[nj], av, acc[mi][nj]); }
    }
#define ACC8(m) "+v"(acc[m][0]), "+v"(acc[m][1]), "+v"(acc[m][2]), "+v"(acc[m][3]), "+v"(acc[m + 1][0]), "+v"(acc[m + 1][1]), "+v"(acc[m + 1][2]), "+v"(acc[m + 1][3])
    asm volatile("s_nop 0" : ACC8(0), ACC8(2)); asm volatile("s_nop 0" : ACC8(4), ACC8(6));
    asm volatile("s_nop 7\n\ts_nop 7\n\ts_nop 7" : ACC8(0), ACC8(2)); asm volatile("s_nop 0" : ACC8(4), ACC8(6));
#undef ACC8
    bf16_t* kc = (bf16_t*)KC + (size_t)(c * NH + h) * DH * DH;
#pragma unroll
    for (int mi = 0; mi < 8; ++mi)
#pragma unroll
        for (int nj = 0; nj < 4; ++nj) { u32x2 w; w.x = cvt_pk_bf16(acc[mi][nj][0], acc[mi][nj][1]); w.y = cvt_pk_bf16(acc[mi][nj][2], acc[mi][nj][3]);
            *(u32x2*)(kc + (size_t)(128 * wr2 + 16 * mi + fr) * DH + 64 * wc2 + 16 * nj + 4 * fq) = w; }
    if (tid < DH) { float s = 0.f; for (int r = 0; r < CH; ++r) s += bf2f(*(const LAS unsigned short*)(Kt + r * RS + tid * 2)); KN[(size_t)(c * NH + h) * DH + tid] = s; }
}

__device__ __forceinline__ void mlstm_scan(const float* KC, const float* KN, const float* aprev, bf16_t* CST, float* NST, int G) {
    const int gid = fresh_bx() * NTHR + fresh_tid(), NT = G * NTHR;
    for (int p = gid; p < NH * DH * DH / 2; p += NT) {
        const int h = p / (DH * DH / 2); const size_t e2 = (size_t)(p % (DH * DH / 2)) * 2;
        float s0 = 0.f, s1 = 0.f;
#pragma unroll 1
        for (int c0 = 0; c0 < NCH; c0 += 32) {
            unsigned k[32]; float ap[32];
#pragma unroll
            for (int j = 0; j < 32; ++j) { k[j] = *(const unsigned*)((const bf16_t*)KC + (size_t)((c0 + j) * NH + h) * DH * DH + e2); ap[j] = aprev[h * 64 + c0 + j]; }
#pragma unroll
            for (int j = 0; j < 32; ++j) { const size_t o = (size_t)((c0 + j) * NH + h) * DH * DH + e2;
                *(unsigned*)(CST + o) = cvt_pk_bf16(s0, s1);
                s0 = ap[j] * s0 + bf_lo(k[j]); s1 = ap[j] * s1 + bf_hi(k[j]); }
        }
    }
    for (int p = gid; p < NH * DH; p += NT) {
        const int h = p / DH, dk = p % DH; float s = 0.f;
#pragma unroll 1
        for (int c0 = 0; c0 < NCH; c0 += 32) {
            float kn[32], ap[32];
#pragma unroll
            for (int j = 0; j < 32; ++j) { kn[j] = KN[(size_t)((c0 + j) * NH + h) * DH + dk]; ap[j] = aprev[h * 64 + c0 + j]; }
#pragma unroll
            for (int j = 0; j < 32; ++j) { NST[(size_t)((c0 + j) * NH + h) * DH + dk] = s; s = ap[j] * s + kn[j]; }
        }
    }
}

__device__ __forceinline__ void mlstm_D(LAS unsigned char* lds, int c, int h, const bf16_t* Z, const float* gi, const float* bcum, const float* marr, const bf16_t* CST, const float* NST,
                                        const float* hgain, bf16_t* YCAT) {
    constexpr int XOFF = 0, XBYTES = 69632, POFF = XBYTES, PRS = (CH + 8) * 2, SOFF = POFF + 8 * 16 * PRS;
    const int tid = fresh_tid(), lane = tid & 63, wave = __builtin_amdgcn_readfirstlane(tid >> 6), fr = lane & 15, fq = lane >> 4;
    LAS unsigned char* X = lds + XOFF; LAS unsigned char* Pw = lds + POFF + wave * 16 * PRS;
    LAS float* gS = (LAS float*)(lds + SOFF); LAS float* Mrow = gS + CH; LAS float* nst = Mrow + CH;
    const int t0 = c * CH; const float mc = marr[h * 65 + c];
    __syncthreads();
    if (tid < CH) gS[tid] = gi[(size_t)(t0 + tid) * 4 + h];
    else if (tid < CH + DH) nst[tid - CH] = NST[(size_t)(c * NH + h) * DH + (tid - CH)];
    __syncthreads();
    if (tid < CH) { float m = mc; for (int s = 0; s <= tid; ++s) m = fmaxf(m, gS[s]); Mrow[tid] = m; }
    stage_tile<CH, DH, 8>(X, Z + (size_t)t0 * EVN + 2048 + h * DH, EVN, tid);
    const int tl = 16 * wave + fr; const size_t trow = (size_t)(t0 + tl);
    bf16x8 aq[8];
#pragma unroll
    for (int ks = 0; ks < 8; ++ks) aq[ks] = *(const bf16x8*)(Z + trow * EVN + 1024 + h * DH + 32 * ks + 8 * fq);
    __syncthreads();
    f32x4 S[8];
#pragma unroll
    for (int j = 0; j < 8; ++j) S[j] = (f32x4){0.f, 0.f, 0.f, 0.f};
#pragma unroll
    for (int ks = 0; ks < 8; ++ks)
        {
#pragma unroll
          for (int j = 0; j < 8; ++j) if (j <= wave) S[j] = MFMA16(row_frag(X, (DH + 8) * 2, 16 * j, 32 * ks, lane), aq[ks], S[j]);
          asm volatile("" ::: "memory"); }
    float nq = 0.f;
#pragma unroll
    for (int ks = 0; ks < 8; ++ks)
#pragma unroll
        for (int e = 0; e < 8; ++e) nq += bf2f((unsigned short)aq[ks][e]) * nst[32 * ks + 8 * fq + e];
    nq += __shfl_xor(nq, 16); nq += __shfl_xor(nq, 32);
    const float Mt = Mrow[tl]; const float SC = 0.0625f; const float wi = expf(mc - Mt) * SC;
    float rsum = 0.f;
#pragma unroll
    for (int j = 0; j < 8; ++j) { float pv[4];
#pragma unroll
        for (int i = 0; i < 4; ++i) { const int s = 16 * j + 4 * fq + i; const float p = (s <= tl) ? S[j][i] * SC * expf(gS[s] - Mt) : 0.f; pv[i] = p; rsum += p; }
        u32x2 w; w.x = cvt_pk_bf16(pv[0], pv[1]); w.y = cvt_pk_bf16(pv[2], pv[3]);
        *(LAS u32x2*)(Pw + fr * PRS + (16 * j + 4 * fq) * 2) = w; }
    rsum += __shfl_xor(rsum, 16); rsum += __shfl_xor(rsum, 32);
    const float den = wi * nq + rsum;
    f32x4 acc[16];
#pragma unroll
    for (int j = 0; j < 16; ++j) acc[j] = (f32x4){0.f, 0.f, 0.f, 0.f};
    const bf16_t* cst = CST + (size_t)(c * NH + h) * DH * DH;
#pragma unroll
    for (int half = 0; half < 2; ++half) {
        __syncthreads();
        stage_tile<DH, 128, 8>(X, cst + half * 128, DH, tid);
        __syncthreads();
#pragma unroll
        for (int ks = 0; ks < 4; ++ks)
            { const bf16x8 aqh = *(const bf16x8*)(Z + trow * EVN + 1024 + h * DH + 32 * (half * 4 + ks) + 8 * fq);
#pragma unroll
              for (int j = 0; j < 16; ++j) acc[j] = MFMA16(row_frag(X, (128 + 8) * 2, 16 * j, 32 * ks, lane), aqh, acc[j]);
              asm volatile("" ::: "memory"); }
    }
#pragma unroll
    for (int j = 0; j < 16; ++j) acc[j] = acc[j] * wi;
    __syncthreads();
    stage_tile<CH, DH, 16>(X, Z + (size_t)t0 * EVN + 3072 + h * DH, EVN, tid);
    __syncthreads();
#pragma unroll 1
    for (int ks = 0; ks < 4; ++ks) { const bf16x8 ap = *(const LAS bf16x8*)(Pw + fr * PRS + (32 * ks + 8 * fq) * 2);
#pragma unroll
        for (int j = 0; j < 16; ++j) acc[j] = MFMA16(tr_frag(X, (DH + 16) * 2, 32 * ks, 16 * j, lane), ap, acc[j]); }
    const float mt = bcum[trow * 4 + h] + Mt; const float inv = 1.0f / fmaxf(fabsf(den), expf(-mt));
    float ss = 0.f;
#pragma unroll
    for (int j = 0; j < 16; ++j) { acc[j] = acc[j] * inv; ss += (acc[j][0] * acc[j][0] + acc[j][1] * acc[j][1]) + (acc[j][2] * acc[j][2] + acc[j][3] * acc[j][3]); }
    ss += __shfl_xor(ss, 16); ss += __shfl_xor(ss, 32);
    const float rs = rsqrtf(ss * (1.0f / DH) + EPS);
#pragma unroll
    for (int j = 0; j < 16; j += 2) { u32x2 ab[2];
#pragma unroll
        for (int n = 0; n < 2; ++n) { const int col = h * DH + 16 * (j + n) + 4 * fq;
            const f32x4 gn = *(const f32x4*)(hgain + col); const u32x2 ov = *(const u32x2*)(Z + trow * EVN + 4096 + col);
            const float o0 = bf_lo(ov.x), o1 = bf_hi(ov.x), o2 = bf_lo(ov.y), o3 = bf_hi(ov.y);
            const float y0 = acc[j + n][0] * rs * gn[0] / (1.0f + expf(-o0)), y1 = acc[j + n][1] * rs * gn[1] / (1.0f + expf(-o1));
            const float y2 = acc[j + n][2] * rs * gn[2] / (1.0f + expf(-o2)), y3 = acc[j + n][3] * rs * gn[3] / (1.0f + expf(-o3));
            ab[n].x = cvt_pk_bf16(y0, y1); ab[n].y = cvt_pk_bf16(y2, y3); }
        const bool odd = fq & 1; const u32x2 give = odd ? ab[0] : ab[1];
        u32x2 got; got.x = (unsigned)__shfl_xor((int)give.x, 16); got.y = (unsigned)__shfl_xor((int)give.y, 16);
        u32x4 w; if (odd) { w.x = got.x; w.y = got.y; w.z = ab[1].x; w.w = ab[1].y; } else { w.x = ab[0].x; w.y = ab[0].y; w.z = got.x; w.w = got.y; }
        *(u32x4*)(YCAT + trow * D + 1024 + h * DH + 16 * (j + (odd ? 1 : 0)) + 4 * (fq & 2)) = w; if ((j & 3) == 2) asm volatile("" ::: "memory"); }
}

__device__ __forceinline__ void pool_diffs(const bf16_t* Z, bf16_t* DP, int G) {
    const int gid = fresh_bx() * NTHR + fresh_tid(), NT = G * NTHR;
    for (int it = gid; it < T * 128; it += NT) {
        const int t = it >> 7, col = (it & 127) * 8, w = 2 << (col >> 8), cnt = (t + 1 < w) ? t + 1 : w;
        u32x4 v[16];
#pragma unroll
        for (int k = 0; k < 16; ++k) v[k] = (k < cnt) ? *(const u32x4*)(Z + (size_t)(t - k) * EVN + col) : (u32x4){0u, 0u, 0u, 0u};
        float s[8];
#pragma unroll
        for (int e = 0; e < 8; ++e) s[e] = 0.f;
#pragma unroll
        for (int k = 0; k < 16; ++k) { s[0] += bf_lo(v[k].x); s[1] += bf_hi(v[k].x); s[2] += bf_lo(v[k].y); s[3] += bf_hi(v[k].y); s[4] += bf_lo(v[k].z); s[5] += bf_hi(v[k].z); s[6] += bf_lo(v[k].w); s[7] += bf_hi(v[k].w); }
        const float ic = 1.0f / (float)cnt; u32x4 o; const u32x4 c0 = v[0];
        o.x = cvt_pk_bf16(s[0] * ic - bf_lo(c0.x), s[1] * ic - bf_hi(c0.x)); o.y = cvt_pk_bf16(s[2] * ic - bf_lo(c0.y), s[3] * ic - bf_hi(c0.y));
        o.z = cvt_pk_bf16(s[4] * ic - bf_lo(c0.z), s[5] * ic - bf_hi(c0.z)); o.w = cvt_pk_bf16(s[6] * ic - bf_lo(c0.w), s[7] * ic - bf_hi(c0.w));
        *(u32x4*)(DP + (size_t)t * 1024 + col) = o;
    }
}
__device__ __forceinline__ void conv_gate(const bf16_t* ZB, const bf16_t* ZC, const float* cw, bf16_t* Y, int G) {
    const int gid = fresh_bx() * NTHR + fresh_tid(), NT = G * NTHR;
    for (int it = gid; it < T * 256; it += NT) {
        const int t = it >> 8, col = (it & 255) * 8; const size_t o = (size_t)t * D + col;
        const u32x4 z0 = *(const u32x4*)(ZC + o), gb = *(const u32x4*)(ZB + o);
        const u32x4 z1 = (t >= 1) ? *(const u32x4*)(ZC + o - D) : (u32x4){0u, 0u, 0u, 0u}, z2 = (t >= 2) ? *(const u32x4*)(ZC + o - 2 * D) : (u32x4){0u, 0u, 0u, 0u};
        const f32x4 wa0 = *(const f32x4*)(cw + col), wa1 = *(const f32x4*)(cw + col + 4), wb0 = *(const f32x4*)(cw + D + col), wb1 = *(const f32x4*)(cw + D + col + 4),
                    wc0 = *(const f32x4*)(cw + 2 * D + col), wc1 = *(const f32x4*)(cw + 2 * D + col + 4);
        float r[8];
        r[0] = bf_lo(gb.x) * (wa0[0] * bf_lo(z2.x) + wb0[0] * bf_lo(z1.x) + wc0[0] * bf_lo(z0.x)); r[1] = bf_hi(gb.x) * (wa0[1] * bf_hi(z2.x) + wb0[1] * bf_hi(z1.x) + wc0[1] * bf_hi(z0.x));
        r[2] = bf_lo(gb.y) * (wa0[2] * bf_lo(z2.y) + wb0[2] * bf_lo(z1.y) + wc0[2] * bf_lo(z0.y)); r[3] = bf_hi(gb.y) * (wa0[3] * bf_hi(z2.y) + wb0[3] * bf_hi(z1.y) + wc0[3] * bf_hi(z0.y));
        r[4] = bf_lo(gb.z) * (wa1[0] * bf_lo(z2.z) + wb1[0] * bf_lo(z1.z) + wc1[0] * bf_lo(z0.z)); r[5] = bf_hi(gb.z) * (wa1[1] * bf_hi(z2.z) + wb1[1] * bf_hi(z1.z) + wc1[1] * bf_hi(z0.z));
        r[6] = bf_lo(gb.w) * (wa1[2] * bf_lo(z2.w) + wb1[2] * bf_lo(z1.w) + wc1[2] * bf_lo(z0.w)); r[7] = bf_hi(gb.w) * (wa1[3] * bf_hi(z2.w) + wb1[3] * bf_hi(z1.w) + wc1[3] * bf_hi(z0.w));
        u32x4 w; w.x = cvt_pk_bf16(r[0], r[1]); w.y = cvt_pk_bf16(r[2], r[3]); w.z = cvt_pk_bf16(r[4], r[5]); w.w = cvt_pk_bf16(r[6], r[7]);
        *(u32x4*)(Y + o) = w;
    }
}

__device__ __forceinline__ void xattn_unit(LAS unsigned char* lds, int hd, int qt, const bf16_t* QX, const bf16_t* KX, const bf16_t* VX, bf16_t* O) {
    constexpr int XBYTES = 73728, PRS = (NMEM + 8) * 2;
    const int tid = fresh_tid(), lane = tid & 63, wave = __builtin_amdgcn_readfirstlane(tid >> 6), fr = lane & 15, fq = lane >> 4;
    LAS unsigned char* X = lds; LAS unsigned char* Pw = lds + XBYTES + wave * 16 * PRS;
    const size_t trow = (size_t)qt * 128 + 16 * wave + fr;
    f32x4 S[16];
#pragma unroll
    for (int j = 0; j < 16; ++j) S[j] = (f32x4){0.f, 0.f, 0.f, 0.f};
    u32x4 pf[8];
    stage_load<NMEM, 128>(pf, KX + hd * XD, D, tid);
#pragma unroll 1
    for (int kc = 0; kc < 4; ++kc) {
        __syncthreads();
        stage_store<NMEM, 128, 8>(X, pf, tid);
        bf16x8 aq[4];
#pragma unroll
        for (int ks = 0; ks < 4; ++ks) aq[ks] = *(const bf16x8*)(QX + trow * D + hd * XD + kc * 128 + 32 * ks + 8 * fq);
        if (kc < 3) stage_load<NMEM, 128>(pf, KX + hd * XD + (kc + 1) * 128, D, tid);
        __syncthreads();
#pragma unroll
        for (int ks = 0; ks < 4; ++ks)
#pragma unroll
            for (int j = 0; j < 16; ++j) S[j] = MFMA16(row_frag(X, (128 + 8) * 2, 16 * j, 32 * ks, lane), aq[ks], S[j]);
    }
    float mx = -INFINITY;
#pragma unroll
    for (int j = 0; j < 16; ++j) mx = fmaxf(mx, fmaxf(fmaxf(S[j][0], S[j][1]), fmaxf(S[j][2], S[j][3])));
    mx = fmaxf(mx, __shfl_xor(mx, 16)); mx = fmaxf(mx, __shfl_xor(mx, 32));
    const float SC = 0.044194173824159216f;
    float sum = 0.f;
#pragma unroll
    for (int j = 0; j < 16; ++j) { float pv[4];
#pragma unroll
        for (int i = 0; i < 4; ++i) { pv[i] = __expf((S[j][i] - mx) * SC); sum += pv[i]; }
        u32x2 w; w.x = cvt_pk_bf16(pv[0], pv[1]); w.y = cvt_pk_bf16(pv[2], pv[3]);
        *(LAS u32x2*)(Pw + fr * PRS + (16 * j + 4 * fq) * 2) = w; }
    sum += __shfl_xor(sum, 16); sum += __shfl_xor(sum, 32);
    const float inv = 1.0f / sum;
    asm volatile("s_waitcnt lgkmcnt(0)" ::: "memory");
    stage_load<NMEM, 128>(pf, VX + hd * XD, D, tid);
    bf16x8 ap[8];
#pragma unroll
    for (int ks = 0; ks < 8; ++ks) ap[ks] = *(const LAS bf16x8*)(Pw + fr * PRS + (32 * ks + 8 * fq) * 2);
#pragma unroll 1
    for (int vc = 0; vc < 4; ++vc) {
        __syncthreads();
        stage_store<NMEM, 128, 16>(X, pf, tid);
        if (vc < 3) stage_load<NMEM, 128>(pf, VX + hd * XD + (vc + 1) * 128, D, tid);
        __syncthreads();
        f32x4 oa[8];
#pragma unroll
        for (int j = 0; j < 8; ++j) oa[j] = (f32x4){0.f, 0.f, 0.f, 0.f};
#pragma unroll
        for (int ks = 0; ks < 8; ++ks)
#pragma unroll
            for (int j = 0; j < 8; ++j) oa[j] = MFMA16(tr_frag(X, (128 + 16) * 2, 32 * ks, 16 * j, lane), ap[ks], oa[j]);
#pragma unroll
        for (int j = 0; j < 8; j += 2) { u32x2 a, b; a.x = cvt_pk_bf16(oa[j][0] * inv, oa[j][1] * inv); a.y = cvt_pk_bf16(oa[j][2] * inv, oa[j][3] * inv);
            b.x = cvt_pk_bf16(oa[j + 1][0] * inv, oa[j + 1][1] * inv); b.y = cvt_pk_bf16(oa[j + 1][2] * inv, oa[j + 1][3] * inv);
            const bool odd = fq & 1; const u32x2 give = odd ? a : b;
            u32x2 got; got.x = (unsigned)__shfl_xor((int)give.x, 16); got.y = (unsigned)__shfl_xor((int)give.y, 16);
            u32x4 w; if (odd) { w.x = got.x; w.y = got.y; w.z = b.x; w.w = b.y; } else { w.x = a.x; w.y = a.y; w.z = got.x; w.w = got.y; }
            *(u32x4*)(O + trow * D + hd * XD + vc * 128 + 16 * (j + (odd ? 1 : 0)) + 4 * (fq & 2)) = w; }
    }
}

__device__ __forceinline__ float vec_elem_f32(u32x4 v, int j) { const unsigned u = v[j]; return __builtin_bit_cast(float, u); }
__device__ __forceinline__ void glds4(const char* base, unsigned voff, unsigned lds_dst) {
    unsigned keep;
    asm volatile("s_mov_b32 %0, m0\n\ts_mov_b32 m0, %3\n\ts_nop 0\n\tglobal_load_lds_dword %1, %2\n\ts_mov_b32 m0, %0" : "=&s"(keep) : "v"(voff), "s"(base), "s"(lds_dst) : "memory");
}
struct MoeDesc { int valid, e, sl, t0, nt, cnt, slot0; const char* Ab; bf16_t* out; const float* W0; const float* W1; };
template <int MODE, int NMT, int ABL>
__device__ __forceinline__ void moe_unit(LAS unsigned char* lds, const char* Abase, u32x4 wrsrc, unsigned wsoff, int bvoff, const unsigned (&voff)[6], unsigned asb, bf16_t* out, int w, int fr, int fq, int bwoff, int bsw,
                                         const LAS unsigned char* pa0, const LAS unsigned char* pa1, const LAS unsigned char* pb0, const LAS unsigned char* pb1,
                                         int t0, int cnt, int slot0, int sl,
                                         bool pre, u32x4 (&bst)[2][4], u32x4 wrsrc_n, unsigned wsoff_n, const char* Abase_n, const LAS int* stash, unsigned kco0, unsigned kco1, const LAS float* gtab, const LAS float* rstash) {
    constexpr int K = (MODE == 2) ? DEXP : D, KS = K / 64, LDA = K, NW = (MODE == 1) ? DEXP : D, LDO = (MODE == 1) ? DEXP : D;
    constexpr int BS_OFF = 0, AS_OFF = 32768, AW = 6144;
        f32x4 acc[NMT][8];
#pragma unroll
        for (int mi = 0; mi < NMT; ++mi)
#pragma unroll
            for (int j = 0; j < 8; ++j) acc[mi][j] = (f32x4){0.f, 0.f, 0.f, 0.f};
        constexpr unsigned BSTEP = 64u * NW * 4u;
#define MOE_LOADB(set, rs, so) do { if constexpr (ABL == 2) break; const unsigned _so = (so); _Pragma("unroll") for (int kk = 0; kk < 4; ++kk) \
            asm volatile("buffer_load_dwordx4 %0, %1, %2, %3 offen" : "=v"(bst[set][kk]) : "v"(bvoff), "s"(rs), "s"(_so + (unsigned)kk * (NW * 4u)) : "memory"); } while (0)
#define MOE_WAITB(set, n) asm volatile("s_waitcnt vmcnt(%4)" : "+v"(bst[set][0]), "+v"(bst[set][1]), "+v"(bst[set][2]), "+v"(bst[set][3]) : "n"(n) : "memory")
#define MOE_DMAA(buf, step) do { if constexpr (ABL == 2) break; _Pragma("unroll") for (int q = 0; q < 2 * NMT; ++q) glds16(Abase + (size_t)(step) * 128, voff[q], asb + (unsigned)(buf) * (8 * AW) + (unsigned)q * 1024u); } while (0)
#define MOE_WRITEB(set, buf, step) do { LAS unsigned char* _b = lds + BS_OFF + (buf) * 16384; \
        if constexpr (MODE == 1) { const f32x4 _g = *(const LAS f32x4*)(gtab + (step) * 64);     \
            _Pragma("unroll") for (int j = 0; j < 4; ++j) { u32x2 o; \
                o.x = cvt_pk_bf16(vec_elem_f32(bst[set][0], j) * _g[0], vec_elem_f32(bst[set][1], j) * _g[1]); o.y = cvt_pk_bf16(vec_elem_f32(bst[set][2], j) * _g[2], vec_elem_f32(bst[set][3], j) * _g[3]); \
                *(LAS u32x2*)(_b + bwoff + j * 128 + (((bsw) ^ (((j) >> 1) & 1)) * 16)) = o; } \
        } else { \
        _Pragma("unroll") for (int j = 0; j < 4; ++j) { u32x2 o; \
            o.x = cvt_pk_bf16(vec_elem_f32(bst[set][0], j), vec_elem_f32(bst[set][1], j)); o.y = cvt_pk_bf16(vec_elem_f32(bst[set][2], j), vec_elem_f32(bst[set][3], j)); \
            *(LAS u32x2*)(_b + bwoff + j * 128 + (((bsw) ^ (((j) >> 1) & 1)) * 16)) = o; } } } while (0)
#define MOE_COMPUTE(buf) do { if constexpr (ABL == 1) break; \
        _Pragma("unroll") for (int ks = 0; ks < 2; ++ks) { bf16x8 af[NMT]; const LAS unsigned char* _pa = (ks ? pa1 : pa0) + (buf) * (8 * AW); const LAS unsigned char* _pb = (ks ? pb1 : pb0) + (buf) * 16384; \
            _Pragma("unroll") for (int mi = 0; mi < NMT; ++mi) af[mi] = *(const LAS bf16x8*)(_pa + mi * 2048); \
            _Pragma("unroll") for (int j = 0; j < 8; ++j) { const bf16x8 bf = *(const LAS bf16x8*)(_pb + j * 2048); \
                _Pragma("unroll") for (int mi = 0; mi < NMT; ++mi) acc[mi][j] = MFMA16(bf, af[mi], acc[mi][j]); } } } while (0)
        if (!pre) {
            __syncthreads();
            MOE_LOADB(0, wrsrc, wsoff); MOE_LOADB(1, wrsrc, wsoff + BSTEP); MOE_DMAA(0, 0);
            asm volatile("s_waitcnt vmcnt(0)" : "+v"(bst[0][0]), "+v"(bst[0][1]), "+v"(bst[0][2]), "+v"(bst[0][3]), "+v"(bst[1][0]), "+v"(bst[1][1]), "+v"(bst[1][2]), "+v"(bst[1][3]) :: "memory");
            MOE_WRITEB(0, 0, 0);
            asm volatile("s_waitcnt lgkmcnt(0)" ::: "memory"); __builtin_amdgcn_s_barrier(); asm volatile("" ::: "memory");
        }
#pragma unroll 1
        for (int t = 0; t < KS; t += 2) {
            const bool nb = (t + 2 >= KS);
            { const u32x4 rs = nb ? wrsrc_n : wrsrc; const unsigned so = nb ? wsoff_n : wsoff + (unsigned)(t + 2) * BSTEP;
              MOE_DMAA(1, t + 1); MOE_LOADB(0, rs, so);
              asm volatile("s_waitcnt vmcnt(%0)" :: "n"(8 + 2 * NMT) : "memory");
              MOE_COMPUTE(0);
              MOE_WAITB(1, 4 + 2 * NMT);
              MOE_WRITEB(1, 1, t + 1);
              asm volatile("s_waitcnt lgkmcnt(0)" ::: "memory"); __builtin_amdgcn_s_barrier(); asm volatile("" ::: "memory"); }
            { const u32x4 rs = nb ? wrsrc_n : wrsrc; const unsigned so = nb ? wsoff_n + BSTEP : wsoff + (unsigned)(t + 3) * BSTEP;
              if (nb) {
                  unsigned vn[6];
#pragma unroll
                  for (int q = 0; q < 6; ++q) vn[q] = (unsigned)stash[q * 64] * (unsigned)(LDA * 2) + ((q & 1) ? kco1 : kco0);
#pragma unroll
                  for (int q = 0; q < 6; ++q) if constexpr (ABL != 2) glds16(Abase_n, vn[q], asb + (unsigned)q * 1024u);
              } else MOE_DMAA(0, t + 2);
              MOE_LOADB(1, rs, so);
              asm volatile("s_waitcnt vmcnt(%0)" :: "n"(8 + 2 * NMT) : "memory");
              MOE_COMPUTE(1);
              MOE_WAITB(0, 4 + 2 * NMT);
              MOE_WRITEB(0, 0, (nb ? 0 : t + 2));
              asm volatile("s_waitcnt lgkmcnt(0)" ::: "memory"); __builtin_amdgcn_s_barrier(); asm volatile("" ::: "memory"); }
        }
        MOE_WAITB(1, 0);
#pragma unroll
        for (int mi = 0; mi < NMT; ++mi) {
            const int prow = (t0 + mi * 8 + w) * 16 + fr;
            if (prow < cnt) {
                bf16_t* op = out + (size_t)(slot0 + prow) * LDO;
                if constexpr (MODE == 1) { const float rs = rstash[mi * 64];
#pragma unroll
                    for (int pp = 0; pp < 2; ++pp) { float r[8];
#pragma unroll
                        for (int n = 0; n < 2; ++n)
#pragma unroll
                            for (int i = 0; i < 4; ++i) { const float g = acc[mi][2 * pp + n][i] * rs, up = acc[mi][4 + 2 * pp + n][i] * rs; r[4 * n + i] = (g * __builtin_amdgcn_rcpf(1.0f + __expf(-g))) * up; }
                        u32x4 o; o.x = cvt_pk_bf16(r[0], r[1]); o.y = cvt_pk_bf16(r[2], r[3]); o.z = cvt_pk_bf16(r[4], r[5]); o.w = cvt_pk_bf16(r[6], r[7]);
                        *(u32x4*)(op + sl * 64 + 32 * pp + 8 * fq) = o; }
                } else {
#pragma unroll
                    for (int pp = 0; pp < 4; ++pp) { u32x4 o; o.x = cvt_pk_bf16(acc[mi][2 * pp][0], acc[mi][2 * pp][1]); o.y = cvt_pk_bf16(acc[mi][2 * pp][2], acc[mi][2 * pp][3]);
                        o.z = cvt_pk_bf16(acc[mi][2 * pp + 1][0], acc[mi][2 * pp + 1][1]); o.w = cvt_pk_bf16(acc[mi][2 * pp + 1][2], acc[mi][2 * pp + 1][3]);
                        *(u32x4*)(op + sl * 128 + 32 * pp + 8 * fq) = o; }
                }
            }
        }
#undef MOE_LOADB
#undef MOE_WAITB
#undef MOE_DMAA
#undef MOE_WRITEB
#undef MOE_COMPUTE
}
template <int MODE, int ABL = 0>
__device__ __forceinline__ void moe_phase(LAS unsigned char* lds, const int* list, const char* Abase, const float* W0, const float* W1, bf16_t* out, int G, int c, const float* gain = nullptr, const float* rsl = nullptr) {
    constexpr int K = (MODE == 2) ? DEXP : D, KS = K / 64, LDA = K, NW = (MODE == 1) ? DEXP : D  , LDO = (MODE == 1) ? DEXP : D;
    constexpr int BS_OFF = 0, AS_OFF = 32768, AW = 6144;
    const int tid = fresh_tid(), lane = tid & 63, w = __builtin_amdgcn_readfirstlane(tid >> 6), fr = lane & 15, fq = lane >> 4;
    const LAS int* tbl = (const LAS int*)(lds + TBL_OFF);
    const unsigned ldsb = (unsigned)__builtin_amdgcn_readfirstlane((int)(unsigned)(__UINTPTR_TYPE__)lds);
    const unsigned asb = ldsb + AS_OFF + (unsigned)w * AW;
    const int NU = (MODE == 3) ? 64 : __builtin_amdgcn_readfirstlane(tbl[MOE_PT_OFF + 32]) * 16;
    const int bL = lane & 15, bn = 32 * (2 * (w & 1) + (bL >> 3)) + 16 * (bL & 1) + 4 * ((bL & 7) >> 1), bk0 = 16 * (w >> 1), bk4 = lane >> 4;
    const int bkc = 2 * (w >> 1) + (bk4 >> 1);
    const int bwoff = bn * 128 + 8 * (bk4 & 1), bsw = bkc ^ ((bn >> 1) & 7);
    const int sw0 = (fq ^ ((fr >> 1) & 7)) * 16, sw1 = sw0 ^ 64;
    const LAS unsigned char* pa0 = lds + AS_OFF + w * AW + fr * 128 + sw0; const LAS unsigned char* pa1 = lds + AS_OFF + w * AW + fr * 128 + sw1;
    const LAS unsigned char* pb0 = lds + BS_OFF + fr * 128 + sw0; const LAS unsigned char* pb1 = lds + BS_OFF + fr * 128 + sw1;
    auto desc = [&](int ui) -> MoeDesc {
        MoeDesc d; d.valid = 0; d.e = 0; d.sl = 0; d.t0 = 0; d.nt = 0; d.cnt = 1; d.slot0 = 0; d.Ab = Abase; d.out = out; d.W0 = W0; d.W1 = W1;
        if constexpr (MODE == 3) {
            const int j = ((c + G - (G >> 1)) % G) + ui * G;
            if (j < NU) { const int l = j >> 5, kv = (j >> 4) & 1; d.sl = j & 15; d.cnt = NMEM; d.nt = NMEM / 16;
                d.Ab = Abase + (size_t)l * NMEM * D * 2; d.out = out + (size_t)(kv * 2 + l) * NMEM * D; d.W0 = (kv ? W1 : W0) + (size_t)l * D * D; d.valid = 1; }
        } else {
            const long L = (long)ui * G + c;
            if (L < NU) {
                int wg = (int)L; { const int q = NU / 8, r = NU % 8, xcd = wg % 8, off = wg / 8; wg = (xcd < r ? xcd * (q + 1) : r * (q + 1) + (xcd - r) * q) + off; }
                d.sl = wg & 15;
                const int pk = __builtin_amdgcn_readfirstlane(tbl[MOE_PARTS + (wg >> 4)]); const int e = pk & 31;
                d.e = e; d.t0 = (pk >> 5) & 1023; d.nt = pk >> 15;
                d.cnt = __builtin_amdgcn_readfirstlane(tbl[33 + e]);
                d.slot0 = __builtin_amdgcn_readfirstlane(tbl[e]) * 256;
                d.valid = 1;
            }
        }
        return d;
    };
    constexpr int STASH_OFF = AS_OFF + 2 * 8 * AW;
    LAS int* stash = (LAS int*)(lds + STASH_OFF + w * 1536) + lane;
    const unsigned stash_b = ldsb + STASH_OFF + (unsigned)w * 1536u;
    const unsigned kco0 = (unsigned)(((lane & 7) ^ (lane >> 4)) * 16), kco1 = (unsigned)(((lane & 7) ^ (4 + (lane >> 4))) * 16);
    auto fill = [&](const MoeDesc& d) {
#pragma unroll
        for (int q = 0; q < 6; ++q) { int idx = (d.t0 + (q >> 1) * 8 + w) * 16 + (q & 1) * 8 + (lane >> 3); idx = idx < d.cnt ? idx : 0;
            if constexpr (MODE == 1) glds4((const char*)list, (unsigned)(d.e * LISTCAP + idx) * 4u, stash_b + (unsigned)q * 256u);
            else stash[q * 64] = d.slot0 + idx; }
    };
    constexpr int GT_OFF = STASH_OFF + 8 * 1536, RS_OFF = GT_OFF + 8192;
    LAS float* gt = (LAS float*)(lds + GT_OFF);
    const LAS float* gtab = gt + bk0 + 4 * bk4;
    const LAS float* rstash = (const LAS float*)(lds + RS_OFF + w * 768) + lane;
    const unsigned rs_b = ldsb + RS_OFF + (unsigned)w * 768u;
    if constexpr (MODE == 1) { *(LAS f32x4*)(gt + 4 * tid) = *(const f32x4*)(gain + 4 * tid); }
    auto fill_rs = [&](const MoeDesc& d) {
        if constexpr (MODE == 1) {
#pragma unroll
            for (int mi = 0; mi < 3; ++mi) { int idx = (d.t0 + mi * 8 + w) * 16 + (lane & 15); idx = idx < d.cnt ? idx : 0;
                glds4((const char*)rsl, (unsigned)(d.e * LISTCAP + idx) * 4u, rs_b + (unsigned)mi * 256u); }
        }
    };
    MoeDesc cur = desc(0);
    if (cur.valid) {
    fill(cur);
    bool pre = false; u32x4 bst[2][4];
#pragma unroll 1
    for (int ui = 0;; ++ui) {
        const MoeDesc nxt = desc(ui + 1);
        if (MODE == 1 && !pre) asm volatile("s_waitcnt vmcnt(0)" ::: "memory");
        unsigned voff[6];
#pragma unroll
        for (int q = 0; q < 6; ++q) voff[q] = (unsigned)stash[q * 64] * (unsigned)(LDA * 2) + ((q & 1) ? kco1 : kco0);
        asm volatile("s_waitcnt lgkmcnt(0)" ::: "memory");
        if (nxt.valid) fill(nxt);
        fill_rs(cur);
        const int nt = cur.nt, nmt = (nt > 16 + w) ? 3 : (nt > 8 + w) ? 2 : (nt > w) ? 1 : 0;
        const MoeDesc& dn = nxt.valid ? nxt : cur;
        const float* wmat = ((MODE == 1 && (w & 1)) ? cur.W1 : cur.W0) + (size_t)cur.e * K * NW;
        const float* wmat_n = ((MODE == 1 && (w & 1)) ? dn.W1 : dn.W0) + (size_t)dn.e * K * NW;
        const unsigned long long wa = (unsigned long long)wmat, wan = (unsigned long long)wmat_n;
        const u32x4 wrsrc = {(unsigned)__builtin_amdgcn_readfirstlane((int)(unsigned)wa), (unsigned)__builtin_amdgcn_readfirstlane((int)(unsigned)(wa >> 32)) & 0xffffu, (unsigned)(K * NW * 4), 0x00020000u};
        const u32x4 wrsrc_n = {(unsigned)__builtin_amdgcn_readfirstlane((int)(unsigned)wan), (unsigned)__builtin_amdgcn_readfirstlane((int)(unsigned)(wan >> 32)) & 0xffffu, (unsigned)(K * NW * 4), 0x00020000u};
        const unsigned wsoff = (unsigned)__builtin_amdgcn_readfirstlane((bk0 * NW + ((MODE == 1) ? cur.sl * 64 : cur.sl * 128 + 64 * (w & 1))) * 4);
        const unsigned wsoff_n = (unsigned)__builtin_amdgcn_readfirstlane((bk0 * NW + ((MODE == 1) ? dn.sl * 64 : dn.sl * 128 + 64 * (w & 1))) * 4);
        const int bvoff = (4 * bk4 * NW + 4 * (lane & 15)) * 4;
#define MOE_CALL(N) moe_unit<MODE, N, ABL>(lds, cur.Ab, wrsrc, wsoff, bvoff, voff, asb, cur.out, w, fr, fq, bwoff, bsw, pa0, pa1, pb0, pb1, cur.t0, cur.cnt, cur.slot0, cur.sl, pre, bst, wrsrc_n, wsoff_n, dn.Ab, stash, kco0, kco1, gtab, rstash)
        if constexpr (MODE == 3) MOE_CALL(2);
        else if (nmt == 3) MOE_CALL(3);
        else if (nmt == 2) MOE_CALL(2);
        else MOE_CALL(1);
#undef MOE_CALL
        if (!nxt.valid) break;
        cur = nxt; pre = true;
    }
    asm volatile("s_waitcnt vmcnt(0)" ::: "memory");
    }
}

#ifndef MK_PER_PHASE
#define MK_PER_PHASE 0
#endif
#ifndef NEWMOE
#define NEWMOE 3
#endif
#ifndef PHMASK
#define PHMASK 0x3fff
#endif
#define PH(n) (((PHMASK) >> (n)) & 1)
#ifndef REPMASK
#define REPMASK 0
#endif
#define NREP(n) ((((REPMASK) >> (n)) & 1) ? 2 : 1)
#ifndef SUBMASK
#define SUBMASK 0xff
#endif
#define SUB(n) (((SUBMASK) >> (n)) & 1)
constexpr int NPH = 27;
struct Args { const float* in[27]; float* out; unsigned char* ws; int ph_lo, ph_hi, fused, pad; };

__global__ void __launch_bounds__(NTHR, 2) mk_fwd(Args args) {
    extern __shared__ __attribute__((aligned(16))) unsigned char lds_raw[];
    LAS unsigned char* lds0 = (LAS unsigned char*)lds_raw;
    const int tid = threadIdx.x, lane = tid & 63, wave = __builtin_amdgcn_readfirstlane(tid >> 6);
    unsigned* const ctl = (unsigned*)(args.ws + WS_CTL);
    for (int u = tid; u < (LDS_BYTES - MISC_OFF) / 4; u += NTHR) ((LAS unsigned*)(lds0 + MISC_OFF))[u] = 0u;
    __syncthreads();
    XcdBarrier bar; bar.bar = ctl + CW_BAR; bar.x = 0; bar.st = nullptr;
    if (args.fused) bar = xcd_barrier_post(ctl + CW_BAR, (volatile LAS unsigned*)(lds0 + MISC_OFF));
    const int lo = args.ph_lo;
#define IN(k) (args.fused || lo == (k))
#ifdef SEAM2X
#define SEAM() do { if (args.fused) { XcdBarrier b2 = bar; asm volatile("" : "+s"(b2.bar), "+s"(b2.x)); xcd_barrier(b2); xcd_barrier(b2); xcd_barrier(b2); } } while (0)
#else
#define SEAM() do { if (args.fused) { XcdBarrier b2 = bar; asm volatile("" : "+s"(b2.bar), "+s"(b2.x)); xcd_barrier(b2); } } while (0)
#endif

#define CAS __attribute__((address_space(4)))
#define KARG() ({ const CAS char* _k = (const CAS char*)__builtin_amdgcn_kernarg_segment_ptr(); asm volatile("" : "+s"(_k)); _k; })
#define INP(k) (*(const float* const CAS*)(ka + 8 * (k)))
#define hbuf (*(float* const CAS*)(ka + 216))
#define DEF_W LAS unsigned char* lds = lds0; asm volatile("" : "+s"(lds)); const LAS int* tbl = (const LAS int*)(lds + TBL_OFF); const int bx = fresh_bx(), G = fresh_s((int)gridDim.x); const CAS char* ka = KARG(); unsigned char* ws = *(unsigned char* const CAS*)(ka + 224);
#define W_EVIN ((bf16_t*)(ws + WS_WEVIN))
#define W_EVOUT ((bf16_t*)(ws + WS_WEVOUT))
#define W_ODIN ((bf16_t*)(ws + WS_WODIN))
#define W_ODOUT ((bf16_t*)(ws + WS_WODOUT))
#define W_XQ ((bf16_t*)(ws + WS_WXQ))
#define W_XK ((bf16_t*)(ws + WS_WXK))
#define W_XV ((bf16_t*)(ws + WS_WXV))
#define W_XO ((bf16_t*)(ws + WS_WXO))
#define W_POOL ((bf16_t*)(ws + WS_WPOOL))
#define MEMN ((bf16_t*)(ws + WS_MEMN))
#define KX ((bf16_t*)(ws + WS_KX))
#define VX ((bf16_t*)(ws + WS_VX))
#define GATES ((float*)(ws + WS_SMALL + SM_GATES))
#define BCUM ((float*)(ws + WS_SMALL + SM_BCUM))
#define GI ((float*)(ws + WS_SMALL + SM_GI))
#define MARR ((float*)(ws + WS_SMALL + SM_MARR))
#define APREV ((float*)(ws + WS_SMALL + SM_APREV))
#define BLG ((float*)(ws + WS_SMALL + SM_BL))
#define KN ((float*)(ws + WS_SMALL + SM_KN))
#define NST ((float*)(ws + WS_SMALL + SM_NST))
#define HN ((bf16_t*)(ws + WS_HN))
#define Z ((bf16_t*)(ws + WS_Z))
#define YCAT ((bf16_t*)(ws + WS_YCAT))
#define DPOOL ((bf16_t*)(ws + WS_DPOOL))
#define KC ((float*)(ws + WS_KC))
#define CST ((bf16_t*)(ws + WS_CST))
#define QX ((bf16_t*)(ws + WS_QX))
#define OATT ((bf16_t*)(ws + WS_OATT))
#define HID ((bf16_t*)(ws + WS_HID))
#define H16 ((bf16_t*)(ws + WS_H16))
#define WRT ((bf16_t*)(ws + WS_WEXP))
#define YB ((bf16_t*)(ws + WS_YB))
#define LIST ((int*)(ws + WS_LIST + (size_t)layer * MiB))
#define RSTD1 ((float*)(ws + WS_WEXP + (size_t)10 * MiB))
#define RSL ((float*)(ws + WS_WEXP + (size_t)(8 + layer) * MiB))
#define TOKINFO ((int*)(ws + WS_TOKINFO + (size_t)layer * 256 * 1024))
#define WG ((const bf16_t*)(ws + WS_WEXP + (size_t)layer * WEXP_LAYER))
#define WU (WG + WEXP_MAT / 2)
#define WD (WG + WEXP_MAT)
#define x_in INP(0)
#define mem_in INP(1)
#define mix_norm INP(2)
#define xattn_norm INP(3)
#define mem_norm INP(4)
#define ffn_norm INP(5)
#define final_norm INP(6)
#define ev_w_in INP(7)
#define ev_b_gates INP(8)
#define ev_pool_w INP(9)
#define ev_pool_scale INP(10)
#define ev_head_norm INP(11)
#define ev_w_out INP(12)
#define od_w_in INP(13)
#define od_conv_w INP(14)
#define od_w_out INP(15)
#define xa_wq INP(16)
#define xa_wk INP(17)
#define xa_wv INP(18)
#define xa_wo INP(19)
#define rt_group_w INP(20)
#define rt_group_b INP(21)
#define rt_expert_w INP(22)
#define rt_expert_b INP(23)
#define ex_w_gate INP(24)
#define ex_w_up INP(25)
#define ex_w_down INP(26)

    constexpr int I_EVIN = (D / 64) * (EVN / 64), I_SQ = (D / 64) * (D / 64), I_ODIN = (D / 64) * (ODN / 64), I_POOL = 4 * 4 * 4;
    constexpr int NP_ITEMS = I_EVIN + I_POOL, NITEMS = NP_ITEMS + I_ODIN + 6 * I_SQ;
#define TRANSPOSE_ITEMS(first, stride, lo, hi) \
        for (int it = (lo) + (first); it < (hi); it += (stride)) { \
            int r = it; const float* src; int ldw, K, N; bf16_t* dst; const float* gain = nullptr; \
            if (r < I_EVIN) { src = ev_w_in; ldw = EVW; K = D; N = EVN; dst = W_EVIN; } \
            else if ((r -= I_EVIN) < I_POOL) { const int m = r / 16; r -= m * 16; src = ev_pool_w + (size_t)m * 65536; ldw = 256; K = 256; N = 256; dst = W_POOL + (size_t)m * 65536; } \
            else if ((r -= I_POOL) < I_SQ) { src = ev_w_out; ldw = D; K = D; N = D; dst = W_EVOUT; } \
            else if ((r -= I_SQ) < I_SQ) { src = xa_wq; ldw = D; K = D; N = D; dst = W_XQ; gain = xattn_norm; } \
            else if ((r -= I_SQ) < I_SQ) { src = xa_wo; ldw = D; K = D; N = D; dst = W_XO; } \
            else if ((r -= I_SQ) < I_ODIN) { src = od_w_in; ldw = ODN; K = D; N = ODN; dst = W_ODIN; gain = mix_norm + D; } \
            else if ((r -= I_ODIN) < I_SQ) { src = od_w_out; ldw = D; K = D; N = D; dst = W_ODOUT; } \
            else if ((r -= I_SQ) < I_SQ) { src = xa_wq + (size_t)D * D; ldw = D; K = D; N = D; dst = W_XQ + (size_t)D * D; gain = xattn_norm + D; } \
            else { r -= I_SQ; src = xa_wo + (size_t)D * D; ldw = D; K = D; N = D; dst = W_XO + (size_t)D * D; } \
            const int nbn = N / 64; \
            transpose_item64(src, ldw, K, dst, r / nbn, r % nbn, scr, lane, gain); }

    if (PH(13) && IN(0)) { DEF_W
        LAS float* scr = (LAS float*)(lds + wave * 16640);
        const int gw = bx * NWAVES + wave, NGW = G * NWAVES;
        for (int rep = 0; rep < NREP(13); ++rep) { TRANSPOSE_ITEMS(gw, NGW, 0, NP_ITEMS) }
        for (int r = gw; r < 2 * NMEM; r += NGW) { const int l = r >> 8, row = r & 255; const float* s = mem_in + (size_t)row * D; const float* g = mem_norm + (size_t)l * D;
            f32x4 v[8]; float ss = 0.f;
#pragma unroll
            for (int j = 0; j < 8; ++j) { v[j] = *(const f32x4*)(s + 4 * lane + 256 * j); ss += (v[j][0] * v[j][0] + v[j][1] * v[j][1]) + (v[j][2] * v[j][2] + v[j][3] * v[j][3]); }
            const float rs = rsqrtf(wave_sum(ss) * (1.0f / D) + EPS);
#pragma unroll
            for (int j = 0; j < 8; ++j) { const f32x4 gg = *(const f32x4*)(g + 4 * lane + 256 * j); const f32x4 y = v[j] * rs * gg; u32x2 w; w.x = cvt_pk_bf16(y[0], y[1]); w.y = cvt_pk_bf16(y[2], y[3]);
                *(u32x2*)(MEMN + (size_t)l * NMEM * D + (size_t)row * D + 4 * lane + 256 * j) = w; } }
        for (int idx = bx * NTHR + tid; idx < 2 * 48 * D; idx += G * NTHR) { const int l = idx / (48 * D), n = (idx / D) % 48, k = idx % D;
            float wv = 0.f;
            if (n < 32) wv = rt_expert_w[((size_t)l * D + k) * NEXP + n]; else if (n < 36) wv = rt_group_w[((size_t)l * D + k) * 4 + (n - 32)];
            wv *= ffn_norm[(size_t)l * D + k];
            const unsigned hi = cvt_pk_bf16(wv, 0.f) & 0xffffu; const float rem = wv - bf2f((unsigned short)hi); const unsigned lo = cvt_pk_bf16(rem, 0.f) & 0xffffu;
            WRT[((size_t)l * 2 + 0) * 48 * D + (size_t)n * D + k] = (bf16_t)hi; WRT[((size_t)l * 2 + 1) * 48 * D + (size_t)n * D + k] = (bf16_t)lo; }
        __syncthreads();
        RowArgs ra{}; ra.hin = x_in; ra.gain = mix_norm; ra.hn = HN; ra.wgate = ev_w_in; ra.bgate = ev_b_gates; ra.gates = GATES;
        row_phase<RM_GATES, false>(lds, ra, G);
        SEAM();
    }

    { constexpr int layer = 0;
        const int pb = 1 + 13 * layer;
#define cnt_p ((unsigned*)(ws + WS_CTL) + CW_CNT + layer * 32 * 64)
        if (PH(0) && IN(pb + 0)) { DEF_W
            for (int rep = 0; rep < NREP(0); ++rep) {
            if (layer == 0) {
                if (SUB(4)) for (int h = bx; h < NH; h += G) mlstm_prep(lds, h, GATES, BCUM, GI, MARR, APREV, BLG);
                if (SUB(0)) { pg8::DenseSched S{(const char*)HN, (size_t)256 * D * 2, 0, (const char*)W_EVIN, (const char*)W_EVIN + (size_t)128 * D * 2, (size_t)256 * D * 2, (char*)Z, EVN, T / 256, EVN / 256, G, bx};
                  pg8::EpiBf16 E{}; pg8::gemm_phase<pg8::EpiBf16, pg8::DenseSched, true>(lds, D, D, D, S, E); }
                if (SUB(1)) moe_phase<3>(lds, nullptr, (const char*)MEMN, xa_wk, xa_wv, KX, G, bx);
                if (SUB(1) && bx >= (G >> 1)) {
                    __syncthreads();
                    const int tid_ = fresh_tid(), lane = tid_ & 63, wave = __builtin_amdgcn_readfirstlane(tid_ >> 6);
                    LAS float* scr = (LAS float*)(lds + wave * 16640);
                    const int b = bx - (G >> 1), nbu = G - (G >> 1), nkv = nbu < 64 ? nbu : 64, WA = nkv * NWAVES, WB = (nbu - nkv) * NWAVES;
                    const int NL = NITEMS - NP_ITEMS, NA = (int)((long)NL * WA / (WA + 5 * WB));
                    if (b < nkv) { TRANSPOSE_ITEMS(b * NWAVES + wave, WA, NP_ITEMS, NP_ITEMS + NA) }
                    else { TRANSPOSE_ITEMS((b - nkv) * NWAVES + wave, WB, NP_ITEMS + NA, NITEMS) }
                }
            } else {
                if (SUB(2)) { pg8::DenseSched S{(const char*)H16, (size_t)256 * D * 2, 0, (const char*)W_ODIN, (const char*)W_ODIN + (size_t)128 * D * 2, (size_t)256 * D * 2, (char*)Z, D, T / 256, D / 256, G, bx};
                  pg8::EpiBf16Rs E{RSTD1}; pg8::gemm_phase<pg8::EpiBf16Rs, pg8::DenseSched, true>(lds, D, D, D, S, E); }
                if (SUB(3)) { pg8::DenseSched S{(const char*)H16, (size_t)256 * D * 2, 0, (const char*)W_ODIN + (size_t)2048 * D * 2, (const char*)W_ODIN + (size_t)4096 * D * 2, (size_t)128 * D * 2, (char*)(Z + (size_t)T * D), D, T / 256, D / 128, G, bx};
                  pg8::EpiPairRs E{RSTD1}; pg8::gemm_phase<pg8::EpiPairRs, pg8::DenseSched, true>(lds, D, D, D, S, E); }
            }
            }
            SEAM();
        }
        if (PH(1) && IN(pb + 1)) { DEF_W
            for (int rep = 0; rep < NREP(1); ++rep) {
            if (layer == 0) {
                for (int u = bx; u < NCH * NH; u += G) mlstm_B(lds, u >> 2, u & 3, Z, GI, MARR, BLG, KC, KN);
                pool_diffs(Z, DPOOL, G);
            } else conv_gate(Z, Z + (size_t)T * D, od_conv_w, YCAT, G);
            }
            SEAM();
        }
        if (PH(2) && layer == 0 && IN(pb + 2)) { DEF_W
            for (int rep = 0; rep < NREP(2); ++rep) {
            if (SUB(5)) mlstm_scan(KC, KN, APREV, CST, NST, G);
            if (SUB(6)) { pg8::DenseSched S{(const char*)DPOOL, (size_t)256 * 1024 * 2, (size_t)256 * 2, (const char*)W_POOL, (const char*)W_POOL + (size_t)128 * 256 * 2, (size_t)256 * 256 * 2, (char*)YCAT, D, T / 256, 4, G, bx};
              pg8::EpiBf16Scale E{ev_pool_scale}; pg8::gemm_phase<pg8::EpiBf16Scale, pg8::DenseSched, true>(lds, 256, 1024, 256, S, E); }
            }
            SEAM();
        }
        if (PH(3) && layer == 0 && IN(pb + 3)) { DEF_W
            for (int rep = 0; rep < NREP(3); ++rep) {
            for (int u = bx; u < NCH * NH; u += G) mlstm_D(lds, u >> 2, u & 3, Z, GI, BCUM, MARR, CST, NST, ev_head_norm, YCAT);
            }
            SEAM();
        }
        if (PH(4) && IN(pb + 4)) { DEF_W
            pg8::DenseSched S{(const char*)YCAT, (size_t)256 * D * 2, 0, (const char*)(layer == 0 ? W_EVOUT : W_ODOUT), (const char*)(layer == 0 ? W_EVOUT : W_ODOUT) + (size_t)128 * D * 2, (size_t)256 * D * 2, (char*)H16, D, T / 256, D / 256, G, bx};
            float* ssq = (float*)(ws + WS_SMALL + SM_SSQP) + (size_t)layer * T * 32;
            if (layer == 0) { pg8::EpiResSsq<false> E{(const void*)x_in, ssq}; pg8::gemm_phase<pg8::EpiResSsq<false>, pg8::DenseSched, true>(lds, D, D, D, S, E); }
            else { pg8::EpiResSsq<true> E{(const void*)H16, ssq}; pg8::gemm_phase<pg8::EpiResSsq<true>, pg8::DenseSched, true>(lds, D, D, D, S, E); }
            SEAM();
        }
        if (PH(6) && IN(pb + 6)) { DEF_W
            for (int rep = 0; rep < NREP(6); ++rep) {
            const bf16_t* W = W_XQ + (size_t)layer * D * D;
            pg8::DenseSched S{(const char*)H16, (size_t)256 * D * 2, 0, (const char*)W, (const char*)W + (size_t)128 * D * 2, (size_t)256 * D * 2, (char*)QX, D, T / 256, D / 256, G, bx};
            pg8::EpiBf16RowScale E{(const float*)(ws + WS_SMALL + SM_SSQP) + (size_t)layer * T * 32, 1.0f / D, EPS}; pg8::gemm_phase<pg8::EpiBf16RowScale, pg8::DenseSched, true>(lds, D, D, D, S, E);
            }
            SEAM();
        }
        if (PH(7) && IN(pb + 7)) { DEF_W
            for (int rep = 0; rep < NREP(7); ++rep) {
            for (int u = bx; u < XH * (T / 128); u += G) xattn_unit(lds, u & 3, u >> 2, QX, KX + (size_t)layer * NMEM * D, VX + (size_t)layer * NMEM * D, OATT);
            }
            SEAM();
        }
        if (PH(8) && IN(pb + 8)) { DEF_W
            const bf16_t* W = W_XO + (size_t)layer * D * D;
            pg8::DenseSched S{(const char*)OATT, (size_t)256 * D * 2, 0, (const char*)W, (const char*)W + (size_t)128 * D * 2, (size_t)256 * D * 2, (char*)H16, D, T / 256, D / 256, G, bx};
            pg8::EpiResSsq<true> E{(const void*)H16, nullptr}; pg8::gemm_phase<pg8::EpiResSsq<true>, pg8::DenseSched, true>(lds, D, D, D, S, E);
            SEAM();
        }
        if (PH(9) && IN(pb + 9)) { DEF_W
            RowArgs ra{}; ra.hin16 = H16; ra.gain = ffn_norm + (size_t)layer * D; ra.hn = HN;
            ra.rgw = rt_group_w + (size_t)layer * D * 4; ra.rgb = rt_group_b + layer * 4; ra.rew = rt_expert_w + (size_t)layer * D * NEXP; ra.reb = rt_expert_b + layer * NEXP;
            ra.cnt = cnt_p; ra.list = LIST; ra.tokinfo = TOKINFO; ra.wr = WRT + (size_t)layer * 2 * 48 * D; ra.rsl = RSL;
            row_phase<RM_ROUTE, false, true, false>(lds, ra, G);
            SEAM();
        }
        if (PH(10) && IN(pb + 10)) { DEF_W
            moe_tables(lds, cnt_p);
#if (NEWMOE & 1)
            moe_phase<1>(lds, LIST, (const char*)H16, ex_w_gate + (size_t)layer * NEXP * D * DEXP, ex_w_up + (size_t)layer * NEXP * D * DEXP, HID, G, bx, ffn_norm + (size_t)layer * D, RSL);
#ifdef MOE_ABLV
            if (NREP(10) > 1) moe_phase<1, MOE_ABLV>(lds, LIST, (const char*)H16, ex_w_gate + (size_t)layer * NEXP * D * DEXP, ex_w_up + (size_t)layer * NEXP * D * DEXP, YB, G, bx, ffn_norm + (size_t)layer * D, RSL);
#else
            if (NREP(10) > 1) moe_phase<1>(lds, LIST, (const char*)H16, ex_w_gate + (size_t)layer * NEXP * D * DEXP, ex_w_up + (size_t)layer * NEXP * D * DEXP, YB, G, bx, ffn_norm + (size_t)layer * D, RSL);
#endif
#else
            Moe1Sched S{tbl, LIST, (const char*)HN, (const char*)WG, (const char*)WU, (char*)HID, G, bx};
            pg8::EpiPair<true> E{}; for (int rep = 0; rep < NREP(10); ++rep) pg8::gemm_phase<pg8::EpiPair<true>, Moe1Sched, true>(lds, D, D, D, S, E);
#endif
            SEAM();
        }
        if (PH(11) && IN(pb + 11)) { DEF_W
            if (!args.fused) moe_tables(lds, cnt_p);
#if (NEWMOE & 2)
            moe_phase<2>(lds, nullptr, (const char*)HID, ex_w_down + (size_t)layer * NEXP * D * DEXP, nullptr, YB, G, bx);
#ifdef MOE_ABLV
            if (NREP(11) > 1) moe_phase<2, MOE_ABLV>(lds, nullptr, (const char*)HID, ex_w_down + (size_t)layer * NEXP * D * DEXP, nullptr, Z, G, bx);
#else
            if (NREP(11) > 1) moe_phase<2>(lds, nullptr, (const char*)HID, ex_w_down + (size_t)layer * NEXP * D * DEXP, nullptr, Z, G, bx);
#endif
#else
            Moe2Sched S{tbl, (const char*)HID, (const char*)WD, (char*)YB, G, bx};
            pg8::EpiBf16 E{}; for (int rep = 0; rep < NREP(11); ++rep) pg8::gemm_phase<pg8::EpiBf16, Moe2Sched, true>(lds, DEXP, DEXP, DEXP, S, E);
#endif
            SEAM();
        }
        if (PH(12) && IN(pb + 12)) { DEF_W
            if (!args.fused) moe_tables(lds, cnt_p);
            if (layer == 0) { combine_phase<false>(lds, H16, YB, TOKINFO, nullptr, RSTD1, nullptr, G); SEAM(); }
            else combine_phase<true>(lds, H16, YB, TOKINFO, final_norm, nullptr, hbuf, G);
        }
    }
    { constexpr int layer = 1;
        const int pb = 1 + 13 * layer;
#define cnt_p ((unsigned*)(ws + WS_CTL) + CW_CNT + layer * 32 * 64)
        if (PH(0) && IN(pb + 0)) { DEF_W
            for (int rep = 0; rep < NREP(0); ++rep) {
            if (layer == 0) {
                if (SUB(4)) for (int h = bx; h < NH; h += G) mlstm_prep(lds, h, GATES, BCUM, GI, MARR, APREV, BLG);
                if (SUB(0)) { pg8::DenseSched S{(const char*)HN, (size_t)256 * D * 2, 0, (const char*)W_EVIN, (const char*)W_EVIN + (size_t)128 * D * 2, (size_t)256 * D * 2, (char*)Z, EVN, T / 256, EVN / 256, G, bx};
                  pg8::EpiBf16 E{}; pg8::gemm_phase<pg8::EpiBf16, pg8::DenseSched, true>(lds, D, D, D, S, E); }
                if (SUB(1)) moe_phase<3>(lds, nullptr, (const char*)MEMN, xa_wk, xa_wv, KX, G, bx);
                if (SUB(1) && bx >= (G >> 1)) {
                    __syncthreads();
                    const int tid_ = fresh_tid(), lane = tid_ & 63, wave = __builtin_amdgcn_readfirstlane(tid_ >> 6);
                    LAS float* scr = (LAS float*)(lds + wave * 16640);
                    const int b = bx - (G >> 1), nbu = G - (G >> 1), nkv = nbu < 64 ? nbu : 64, WA = nkv * NWAVES, WB = (nbu - nkv) * NWAVES;
                    const int NL = NITEMS - NP_ITEMS, NA = (int)((long)NL * WA / (WA + 5 * WB));
                    if (b < nkv) { TRANSPOSE_ITEMS(b * NWAVES + wave, WA, NP_ITEMS, NP_ITEMS + NA) }
                    else { TRANSPOSE_ITEMS((b - nkv) * NWAVES + wave, WB, NP_ITEMS + NA, NITEMS) }
                }
            } else {
                if (SUB(2)) { pg8::DenseSched S{(const char*)H16, (size_t)256 * D * 2, 0, (const char*)W_ODIN, (const char*)W_ODIN + (size_t)128 * D * 2, (size_t)256 * D * 2, (char*)Z, D, T / 256, D / 256, G, bx};
                  pg8::EpiBf16Rs E{RSTD1}; pg8::gemm_phase<pg8::EpiBf16Rs, pg8::DenseSched, true>(lds, D, D, D, S, E); }
                if (SUB(3)) { pg8::DenseSched S{(const char*)H16, (size_t)256 * D * 2, 0, (const char*)W_ODIN + (size_t)2048 * D * 2, (const char*)W_ODIN + (size_t)4096 * D * 2, (size_t)128 * D * 2, (char*)(Z + (size_t)T * D), D, T / 256, D / 128, G, bx};
                  pg8::EpiPairRs E{RSTD1}; pg8::gemm_phase<pg8::EpiPairRs, pg8::DenseSched, true>(lds, D, D, D, S, E); }
            }
            }
            SEAM();
        }
        if (PH(1) && IN(pb + 1)) { DEF_W
            for (int rep = 0; rep < NREP(1); ++rep) {
            if (layer == 0) {
                for (int u = bx; u < NCH * NH; u += G) mlstm_B(lds, u >> 2, u & 3, Z, GI, MARR, BLG, KC, KN);
                pool_diffs(Z, DPOOL, G);
            } else conv_gate(Z, Z + (size_t)T * D, od_conv_w, YCAT, G);
            }
            SEAM();
        }
        if (PH(2) && layer == 0 && IN(pb + 2)) { DEF_W
            for (int rep = 0; rep < NREP(2); ++rep) {
            if (SUB(5)) mlstm_scan(KC, KN, APREV, CST, NST, G);
            if (SUB(6)) { pg8::DenseSched S{(const char*)DPOOL, (size_t)256 * 1024 * 2, (size_t)256 * 2, (const char*)W_POOL, (const char*)W_POOL + (size_t)128 * 256 * 2, (size_t)256 * 256 * 2, (char*)YCAT, D, T / 256, 4, G, bx};
              pg8::EpiBf16Scale E{ev_pool_scale}; pg8::gemm_phase<pg8::EpiBf16Scale, pg8::DenseSched, true>(lds, 256, 1024, 256, S, E); }
            }
            SEAM();
        }
        if (PH(3) && layer == 0 && IN(pb + 3)) { DEF_W
            for (int rep = 0; rep < NREP(3); ++rep) {
            for (int u = bx; u < NCH * NH; u += G) mlstm_D(lds, u >> 2, u & 3, Z, GI, BCUM, MARR, CST, NST, ev_head_norm, YCAT);
            }
            SEAM();
        }
        if (PH(4) && IN(pb + 4)) { DEF_W
            pg8::DenseSched S{(const char*)YCAT, (size_t)256 * D * 2, 0, (const char*)(layer == 0 ? W_EVOUT : W_ODOUT), (const char*)(layer == 0 ? W_EVOUT : W_ODOUT) + (size_t)128 * D * 2, (size_t)256 * D * 2, (char*)H16, D, T / 256, D / 256, G, bx};
            float* ssq = (float*)(ws + WS_SMALL + SM_SSQP) + (size_t)layer * T * 32;
            if (layer == 0) { pg8::EpiResSsq<false> E{(const void*)x_in, ssq}; pg8::gemm_phase<pg8::EpiResSsq<false>, pg8::DenseSched, true>(lds, D, D, D, S, E); }
            else { pg8::EpiResSsq<true> E{(const void*)H16, ssq}; pg8::gemm_phase<pg8::EpiResSsq<true>, pg8::DenseSched, true>(lds, D, D, D, S, E); }
            SEAM();
        }
        if (PH(6) && IN(pb + 6)) { DEF_W
            for (int rep = 0; rep < NREP(6); ++rep) {
            const bf16_t* W = W_XQ + (size_t)layer * D * D;
            pg8::DenseSched S{(const char*)H16, (size_t)256 * D * 2, 0, (const char*)W, (const char*)W + (size_t)128 * D * 2, (size_t)256 * D * 2, (char*)QX, D, T / 256, D / 256, G, bx};
            pg8::EpiBf16RowScale E{(const float*)(ws + WS_SMALL + SM_SSQP) + (size_t)layer * T * 32, 1.0f / D, EPS}; pg8::gemm_phase<pg8::EpiBf16RowScale, pg8::DenseSched, true>(lds, D, D, D, S, E);
            }
            SEAM();
        }
        if (PH(7) && IN(pb + 7)) { DEF_W
            for (int rep = 0; rep < NREP(7); ++rep) {
            for (int u = bx; u < XH * (T / 128); u += G) xattn_unit(lds, u & 3, u >> 2, QX, KX + (size_t)layer * NMEM * D, VX + (size_t)layer * NMEM * D, OATT);
            }
            SEAM();
        }
        if (PH(8) && IN(pb + 8)) { DEF_W
            const bf16_t* W = W_XO + (size_t)layer * D * D;
            pg8::DenseSched S{(const char*)OATT, (size_t)256 * D * 2, 0, (const char*)W, (const char*)W + (size_t)128 * D * 2, (size_t)256 * D * 2, (char*)H16, D, T / 256, D / 256, G, bx};
            pg8::EpiResSsq<true> E{(const void*)H16, nullptr}; pg8::gemm_phase<pg8::EpiResSsq<true>, pg8::DenseSched, true>(lds, D, D, D, S, E);
            SEAM();
        }
        if (PH(9) && IN(pb + 9)) { DEF_W
            RowArgs ra{}; ra.hin16 = H16; ra.gain = ffn_norm + (size_t)layer * D; ra.hn = HN;
            ra.rgw = rt_group_w + (size_t)layer * D * 4; ra.rgb = rt_group_b + layer * 4; ra.rew = rt_expert_w + (size_t)layer * D * NEXP; ra.reb = rt_expert_b + layer * NEXP;
            ra.cnt = cnt_p; ra.list = LIST; ra.tokinfo = TOKINFO; ra.wr = WRT + (size_t)layer * 2 * 48 * D; ra.rsl = RSL;
            row_phase<RM_ROUTE, false, true, false>(lds, ra, G);
            SEAM();
        }
        if (PH(10) && IN(pb + 10)) { DEF_W
            moe_tables(lds, cnt_p);
#if (NEWMOE & 1)
            moe_phase<1>(lds, LIST, (const char*)H16, ex_w_gate + (size_t)layer * NEXP * D * DEXP, ex_w_up + (size_t)layer * NEXP * D * DEXP, HID, G, bx, ffn_norm + (size_t)layer * D, RSL);
#ifdef MOE_ABLV
            if (NREP(10) > 1) moe_phase<1, MOE_ABLV>(lds, LIST, (const char*)H16, ex_w_gate + (size_t)layer * NEXP * D * DEXP, ex_w_up + (size_t)layer * NEXP * D * DEXP, YB, G, bx, ffn_norm + (size_t)layer * D, RSL);
#else
            if (NREP(10) > 1) moe_phase<1>(lds, LIST, (const char*)H16, ex_w_gate + (size_t)layer * NEXP * D * DEXP, ex_w_up + (size_t)layer * NEXP * D * DEXP, YB, G, bx, ffn_norm + (size_t)layer * D, RSL);
#endif
#else
            Moe1Sched S{tbl, LIST, (const char*)HN, (const char*)WG, (const char*)WU, (char*)HID, G, bx};
            pg8::EpiPair<true> E{}; for (int rep = 0; rep < NREP(10); ++rep) pg8::gemm_phase<pg8::EpiPair<true>, Moe1Sched, true>(lds, D, D, D, S, E);
#endif
            SEAM();
        }
        if (PH(11) && IN(pb + 11)) { DEF_W
            if (!args.fused) moe_tables(lds, cnt_p);
#if (NEWMOE & 2)
            moe_phase<2>(lds, nullptr, (const char*)HID, ex_w_down + (size_t)layer * NEXP * D * DEXP, nullptr, YB, G, bx);
#ifdef MOE_ABLV
            if (NREP(11) > 1) moe_phase<2, MOE_ABLV>(lds, nullptr, (const char*)HID, ex_w_down + (size_t)layer * NEXP * D * DEXP, nullptr, Z, G, bx);
#else
            if (NREP(11) > 1) moe_phase<2>(lds, nullptr, (const char*)HID, ex_w_down + (size_t)layer * NEXP * D * DEXP, nullptr, Z, G, bx);
#endif
#else
            Moe2Sched S{tbl, (const char*)HID, (const char*)WD, (char*)YB, G, bx};
            pg8::EpiBf16 E{}; for (int rep = 0; rep < NREP(11); ++rep) pg8::gemm_phase<pg8::EpiBf16, Moe2Sched, true>(lds, DEXP, DEXP, DEXP, S, E);
#endif
            SEAM();
        }
        if (PH(12) && IN(pb + 12)) { DEF_W
            if (!args.fused) moe_tables(lds, cnt_p);
            if (layer == 0) { combine_phase<false>(lds, H16, YB, TOKINFO, nullptr, RSTD1, nullptr, G); SEAM(); }
            else combine_phase<true>(lds, H16, YB, TOKINFO, final_norm, nullptr, hbuf, G);
        }
    }
#undef IN
#undef SEAM
#undef KARG
#undef hbuf
#undef INP
#undef DEF_W
#undef W_EVIN
#undef W_EVOUT
#undef W_ODIN
#undef W_ODOUT
#undef W_XQ
#undef W_XK
#undef W_XV
#undef W_XO
#undef W_POOL
#undef MEMN
#undef KX
#undef VX
#undef GATES
#undef BCUM
#undef GI
#undef MARR
#undef APREV
#undef BLG
#undef KN
#undef NST
#undef HN
#undef Z
#undef YCAT
#undef DPOOL
#undef KC
#undef CST
#undef QX
#undef OATT
#undef HID
#undef H16
#undef WRT
#undef YB
#undef LIST
#undef RSL
#undef RSTD1
#undef TOKINFO
#undef WG
#undef WU
#undef WD
#undef cnt_p
#undef x_in
#undef mem_in
#undef mix_norm
#undef xattn_norm
#undef mem_norm
#undef ffn_norm
#undef final_norm
#undef ev_w_in
#undef ev_b_gates
#undef ev_pool_w
#undef ev_pool_scale
#undef ev_head_norm
#undef ev_w_out
#undef od_w_in
#undef od_conv_w
#undef od_w_out
#undef xa_wq
#undef xa_wk
#undef xa_wv
#undef xa_wo
#undef rt_group_w
#undef rt_group_b
#undef rt_expert_w
#undef rt_expert_b
#undef ex_w_gate
#undef ex_w_up
#undef ex_w_down
}

extern "C" void kernel_launch(void* const* d_in, const int* in_sizes, int n_in, void* d_out, int out_size, void* d_ws, size_t ws_size, hipStream_t stream) {
    static int grid = 0;
    if (grid == 0) {
        if (n_in != 27 || in_sizes[0] != T * D || out_size != T * D || ws_size < WS_END) { fprintf(stderr, "kernel_launch: unexpected shapes (n_in %d, in0 %d, out %d, ws %zu < %zu); nothing launched\n", n_in, n_in > 0 ? in_sizes[0] : -1, out_size, ws_size, (size_t)WS_END); grid = -1; return; }
        int dev = 0, cus = 0, per_cu = 0;
        if (hipGetDevice(&dev) != hipSuccess || hipDeviceGetAttribute(&cus, hipDeviceAttributeMultiprocessorCount, dev) != hipSuccess) { fprintf(stderr, "kernel_launch: device query failed\n"); grid = -1; return; }
        if (hipFuncSetAttribute((const void*)mk_fwd, hipFuncAttributeMaxDynamicSharedMemorySize, LDS_BYTES) != hipSuccess) { fprintf(stderr, "kernel_launch: hipFuncSetAttribute(%d B LDS) failed\n", LDS_BYTES); grid = -1; return; }
        if (hipOccupancyMaxActiveBlocksPerMultiprocessor(&per_cu, (const void*)mk_fwd, NTHR, LDS_BYTES) != hipSuccess || per_cu < 1) fprintf(stderr, "kernel_launch: note: occupancy query reports %d workgroups per CU\n", per_cu);
        (void)hipGetLastError();
        grid = cus;
    }
    if (grid < 0) return;
    if (hipMemsetAsync((char*)d_ws + WS_CTL, 0, CTL_ZERO_BYTES, stream) != hipSuccess) { fprintf(stderr, "kernel_launch: memset failed\n"); return; }
    Args a{};
    for (int i = 0; i < 27; ++i) a.in[i] = (const float*)d_in[i];
    a.out = (float*)d_out; a.ws = (unsigned char*)d_ws;
#if MK_PER_PHASE
    for (int p = 0; p < NPH; ++p) {
        if (p == 16 || p == 17) continue;
        a.ph_lo = p; a.ph_hi = p + 1; a.fused = 0;
        hipLaunchKernelGGL(mk_fwd, dim3(grid), dim3(NTHR), LDS_BYTES, stream, a);
    }
#else
    a.ph_lo = 0; a.ph_hi = NPH; a.fused = 1;
    hipLaunchKernelGGL(mk_fwd, dim3(grid), dim3(NTHR), LDS_BYTES, stream, a);
#endif
    const hipError_t le = hipPeekAtLastError();
    if (le != hipSuccess) fprintf(stderr, "kernel_launch: launch failed: %s (grid %d)\n", hipGetErrorName(le), grid);
}
```
